# Optimizing an MI355X kernel written in HIP

```python
import math
import jax
import jax.numpy as jnp
from jax import lax
import numpy as np

D_MODEL = 1024
BATCH = 8
SEQ = 4096
DEPTH = 2

GRID_W = 64
CTX_LEN = 256
ATTN_WIDTH = D_MODEL // 2
SSD_WIDTH = D_MODEL // 4
RG_WIDTH = D_MODEL // 4
MIX_WIDTH = ATTN_WIDTH + SSD_WIDTH + RG_WIDTH
HEAD_DIM = 64
ATTN_HEADS = ATTN_WIDTH // HEAD_DIM
KV_HEADS = 2
Q_PER_KV = ATTN_HEADS // KV_HEADS
KV_WIDTH = KV_HEADS * HEAD_DIM
AXIS_DIM = HEAD_DIM // 2
ROPE_THETA = 10000.0
Q_BLOCK = 128
SSD_HEAD_DIM = 64
SSD_HEADS = SSD_WIDTH // SSD_HEAD_DIM
SSD_GROUPS = 2
SSD_STATE = 64
SSD_BC_WIDTH = SSD_GROUPS * SSD_STATE
SSD_XBC_WIDTH = SSD_WIDTH + 2 * SSD_BC_WIDTH
SSD_CHUNK = 128
RG_BLOCKS = 4
RG_BLOCK_DIM = RG_WIDTH // RG_BLOCKS
RG_C = 8.0
CONV_W = 4
CONV_PAD_LO = (CONV_W - 1) // 2
CONV_PAD_HI = CONV_W // 2
N_EXPERTS = 16
EXPERT_FF = 2 * D_MODEL
EC_CAPACITY = 2
EPS = 1e-6
DEEPNORM_ALPHA = (2 * DEPTH) ** 0.25
DEEPNORM_BETA = (8 * DEPTH) ** -0.25
IN_SPLITS = (ATTN_WIDTH, KV_WIDTH, KV_WIDTH, SSD_XBC_WIDTH, SSD_WIDTH, 2 * SSD_HEADS, RG_WIDTH, RG_WIDTH)
IN_WIDTH = ATTN_WIDTH + 2 * KV_WIDTH + SSD_XBC_WIDTH + SSD_WIDTH + 2 * SSD_HEADS + 2 * RG_WIDTH

kernel_name = 'hybrid_attn_ssd_rglru_ec_moe_dit'

F32 = jnp.float32


def split_columns(t, sizes):
    out, start = [], 0
    for s in sizes:
        out.append(t[..., start:start + s])
        start += s
    return out


def layer_norm(x, w, b):
    xf = x.astype(F32)
    mu = jnp.mean(xf, axis=-1, keepdims=True)
    var = jnp.mean(jnp.square(xf - mu), axis=-1, keepdims=True)
    return ((xf - mu) * lax.rsqrt(var + EPS) * w + b).astype(x.dtype)


def rms_norm(x, w):
    xf = x.astype(F32)
    return (xf * lax.rsqrt(jnp.mean(xf * xf, axis=-1, keepdims=True) + EPS) * w).astype(x.dtype)


def dw_conv(x, w, b):
    y = lax.conv_general_dilated(x, w[:, None, :].astype(x.dtype), window_strides=(1,),
                                 padding=[(CONV_PAD_LO, CONV_PAD_HI)],
                                 dimension_numbers=('NWC', 'WIO', 'NWC'),
                                 feature_group_count=x.shape[-1])
    return y + b


def to_heads(t, n_heads):
    return t.reshape(t.shape[0], t.shape[1], n_heads, HEAD_DIM)


def axial_rope_tables(n):
    rows = n // GRID_W
    row = jnp.repeat(jnp.arange(rows, dtype=F32), GRID_W)
    col = jnp.tile(jnp.arange(GRID_W, dtype=F32), rows)
    inv_freq = ROPE_THETA ** (-jnp.arange(0, AXIS_DIM, 2, dtype=F32) / AXIS_DIM)
    ang_r = row[:, None] * inv_freq
    ang_c = col[:, None] * inv_freq
    return (jnp.cos(ang_r), jnp.sin(ang_r), jnp.cos(ang_c), jnp.sin(ang_c))


def _rotate_half(t, cos, sin):
    t1, t2 = jnp.split(t, 2, axis=-1)
    cos = cos[:, None, :]
    sin = sin[:, None, :]
    return jnp.concatenate([t1 * cos - t2 * sin, t2 * cos + t1 * sin], axis=-1)


def apply_axial_rope(t, rope):
    cos_r, sin_r, cos_c, sin_c = rope
    out = jnp.concatenate([_rotate_half(t[..., :AXIS_DIM], cos_r, sin_r),
                           _rotate_half(t[..., AXIS_DIM:], cos_c, sin_c)], axis=-1)
    return out.astype(t.dtype)


def attend(q, k, v):
    s = jnp.einsum('bqkgd,blkd->bkgql', q, k).astype(F32) * (HEAD_DIM ** -0.5)
    p = jax.nn.softmax(s, axis=-1).astype(v.dtype)
    return jnp.einsum('bkgql,blkd->bqkgd', p, v)


def blocked_attention(q, k, v):
    b, n = q.shape[0], q.shape[1]
    nblk = n // Q_BLOCK
    qb = q.reshape(b, nblk, Q_BLOCK, KV_HEADS, Q_PER_KV, HEAD_DIM).transpose(1, 0, 2, 3, 4, 5)
    o = lax.map(lambda blk: attend(blk, k, v), qb)
    return o.transpose(1, 0, 2, 3, 4, 5).reshape(b, n, ATTN_WIDTH)


def segsum_from_cumsum(cs):
    t = cs.shape[-1]
    diff = cs[..., :, None] - cs[..., None, :]
    return jnp.where(jnp.tril(jnp.ones((t, t), dtype=bool)), diff, -jnp.inf)


def ssd_scan(xh, dt, a, bh, ch, h0):
    b, l, h, p = xh.shape
    n = bh.shape[-1]
    nc = l // SSD_CHUNK
    xdt = (xh * dt[..., None]).reshape(b, nc, SSD_CHUNK, h, p)
    bc = bh.reshape(b, nc, SSD_CHUNK, h, n)
    cc = ch.reshape(b, nc, SSD_CHUNK, h, n)
    da = (dt * a).reshape(b, nc, SSD_CHUNK, h).transpose(0, 3, 1, 2)
    da_cs = jnp.cumsum(da, axis=-1)
    l_mat = jnp.exp(segsum_from_cumsum(da_cs))
    y_diag = jnp.einsum('bclhn,bcshn,bhcls,bcshp->bclhp', cc, bc, l_mat, xdt)
    decay_states = jnp.exp(da_cs[..., -1:] - da_cs)
    states = jnp.einsum('bclhn,bhcl,bclhp->bchpn', bc, decay_states, xdt)
    states = jnp.concatenate([h0[:, None].astype(states.dtype), states], axis=1)
    chunk_tot = jnp.pad(da_cs[..., -1], ((0, 0), (0, 0), (1, 0)))
    decay_chunk = jnp.exp(segsum_from_cumsum(jnp.cumsum(chunk_tot, axis=-1)))
    new_states = jnp.einsum('bhzc,bchpn->bzhpn', decay_chunk, states)
    states_in, h_final = new_states[:, :-1], new_states[:, -1]
    y_off = jnp.einsum('bclhn,bchpn,bhcl->bclhp', cc, states_in, jnp.exp(da_cs))
    return (y_diag + y_off).reshape(b, l, h, p), h_final


def ssd_stream(xbc, dt_raw, lp, h0_f, h0_b):
    b, n, _ = xbc.shape
    xbc = jax.nn.silu(dw_conv(xbc, lp['ssd_conv_w'], lp['ssd_conv_b']))
    xs, bs, cs = split_columns(xbc, (SSD_WIDTH, SSD_BC_WIDTH, SSD_BC_WIDTH))
    xh = xs.reshape(b, n, SSD_HEADS, SSD_HEAD_DIM)
    rep = SSD_HEADS // SSD_GROUPS
    bh = jnp.repeat(bs.reshape(b, n, SSD_GROUPS, SSD_STATE), rep, axis=2)
    ch = jnp.repeat(cs.reshape(b, n, SSD_GROUPS, SSD_STATE), rep, axis=2)
    dt = jax.nn.softplus(dt_raw.astype(F32).reshape(b, n, 2, SSD_HEADS) + lp['ssd_dt_bias'].astype(F32))
    a = -jnp.exp(lp['ssd_a_log'].astype(F32))
    flip = lambda t: jnp.flip(t, axis=1)
    y_f, s_f = ssd_scan(xh, dt[:, :, 0], a[0], bh, ch, h0_f)
    y_b, s_b = ssd_scan(flip(xh), flip(dt[:, :, 1]), a[1], flip(bh), flip(ch), h0_b)
    y = y_f + flip(y_b) + lp['ssd_d'][:, None] * xh
    return y.reshape(b, n, SSD_WIDTH).astype(xs.dtype), s_f, s_b


def linear_scan(a, u, h0):
    u = u.at[:, 0].add(a[:, 0] * h0)

    def combine(left, right):
        a_l, u_l = left
        a_r, u_r = right
        return a_l * a_r, a_r * u_l + u_r

    _, h = lax.associative_scan(combine, (a, u), axis=1)
    return h


def rglru_stream(u_raw, lp, h0_f, h0_b):
    b, n, _ = u_raw.shape
    u = dw_conv(u_raw, lp['rg_conv_w'], lp['rg_conv_b'])
    ub = u.reshape(b, n, RG_BLOCKS, RG_BLOCK_DIM)

    def block_gate(w, bias):
        pre = jnp.einsum('bnkd,jkde->jbnke', ub, w).reshape(2, b, n, RG_WIDTH) + bias[:, None, None, :]
        return jax.nn.sigmoid(pre.astype(F32))

    r = block_gate(lp['rg_wa'], lp['rg_ba'])
    i = block_gate(lp['rg_wx'], lp['rg_bx'])
    log_a = -RG_C * r * jax.nn.softplus(-lp['rg_lambda'].astype(F32))[:, None, None, :]
    a = jnp.exp(log_a)
    inp = jnp.sqrt(-jnp.expm1(2.0 * log_a)) * i * u.astype(F32)[None]
    h_f = linear_scan(a[0], inp[0], h0_f)
    h_b = jnp.flip(linear_scan(jnp.flip(a[1], axis=1), jnp.flip(inp[1], axis=1), h0_b), axis=1)
    return (h_f + h_b).astype(u.dtype), h_f[:, -1], h_b[:, 0]


def expert_choice_ffn(h, lp):
    b, n, d = h.shape
    cap = EC_CAPACITY * n // N_EXPERTS
    aff = jax.nn.softmax(jnp.einsum('bnd,de->ben', h, lp['w_router']).astype(F32), axis=1)
    gate, idx = lax.top_k(aff, cap)
    xs = jax.vmap(lambda hb, ib: hb[ib])(h, idx)
    hid = jax.nn.silu(jnp.einsum('becd,edf->becf', xs, lp['w_gate'])) * jnp.einsum('becd,edf->becf', xs, lp['w_up'])
    ys = jnp.einsum('becf,efd->becd', hid, lp['w_down']) * gate[..., None].astype(h.dtype)
    return jax.vmap(lambda ib, yb: jnp.zeros((n, d), yb.dtype).at[ib.reshape(-1)].add(yb.reshape(-1, d)))(idx, ys)


def hybrid_layer(x, ctx, mod_x, mod_c, rope, lp, last):
    b = x.shape[0]
    m = ctx.shape[1]
    sh1, sc1, g1, sh2, sc2, g2 = jnp.split(mod_x[:, None, :], 6, axis=-1)
    csh1, csc1, cg1, csh2, csc2, cg2 = jnp.split(mod_c, 6, axis=-1)

    hx = x * (1 + sc1) + sh1
    hc = ctx * (1 + csc1) + csh1
    qx, kx, vx, xbc_x, zx, dtx, ux, gx = split_columns(hx @ lp['w_in'], IN_SPLITS)
    qc, kc, vc, xbc_c, zc, dtc, uc, gc = split_columns(hc @ lp['w_in'], IN_SPLITS)

    k_ctx = rms_norm(to_heads(kc, KV_HEADS), lp['k_norm'])
    v_ctx = to_heads(vc, KV_HEADS)
    q_lat = apply_axial_rope(rms_norm(to_heads(qx, ATTN_HEADS), lp['q_norm']), rope)
    k_lat = apply_axial_rope(rms_norm(to_heads(kx, KV_HEADS), lp['k_norm']), rope)
    k_all = jnp.concatenate([k_ctx, k_lat], axis=1)
    v_all = jnp.concatenate([v_ctx, to_heads(vx, KV_HEADS)], axis=1)
    attn_x = blocked_attention(q_lat, k_all, v_all)

    s0 = jnp.zeros((b, SSD_HEADS, SSD_HEAD_DIM, SSD_STATE), F32)
    ssd_c, s_f, s_b = ssd_stream(xbc_c, dtc, lp, s0, s0)
    ssd_x, _, _ = ssd_stream(xbc_x, dtx, lp, s_f, s_b)

    r0 = jnp.zeros((b, RG_WIDTH), F32)
    rg_c, r_f, r_b = rglru_stream(uc, lp, r0, r0)
    rg_x, _, _ = rglru_stream(ux, lp, r_f, r_b)

    def merge(attn, ssd, z, rg, gate):
        groups = [rms_norm(attn, lp['attn_out_norm']),
                  rms_norm(ssd * jax.nn.silu(z), lp['ssd_norm']),
                  rms_norm(rg * jax.nn.gelu(gate), lp['rg_out_norm'])]
        return jnp.concatenate(groups, axis=-1) @ lp['w_out']

    x = layer_norm(DEEPNORM_ALPHA * x + g1 * merge(attn_x, ssd_x, zx, rg_x, gx), lp['ln1_w'], lp['ln1_b'])
    if not last:
        q_ctx = rms_norm(to_heads(qc, ATTN_HEADS), lp['q_norm']).reshape(b, m, KV_HEADS, Q_PER_KV, HEAD_DIM)
        attn_c = attend(q_ctx, k_ctx, v_ctx).reshape(b, m, ATTN_WIDTH)
        ctx = layer_norm(DEEPNORM_ALPHA * ctx + cg1 * merge(attn_c, ssd_c, zc, rg_c, gc), lp['ln1_w'], lp['ln1_b'])

    x = layer_norm(DEEPNORM_ALPHA * x + g2 * expert_choice_ffn(x * (1 + sc2) + sh2, lp), lp['ln2_w'], lp['ln2_b'])
    if not last:
        ctx = layer_norm(DEEPNORM_ALPHA * ctx + cg2 * expert_choice_ffn(ctx * (1 + csc2) + csh2, lp), lp['ln2_w'], lp['ln2_b'])
    return x, ctx


def setup_inputs(seed: int = 0) -> dict:
    key = jax.random.key(seed)
    keys = iter(jax.random.split(key, 48))
    nrm = lambda shape, scale: jax.random.normal(next(keys), shape, F32) * scale
    L, D = DEPTH, D_MODEL
    dt0 = jnp.exp(jax.random.uniform(next(keys), (L, 2, SSD_HEADS), F32, math.log(1e-3), math.log(1e-1)))
    a0 = jax.random.uniform(next(keys), (L, 2, RG_WIDTH), F32, 0.9, 0.999)
    return {
        'x': nrm((BATCH, SEQ, D), 1.0),
        'c': nrm((BATCH, D), 1.0),
        'ctx': nrm((BATCH, CTX_LEN, D), 1.0),
        'c_ctx': nrm((D,), 1.0),
        'w_mod': nrm((L, D, 6 * D), 0.5 * D ** -0.5),
        'b_mod': nrm((L, 6 * D), 0.02),
        'w_in': nrm((L, D, IN_WIDTH), D ** -0.5),
        'q_norm': 1.0 + nrm((L, HEAD_DIM), 0.02),
        'k_norm': 1.0 + nrm((L, HEAD_DIM), 0.02),
        'attn_out_norm': 1.0 + nrm((L, ATTN_WIDTH), 0.02),
        'ssd_conv_w': nrm((L, CONV_W, SSD_XBC_WIDTH), CONV_W ** -0.5),
        'ssd_conv_b': nrm((L, SSD_XBC_WIDTH), 0.02),
        'ssd_dt_bias': dt0 + jnp.log(-jnp.expm1(-dt0)),
        'ssd_a_log': jnp.log(jax.random.uniform(next(keys), (L, 2, SSD_HEADS), F32, 1.0, 16.0)),
        'ssd_d': 1.0 + nrm((L, SSD_HEADS), 0.02),
        'ssd_norm': 1.0 + nrm((L, SSD_WIDTH), 0.02),
        'rg_conv_w': nrm((L, CONV_W, RG_WIDTH), CONV_W ** -0.5),
        'rg_conv_b': nrm((L, RG_WIDTH), 0.02),
        'rg_wa': nrm((L, 2, RG_BLOCKS, RG_BLOCK_DIM, RG_BLOCK_DIM), RG_BLOCK_DIM ** -0.5),
        'rg_ba': nrm((L, 2, RG_WIDTH), 0.02),
        'rg_wx': nrm((L, 2, RG_BLOCKS, RG_BLOCK_DIM, RG_BLOCK_DIM), RG_BLOCK_DIM ** -0.5),
        'rg_bx': nrm((L, 2, RG_WIDTH), 0.02),
        'rg_lambda': jnp.log(a0) - jnp.log1p(-a0),
        'rg_out_norm': 1.0 + nrm((L, RG_WIDTH), 0.02),
        'w_out': nrm((L, MIX_WIDTH, D), DEEPNORM_BETA * MIX_WIDTH ** -0.5),
        'ln1_w': 1.0 + nrm((L, D), 0.02),
        'ln1_b': nrm((L, D), 0.02),
        'w_router': nrm((L, D, N_EXPERTS), D ** -0.5),
        'w_gate': nrm((L, N_EXPERTS, D, EXPERT_FF), D ** -0.5),
        'w_up': nrm((L, N_EXPERTS, D, EXPERT_FF), D ** -0.5),
        'w_down': nrm((L, N_EXPERTS, EXPERT_FF, D), DEEPNORM_BETA * EXPERT_FF ** -0.5),
        'ln2_w': 1.0 + nrm((L, D), 0.02),
        'ln2_b': nrm((L, D), 0.02),
    }


def reference(x, c, ctx, c_ctx, w_mod, b_mod, w_in, q_norm, k_norm, attn_out_norm,
              ssd_conv_w, ssd_conv_b, ssd_dt_bias, ssd_a_log, ssd_d, ssd_norm,
              rg_conv_w, rg_conv_b, rg_wa, rg_ba, rg_wx, rg_bx, rg_lambda, rg_out_norm,
              w_out, ln1_w, ln1_b, w_router, w_gate, w_up, w_down, ln2_w, ln2_b):
    rope = axial_rope_tables(x.shape[1])
    for l in range(DEPTH):
        lp = dict(w_in=w_in[l], q_norm=q_norm[l], k_norm=k_norm[l], attn_out_norm=attn_out_norm[l],
                  ssd_conv_w=ssd_conv_w[l], ssd_conv_b=ssd_conv_b[l], ssd_dt_bias=ssd_dt_bias[l],
                  ssd_a_log=ssd_a_log[l], ssd_d=ssd_d[l], ssd_norm=ssd_norm[l],
                  rg_conv_w=rg_conv_w[l], rg_conv_b=rg_conv_b[l], rg_wa=rg_wa[l], rg_ba=rg_ba[l],
                  rg_wx=rg_wx[l], rg_bx=rg_bx[l], rg_lambda=rg_lambda[l], rg_out_norm=rg_out_norm[l],
                  w_out=w_out[l], ln1_w=ln1_w[l], ln1_b=ln1_b[l], w_router=w_router[l],
                  w_gate=w_gate[l], w_up=w_up[l], w_down=w_down[l], ln2_w=ln2_w[l], ln2_b=ln2_b[l])
        mod_x = jax.nn.silu(c) @ w_mod[l] + b_mod[l]
        mod_c = jax.nn.silu(c_ctx) @ w_mod[l] + b_mod[l]
        x, ctx = hybrid_layer(x, ctx, mod_x, mod_c, rope, lp, l == DEPTH - 1)
    return x
```

```cpp
#include <hip/hip_runtime.h>
#include <hip/hip_bf16.h>
#include <cstdio>
#include <cstdint>
#include <cmath>
namespace pg8 {
#define PG8_LAS __attribute__((address_space(3)))
typedef unsigned short bf16_t;
typedef short bf16x8 __attribute__((ext_vector_type(8)));
typedef float f32x4 __attribute__((ext_vector_type(4)));
typedef unsigned u32x4 __attribute__((ext_vector_type(4)));
constexpr int BM = 256, BK = 64, HALF = 128, HTB = HALF * BK * 2  , STAGE_BYTES = 8 * HTB, NXCD = 8, WGM = 8;

__host__ __device__ __forceinline__ int lds_byte(int r, int c) { const int st = (r >> 4) * 2 + (c >> 5), rr = r & 15, cc = c & 31, ob = rr * 64 + cc * 2; return st * 1024 + (ob ^ (((ob >> 9) & 1) << 5)); }
__host__ __device__ __forceinline__ void stage_rc(int b, int& R, int& C) { const int st = b / 1024, sb = b % 1024, swz = sb ^ (((sb >> 9) & 1) << 5); R = (st >> 1) * 16 + swz / 64; C = (st & 1) * 32 + (swz % 64) / 2; }
__host__ __device__ __forceinline__ int perm32(int rho) { const int n = rho >> 4, i = rho & 15; return 8 * (i >> 2) + 4 * n + (i & 3); }

struct Unit { int pm, pn, pa, pb; };
struct Gemm { const bf16_t* A; const bf16_t* Bt; int M, N, K; const int* rowsrc = nullptr; };

struct StaticOrder {
    int nM, nN, nwg, G, c;
    __host__ __device__ void init(int M, int N, int G_, int c_) { nM = M / BM; nN = N / BM; nwg = nM * nN; G = G_; c = c_; }
    __host__ __device__ bool next(int i, Unit& u) const {
        const long L = (long)i * G + c; if (L >= nwg) return false;
        int wgid = (int)L; { const int q = nwg / NXCD, r = nwg % NXCD, xcd = wgid % NXCD, off = wgid / NXCD; wgid = (xcd < r ? xcd * (q + 1) : r * (q + 1) + (xcd - r) * q) + off; }
        const int nig = WGM * nN, gid = wgid / nig, fm = gid * WGM, gsz = (nM - fm) < WGM ? (nM - fm) : WGM;
        u.pm = fm + ((wgid % nig) % gsz); u.pn = (wgid % nig) / gsz; u.pa = u.pm; u.pb = u.pn; return true;
    }
    __device__ __forceinline__ void a_ready(const Unit&) const {}
    __device__ __forceinline__ void done(const Unit&) const {}
};

__device__ __forceinline__ unsigned cvt_pk_bf16(float lo, float hi) { unsigned r; asm volatile("v_cvt_pk_bf16_f32 %0, %1, %2" : "=v"(r) : "v"(lo), "v"(hi)); return r; }
__device__ __forceinline__ float silu_f(float x) { return x * __builtin_amdgcn_rcpf(1.f + __builtin_amdgcn_exp2f(x * -1.4426950408889634f)); }
struct EpiStoreBf16 {
    static constexpr bool PERM = true, AFTER_DRAIN = false;
    bf16_t* O; int ldc; const float* rowscale;
    __device__ __forceinline__ void operator()(const f32x4 (&acc)[2][2][4][2], const Unit& u, int wr, int wc, int fr, int fq) const {
        const int row0 = u.pm * BM + wr * 64 + fr; const int col0 = u.pn * BM + wc * 32 + 8 * fq;
#pragma unroll
        for (int ai = 0; ai < 2; ++ai)
#pragma unroll
            for (int m = 0; m < 4; ++m) { const int row = row0 + ai * HALF + m * 16; bf16_t* rowp = O + (size_t)row * ldc + col0;
                const float sc = rowscale ? rowscale[row] : 1.f;
#pragma unroll
                for (int bj = 0; bj < 2; ++bj) { const f32x4 v0 = acc[ai][bj][m][0] * sc, v1 = acc[ai][bj][m][1] * sc;
                    u32x4 w; w.x = cvt_pk_bf16(v0[0], v0[1]); w.y = cvt_pk_bf16(v0[2], v0[3]); w.z = cvt_pk_bf16(v1[0], v1[1]); w.w = cvt_pk_bf16(v1[2], v1[3]);
                    *(u32x4*)(rowp + bj * HALF) = w; } }
    }
};
struct EpiSwiGlu {
    static constexpr bool PERM = false, AFTER_DRAIN = false;
    bf16_t* O; int ldc;
    __device__ __forceinline__ void operator()(const f32x4 (&acc)[2][2][4][2], const Unit& u, int wr, int wc, int fr, int fq) const {
#pragma unroll
        for (int ai = 0; ai < 2; ++ai)
#pragma unroll
            for (int m = 0; m < 4; ++m) { const int row = u.pm * BM + ai * HALF + wr * 64 + m * 16 + fr; const int col = u.pn * 128 + wc * 32 + 8 * fq;
                const f32x4 g0 = acc[ai][0][m][0], u0 = acc[ai][0][m][1], g1 = acc[ai][1][m][0], u1 = acc[ai][1][m][1];
                u32x4 w; w.x = cvt_pk_bf16(silu_f(g0[0]) * u0[0], silu_f(g0[1]) * u0[1]); w.y = cvt_pk_bf16(silu_f(g0[2]) * u0[2], silu_f(g0[3]) * u0[3]);
                w.z = cvt_pk_bf16(silu_f(g1[0]) * u1[0], silu_f(g1[1]) * u1[1]); w.w = cvt_pk_bf16(silu_f(g1[2]) * u1[2], silu_f(g1[3]) * u1[3]);
                *(u32x4*)(O + (size_t)row * ldc + col) = w; }
    }
};
struct EpiResid {
    static constexpr bool PERM = false, AFTER_DRAIN = false;
    const float* xres; float* out; const float* g1base; float alpha;
    __device__ __forceinline__ void operator()(const f32x4 (&acc)[2][2][4][2], const Unit& u, int wr, int wc, int fr, int fq) const {
        const int mrow = (u.pm % 17 == 0) ? 8 : (u.pm / 17); const float* g1 = g1base + (size_t)mrow * 6144;
        const int col0 = u.pn * BM + wc * 32 + 4 * fq;
        f32x4 gv[2][2];
#pragma unroll
        for (int bj = 0; bj < 2; ++bj)
#pragma unroll
            for (int n = 0; n < 2; ++n) gv[bj][n] = *(const f32x4*)(g1 + col0 + bj * HALF + n * 16);
#pragma unroll
        for (int ai = 0; ai < 2; ++ai)
#pragma unroll
            for (int m = 0; m < 4; ++m) { const size_t off = (size_t)(u.pm * BM + ai * HALF + wr * 64 + m * 16 + fr) * 1024 + col0;
#pragma unroll
                for (int bj = 0; bj < 2; ++bj)
#pragma unroll
                    for (int n = 0; n < 2; ++n) { const f32x4 xr = *(const f32x4*)(xres + off + bj * HALF + n * 16);
                        *(f32x4*)(out + off + bj * HALF + n * 16) = acc[ai][bj][m][n] * gv[bj][n] + xr * alpha; } }
    }
};
struct RowOrder {
    bool xonly; int G, c;
    __device__ __forceinline__ bool next(int i, Unit& u) const {
        const long L = (long)i * G + c; const int ntiles = xonly ? 128 : 136; if (L >= (long)ntiles * 4) return false;
        const int U = (int)L, xt = U >> 2; u.pm = xonly ? (xt >> 4) * 17 + 1 + (xt & 15) : xt; u.pn = U & 3; u.pa = u.pm; u.pb = u.pn; return true;
    }
    __device__ __forceinline__ void a_ready(const Unit&) const {}
    __device__ __forceinline__ void done(const Unit&) const {}
};
struct MoeOrder {
    int MT, NTB, G, c;
    __device__ __forceinline__ bool next(int i, Unit& u) const {
        const long L = (long)i * G + c; if (L >= (long)16 * MT * NTB) return false;
        const int U = (int)L, per = MT * NTB, e = U / per, rem = U % per; int mt = rem / NTB, nt = rem % NTB;
        if (MT == 16 && NTB == 16) { const int x = rem >> 5, sl = rem & 31; mt = 4 * (x >> 1) + (sl >> 3); nt = 8 * (x & 1) + (sl & 7); }
        u.pa = e * 17 + mt; u.pb = e * NTB + nt; u.pm = u.pa; u.pn = nt; return true;
    }
    __device__ __forceinline__ void a_ready(const Unit&) const {}
    __device__ __forceinline__ void done(const Unit&) const {}
};
template <class Epi, class Sched, bool ALIGN_EPI = false, bool SP2 = false, bool GATHER = false>
__device__ __forceinline__ void gemm_phase(PG8_LAS unsigned char* lds, const Gemm g, const Sched& S, const Epi& E) {
    int tid_ = threadIdx.x; asm volatile("" : "+v"(tid_));
    const int tid = tid_, wid = __builtin_amdgcn_readfirstlane(tid >> 6), lane = tid & 63, wr = wid >> 2, wc = wid & 3, fr = lane & 15, fq = lane >> 4;
    const int K = g.K, nt = K / BK;
    static_assert(!GATHER || SP2, "the gathered A path is written for the SP2 loop only");
    unsigned voffA[2], voffB[2], ccol[2] = {0u, 0u}; int rrow[2] = {0, 0};
#pragma unroll
    for (int i = 0; i < 2; ++i) { int R, C; stage_rc(tid * 16 + i * 8192, R, C); const int Rb = Epi::PERM ? ((R & ~31) + perm32(R & 31)) : R;
        voffA[i] = (unsigned)(R * K + C) * 2u; voffB[i] = (unsigned)(Rb * K + C) * 2u; ccol[i] = (unsigned)C * 2u; rrow[i] = R; }
    const size_t kstep = (size_t)(BK * 2);
    const size_t hstep = (size_t)HALF * K * 2;
    const size_t tstep = 2 * hstep;
    const unsigned ldsw = (unsigned)wid * 1024u;
    const int aoff = lds_byte(wr * 64 + fr, fq * 8), boff = lds_byte(wc * 32 + fr, fq * 8);
#define PG8_SA(b, h) (((b) * 2 + (h)) * HTB)
#define PG8_SB(b, h) ((4 + (b) * 2 + (h)) * HTB)
    const char* gA = (const char*)g.A; PG8_LAS unsigned* idxl = (PG8_LAS unsigned*)(lds + STAGE_BYTES);
#define PG8_IDX(buf, hi) (idxl[((buf) * 4 + (hi)) * 512 + wid * 64 + lane])
#define PG8_STA(bufoff, gbase, gptr, w0, w1) do { if constexpr (GATHER) { const unsigned vo_[2] = {(w0) * (unsigned)(K * 2) + ccol[0], (w1) * (unsigned)(K * 2) + ccol[1]}; PG8_STAGE(bufoff, gptr, vo_); } else { PG8_STAGE(bufoff, gbase, voffA); } } while (0)
#define PG8_WAIT_VX() do { if constexpr (GATHER) asm volatile("s_waitcnt vmcnt(12)" ::: "memory"); else asm volatile("s_waitcnt vmcnt(8)" ::: "memory"); } while (0)
#define PG8_STAGE(bufoff, gbase, voff) do { _Pragma("unroll") for (int _i = 0; _i < 2; ++_i) \
        __builtin_amdgcn_global_load_lds((const unsigned*)((const char*)(gbase) + (voff)[_i]), (PG8_LAS unsigned*)(lds + (bufoff) + ldsw + _i * 8192), 16, 0, 0); } while (0)
#define PG8_LDA(dst, b, h) do { _Pragma("unroll") for (int m = 0; m < 4; ++m) _Pragma("unroll") for (int k = 0; k < 2; ++k) dst[m][k] = *(const PG8_LAS bf16x8*)(lds + PG8_SA(b, h) + aoff + m * 2048 + k * 1024); } while (0)
#define PG8_LDB(dst, b, h) do { _Pragma("unroll") for (int n = 0; n < 2; ++n) _Pragma("unroll") for (int k = 0; k < 2; ++k) dst[n][k] = *(const PG8_LAS bf16x8*)(lds + PG8_SB(b, h) + boff + n * 2048 + k * 1024); } while (0)
#define PG8_MMA(ai, bj, At, Bt) do { __builtin_amdgcn_s_setprio(1); _Pragma("unroll") for (int m = 0; m < 4; ++m) _Pragma("unroll") for (int n = 0; n < 2; ++n) _Pragma("unroll") for (int k = 0; k < 2; ++k) \
        acc[ai][bj][m][n] = __builtin_amdgcn_mfma_f32_16x16x32_bf16(Bt[n][k], At[m][k], acc[ai][bj][m][n], 0, 0, 0); __builtin_amdgcn_s_setprio(0); } while (0)
#define PG8_WAIT_V(n) asm volatile("s_waitcnt vmcnt(" #n ")" ::: "memory")
#define PG8_WAIT_L(n) asm volatile("s_waitcnt lgkmcnt(" #n ")" ::: "memory")
#define PG8_BAR __builtin_amdgcn_s_barrier()
#define PG8_SCHED __builtin_amdgcn_sched_barrier(0)
    Unit cur, nxt; int ui = 0;
    if (!S.next(0, cur)) return;
    f32x4 acc[2][2][4][2];
#pragma unroll
    for (int a = 0; a < 2; ++a)
#pragma unroll
        for (int b = 0; b < 2; ++b)
#pragma unroll
            for (int m = 0; m < 4; ++m)
#pragma unroll
                for (int n = 0; n < 2; ++n) acc[a][b][m][n] = (f32x4){0.f, 0.f, 0.f, 0.f};
    bf16x8 At[4][2], B0[2][2], B1[2][2];
    const char* cA = (const char*)g.A + (size_t)cur.pa * tstep; const char* cB = (const char*)g.Bt + (size_t)cur.pb * tstep;
    unsigned w00 = 0u, w01 = 0u, w10 = 0u, w11 = 0u;
    if constexpr (GATHER) { const int* rs = g.rowsrc + (size_t)cur.pa * 256; w00 = (unsigned)rs[rrow[0]]; w01 = (unsigned)rs[rrow[1]]; w10 = (unsigned)rs[128 + rrow[0]]; w11 = (unsigned)rs[128 + rrow[1]];
        PG8_IDX(0, 0) = w00; PG8_IDX(0, 1) = w01; PG8_IDX(0, 2) = w10; PG8_IDX(0, 3) = w11; }
    S.a_ready(cur);
    if constexpr (SP2) {
        PG8_STAGE(PG8_SB(0, 0), cB, voffB); PG8_STAGE(PG8_SB(0, 1), cB + hstep, voffB); PG8_STA(PG8_SA(0, 0), cA, gA, w00, w01); PG8_STA(PG8_SA(0, 1), cA + hstep, gA, w10, w11);
        if (wr == 1) PG8_BAR;
        PG8_WAIT_V(2); PG8_BAR;
        PG8_STAGE(PG8_SB(1, 0), cB + kstep, voffB); PG8_STA(PG8_SA(1, 0), cA + kstep, gA + kstep, w00, w01); PG8_STAGE(PG8_SB(1, 1), cB + hstep + kstep, voffB);
        PG8_WAIT_V(6); PG8_BAR;
    } else {
        PG8_STAGE(PG8_SB(0, 0), cB, voffB); PG8_STAGE(PG8_SA(0, 0), cA, voffA); PG8_STAGE(PG8_SB(0, 1), cB + hstep, voffB); PG8_STAGE(PG8_SA(0, 1), cA + hstep, voffA);
        if (wr == 1) PG8_BAR;
        PG8_WAIT_V(4); PG8_BAR;
        PG8_STAGE(PG8_SB(1, 0), cB + kstep, voffB); PG8_STAGE(PG8_SA(1, 0), cA + kstep, voffA); PG8_STAGE(PG8_SB(1, 1), cB + hstep + kstep, voffB);
        PG8_WAIT_V(6); PG8_BAR;
    }
    for (;;) {
        const bool has_next = S.next(ui + 1, nxt);
        const char* nA = has_next ? (const char*)g.A + (size_t)nxt.pa * tstep : cA; const char* nB = has_next ? (const char*)g.Bt + (size_t)nxt.pb * tstep : cB;
        for (int t = 0; t < nt; t += 2) {
            const bool last = (t == nt - 2);
            const char* a1 = cA + (size_t)(t + 1) * kstep;
            const char* a2 = last ? nA : cA + (size_t)(t + 2) * kstep; const char* b2 = last ? nB : cB + (size_t)(t + 2) * kstep;
            const char* a3 = a2 + kstep; const char* b3 = b2 + kstep;
            if (last && has_next) S.a_ready(nxt);
            const int cbuf = ui & 1, xbuf = (last && has_next) ? (cbuf ^ 1) : cbuf;
            const char* ga1 = gA + (size_t)(t + 1) * kstep; const char* ga2 = last ? gA : gA + (size_t)(t + 2) * kstep; const char* ga3 = ga2 + kstep;
            unsigned c10 = 0u, c11 = 0u, x00 = 0u, x01 = 0u, x10 = 0u, x11 = 0u;
            if constexpr (GATHER) {
                { const int* rs = g.rowsrc + (size_t)(has_next ? nxt.pa : cur.pa) * 256;
                    __builtin_amdgcn_global_load_lds((const unsigned*)(rs + rrow[0]), &PG8_IDX(cbuf ^ 1, 0) - lane, 4, 0, 0); __builtin_amdgcn_global_load_lds((const unsigned*)(rs + rrow[1]), &PG8_IDX(cbuf ^ 1, 1) - lane, 4, 0, 0);
                    __builtin_amdgcn_global_load_lds((const unsigned*)(rs + 128 + rrow[0]), &PG8_IDX(cbuf ^ 1, 2) - lane, 4, 0, 0); __builtin_amdgcn_global_load_lds((const unsigned*)(rs + 128 + rrow[1]), &PG8_IDX(cbuf ^ 1, 3) - lane, 4, 0, 0); }
                c10 = PG8_IDX(cbuf, 2); c11 = PG8_IDX(cbuf, 3); x00 = PG8_IDX(xbuf, 0); x01 = PG8_IDX(xbuf, 1); x10 = PG8_IDX(xbuf, 2); x11 = PG8_IDX(xbuf, 3);
            }
            if constexpr (SP2) {
            PG8_LDB(B0, 0, 0); PG8_LDB(B1, 0, 1); PG8_SCHED; PG8_LDA(At, 0, 0); PG8_STA(PG8_SA(1, 1), a1 + hstep, ga1, c10, c11);
            PG8_WAIT_VX(); PG8_WAIT_L(0); PG8_BAR; PG8_MMA(0, 0, At, B0); PG8_MMA(0, 1, At, B1); PG8_BAR; PG8_SCHED;
            PG8_LDA(At, 0, 1); PG8_STAGE(PG8_SB(0, 0), b2, voffB); PG8_STAGE(PG8_SB(0, 1), b2 + hstep, voffB); PG8_STA(PG8_SA(0, 0), a2, ga2, x00, x01);
            PG8_WAIT_VX(); PG8_WAIT_L(0); PG8_BAR; PG8_MMA(1, 0, At, B0); PG8_MMA(1, 1, At, B1); PG8_BAR; PG8_SCHED;
            PG8_LDB(B0, 1, 0); PG8_LDB(B1, 1, 1); PG8_SCHED; PG8_LDA(At, 1, 0); PG8_STA(PG8_SA(0, 1), a2 + hstep, ga2, x10, x11);
            PG8_WAIT_V(8); PG8_WAIT_L(0); PG8_BAR; PG8_MMA(0, 0, At, B0); PG8_MMA(0, 1, At, B1); PG8_BAR; PG8_SCHED;
            PG8_LDA(At, 1, 1); PG8_STAGE(PG8_SB(1, 0), b3, voffB); PG8_STAGE(PG8_SB(1, 1), b3 + hstep, voffB); PG8_STA(PG8_SA(1, 0), a3, ga3, x00, x01);
            PG8_WAIT_V(8); PG8_WAIT_L(0); PG8_BAR; PG8_MMA(1, 0, At, B0); PG8_MMA(1, 1, At, B1); PG8_BAR; PG8_SCHED;
            } else {
            PG8_LDB(B0, 0, 0); PG8_SCHED; PG8_LDA(At, 0, 0); PG8_STAGE(PG8_SA(1, 1), a1 + hstep, voffA);
            PG8_WAIT_L(8); PG8_BAR; PG8_WAIT_L(0); PG8_MMA(0, 0, At, B0); PG8_BAR; PG8_SCHED;
            PG8_LDB(B1, 0, 1); PG8_STAGE(PG8_SB(0, 0), b2, voffB);
            PG8_BAR; PG8_WAIT_L(0); PG8_MMA(0, 1, At, B1); PG8_BAR;
            PG8_LDA(At, 0, 1); PG8_STAGE(PG8_SA(0, 0), a2, voffA);
            PG8_BAR; PG8_WAIT_L(0); PG8_MMA(1, 0, At, B0); PG8_BAR; PG8_SCHED;
            PG8_STAGE(PG8_SB(0, 1), b2 + hstep, voffB);
            PG8_WAIT_V(6); PG8_BAR; PG8_MMA(1, 1, At, B1); PG8_BAR;
            PG8_LDB(B0, 1, 0); PG8_SCHED; PG8_LDA(At, 1, 0); PG8_STAGE(PG8_SA(0, 1), a2 + hstep, voffA);
            PG8_WAIT_L(8); PG8_BAR; PG8_WAIT_L(0); PG8_MMA(0, 0, At, B0); PG8_BAR; PG8_SCHED;
            PG8_LDB(B1, 1, 1); PG8_STAGE(PG8_SB(1, 0), b3, voffB);
            PG8_BAR; PG8_WAIT_L(0); PG8_MMA(0, 1, At, B1); PG8_BAR;
            PG8_LDA(At, 1, 1); PG8_STAGE(PG8_SA(1, 0), a3, voffA);
            PG8_BAR; PG8_WAIT_L(0); PG8_MMA(1, 0, At, B0); PG8_BAR; PG8_SCHED;
            PG8_STAGE(PG8_SB(1, 1), b3 + hstep, voffB);
            PG8_WAIT_V(6); PG8_BAR; PG8_MMA(1, 1, At, B1); PG8_BAR;
            }
        }
        if constexpr (ALIGN_EPI) { if (wr == 0) PG8_BAR; }
        if constexpr (!Epi::AFTER_DRAIN) { E(acc, cur, wr, wc, fr, fq); S.done(cur); }
        if (!has_next) break;
#pragma unroll
        for (int a = 0; a < 2; ++a)
#pragma unroll
            for (int b = 0; b < 2; ++b)
#pragma unroll
                for (int m = 0; m < 4; ++m)
#pragma unroll
                    for (int n = 0; n < 2; ++n) acc[a][b][m][n] = (f32x4){0.f, 0.f, 0.f, 0.f};
        cur = nxt; cA = nA; cB = nB; ++ui;
        if constexpr (ALIGN_EPI) { if (wr == 1) PG8_BAR; }
    }
    PG8_WAIT_V(0);
    if constexpr (!ALIGN_EPI) { if (wr == 0) PG8_BAR; }
    PG8_BAR;
    if constexpr (Epi::AFTER_DRAIN) { E.fused(acc, cur, wr, wc, fr, fq, lds, wid, lane); S.done(cur); }
#undef PG8_SA
#undef PG8_SB
#undef PG8_STAGE
#undef PG8_STA
#undef PG8_IDX
#undef PG8_WAIT_VX
#undef PG8_LDA
#undef PG8_LDB
#undef PG8_MMA
#undef PG8_WAIT_V
#undef PG8_WAIT_L
#undef PG8_BAR
#undef PG8_SCHED
}
}
namespace attn_body {
using bf16=__hip_bfloat16;
using bf16x8=__attribute__((ext_vector_type(8)))short;
using s16x4=__attribute__((ext_vector_type(4)))short;
using f32x16=__attribute__((ext_vector_type(16)))float;
using u32x4=__attribute__((ext_vector_type(4)))unsigned;
constexpr int D=64,DM=2048,DMK=128,LBROWS=4352;
constexpr int NW=8,QBLK=32,QB=QBLK*NW,KVBLK=64;
__device__ __forceinline__ int crow(int r,int hi){return (r&3)+8*(r>>2)+4*hi;}
#define SBAR() __builtin_amdgcn_sched_barrier(0)
__device__ __forceinline__ void cmask(f32x16&p0,f32x16&p1,int jb,int qrel,int hi){
  const float NEG=-INFINITY; int kb=64*jb+4*hi;
  #pragma unroll
  for(int r=0;r<16;++r){int kv=kb+(r&3)+8*(r>>2); if(kv>qrel)p0[r]=NEG; if(kv+32>qrel)p1[r]=NEG;}
}

constexpr int NSLOT=3, SLOTB=8192;
constexpr int LDS_K=0, LDS_V=NSLOT*SLOTB, LDS_WS=2*NSLOT*SLOTB, LDS_OST=LDS_WS+NW*64*4, LDS_BYTES=LDS_OST+NW*4096;
constexpr float C2=0.125f*1.4426950408889634f;
__device__ __forceinline__ void glds16(const void*gsrc,unsigned lds_dst){unsigned keep;
  asm volatile("s_mov_b32 %0, m0\n\ts_mov_b32 m0, %2\n\ts_nop 0\n\tglobal_load_lds_dwordx4 %1, off\n\ts_mov_b32 m0, %0":"=&s"(keep):"v"(gsrc),"s"(lds_dst):"memory");}
__device__ __forceinline__ float max3f(float a,float b,float c){float r;asm("v_max3_f32 %0, %1, %2, %3":"=v"(r):"v"(a),"v"(b),"v"(c));return r;}
__device__ __forceinline__ float max2f(float a,float b){float r;asm("v_max_f32_e32 %0, %1, %2":"=v"(r):"v"(a),"v"(b));return r;}
__device__ __forceinline__ float fadd_s(float a,float b){float r;asm("v_add_f32_e32 %0, %1, %2":"=v"(r):"v"(a),"v"(b));return r;}
__device__ __forceinline__ float fsub_s(float a,float b){float r;asm("v_sub_f32_e32 %0, %1, %2":"=v"(r):"v"(a),"v"(b));return r;}
typedef float f32x2_t __attribute__((ext_vector_type(2))); typedef __bf16 bf16x2_t __attribute__((ext_vector_type(2)));
__device__ __forceinline__ unsigned cvtpk_s(float lo,float hi){f32x2_t v={lo,hi};bf16x2_t b=__builtin_convertvector(v,bf16x2_t);return __builtin_bit_cast(unsigned,b);}
#define WAIT_BAR(N) asm volatile("s_waitcnt vmcnt(" #N ") lgkmcnt(0)\n\ts_barrier":::"memory")

__device__ __forceinline__ void qkt(f32x16&p0,f32x16&p1,const char*Kslot,const bf16x8*qr,const f32x16&negm,int r32,int hi){
  const char*kb=Kslot+hi*1024+r32*16;
  #pragma unroll
  for(int d0=0;d0<4;++d0){
    const bf16x8 b0=*reinterpret_cast<const bf16x8*>(kb+d0*2048);
    const bf16x8 b1=*reinterpret_cast<const bf16x8*>(kb+d0*2048+512);
    if(d0==0){p0=__builtin_amdgcn_mfma_f32_32x32x16_bf16(b0,qr[0],negm,0,0,0);p1=__builtin_amdgcn_mfma_f32_32x32x16_bf16(b1,qr[0],negm,0,0,0);}
    else{p0=__builtin_amdgcn_mfma_f32_32x32x16_bf16(b0,qr[d0],p0,0,0,0);p1=__builtin_amdgcn_mfma_f32_32x32x16_bf16(b1,qr[d0],p1,0,0,0);}}
}
typedef __attribute__((address_space(3))) const char* lds_cptr;
typedef short v4i16_t __attribute__((ext_vector_type(4)));
__device__ __forceinline__ void kload8(bf16x8*kf,lds_cptr kp){
  kf[0]=*(const __attribute__((address_space(3))) bf16x8*)(kp);      kf[1]=*(const __attribute__((address_space(3))) bf16x8*)(kp+512);
  kf[2]=*(const __attribute__((address_space(3))) bf16x8*)(kp+2048); kf[3]=*(const __attribute__((address_space(3))) bf16x8*)(kp+2560);
  kf[4]=*(const __attribute__((address_space(3))) bf16x8*)(kp+4096); kf[5]=*(const __attribute__((address_space(3))) bf16x8*)(kp+4608);
  kf[6]=*(const __attribute__((address_space(3))) bf16x8*)(kp+6144); kf[7]=*(const __attribute__((address_space(3))) bf16x8*)(kp+6656);
}
__device__ __forceinline__ void kload2(bf16x8*kf,lds_cptr kp,int j){ kf[2*j]=*(const __attribute__((address_space(3))) bf16x8*)(kp+j*2048); kf[2*j+1]=*(const __attribute__((address_space(3))) bf16x8*)(kp+j*2048+512); }
__device__ __forceinline__ s16x4 vtr(lds_cptr p){ return __builtin_bit_cast(s16x4,__builtin_amdgcn_ds_read_tr16_b64_v4i16((__attribute__((address_space(3))) v4i16_t*)p)); }
__device__ __forceinline__ float rowmax(const f32x16&p0,const f32x16&p1){
  float a=max3f(p0[0],p0[1],p1[0]),b=max3f(p0[2],p0[3],p1[1]);a=max3f(a,p1[2],p1[3]);
  #pragma unroll
  for(int r=4;r<16;r+=4){a=max3f(a,p0[r],p0[r+1]);b=max3f(b,p0[r+2],p0[r+3]);a=max3f(a,p1[r],p1[r+1]);b=max3f(b,p1[r+2],p1[r+3]);}
  const float m=max2f(a,b);
  auto rr=__builtin_amdgcn_permlane32_swap(__float_as_uint(m),__float_as_uint(m),false,false);
  return max2f(__uint_as_float(rr[0]),__uint_as_float(rr[1]));
}
__device__ __forceinline__ void pv(f32x16*o,int vb,bf16x8 pa0,bf16x8 pa1,bf16x8 pa2,bf16x8 pa3){
  #pragma unroll
  for(int d0=0;d0<2;++d0){s16x4 lo[4],hi[4];
    #pragma unroll
    for(int ks=0;ks<4;++ks){
      asm volatile("ds_read_b64_tr_b16 %0,%1 offset:%c2":"=&v"(lo[ks]):"v"(vb),"i"(d0*4096+ks*1024):"memory");
      asm volatile("ds_read_b64_tr_b16 %0,%1 offset:%c2":"=&v"(hi[ks]):"v"(vb),"i"(d0*4096+ks*1024+512):"memory");}
    asm volatile("s_waitcnt lgkmcnt(0)":::"memory");SBAR();
    #define PK(k) (bf16x8){lo[k][0],lo[k][1],lo[k][2],lo[k][3],hi[k][0],hi[k][1],hi[k][2],hi[k][3]}
    o[d0]=__builtin_amdgcn_mfma_f32_32x32x16_bf16(pa0,PK(0),o[d0],0,0,0);
    o[d0]=__builtin_amdgcn_mfma_f32_32x32x16_bf16(pa1,PK(1),o[d0],0,0,0);
    o[d0]=__builtin_amdgcn_mfma_f32_32x32x16_bf16(pa2,PK(2),o[d0],0,0,0);
    o[d0]=__builtin_amdgcn_mfma_f32_32x32x16_bf16(pa3,PK(3),o[d0],0,0,0);
    #undef PK
  }
}

#ifndef ATTN_STORE16
#define ATTN_STORE16(p,v) (*(u32x4*)(p)=(v))
#endif
template<int THRL> __device__ __forceinline__ void attn_unit(int b,int h,int q0,int NT,const bf16*P,const bf16*KC,const bf16*VC,bf16*OB,const float*qnw,const float*rope,char*shm){
  int tid_=threadIdx.x; asm volatile("":"+v"(tid_)); const int tid=tid_,lane=tid&63,r32=lane&31,hi=lane>>5; const int wid=__builtin_amdgcn_readfirstlane(tid>>6);
  const long rowbase=(long)b*LBROWS;
  const bf16*Qw=P+(rowbase+q0+wid*QBLK)*DM+h*D;
  const bf16*Kh=KC+((long)b*(LBROWS/64)*2+(h>>2))*4096,*Vh=VC+((long)b*(LBROWS/64)*2+(h>>2))*4096;
  const unsigned lds0=(unsigned)(uintptr_t)shm;
  float*wsf=(float*)(shm+LDS_WS)+wid*64;
  const bf16*ksrc=Kh+(wid*64+lane)*8;
  const bf16*vsrc=Vh+(wid*64+lane)*8;
  const unsigned kdst=lds0+LDS_K+wid*1024, vdst=lds0+LDS_V+wid*1024;
  #define DMA_K(t,slot) glds16(ksrc+(long)(t)*8192,(unsigned)__builtin_amdgcn_readfirstlane(kdst+(slot)))
  #define DMA_V(t,slot) glds16(vsrc+(long)(t)*8192,(unsigned)__builtin_amdgcn_readfirstlane(vdst+(slot)))
  const int vb0=(int)(lds0+LDS_V)+((lane>>4)&1)*32+(lane&3)*8+(4*hi+((lane&15)>>2))*64;
  const char*Kbase=shm+LDS_K; bf16x8 kf[8];
  const lds_cptr shm3=(lds_cptr)shm; const lds_cptr kp0=shm3+LDS_K+hi*1024+r32*16; const lds_cptr vp0=shm3+LDS_V+((lane>>4)&1)*32+(lane&3)*8+(4*hi+((lane&15)>>2))*64;
  DMA_K(0,0);DMA_V(0,0);DMA_K(1,SLOTB);
  bf16x8 qr[4];
  #pragma unroll
  for(int d0=0;d0<4;++d0)qr[d0]=*reinterpret_cast<const bf16x8*>(&Qw[(long)r32*DM+d0*16+hi*8]);
  {
    float e[4][8]; float ss=0.f;
    #pragma unroll
    for(int d0=0;d0<4;++d0){
      #pragma unroll
      for(int j=0;j<8;++j){ e[d0][j]=__uint_as_float((unsigned)(unsigned short)qr[d0][j]<<16); ss+=e[d0][j]*e[d0][j]; } }
    ss+=__shfl_xor(ss,32);
    const float rs=1.f/sqrtf(ss*(1.f/64.f)+1e-6f);
    #pragma unroll
    for(int d0=0;d0<4;++d0){ const float*wp=qnw+16*d0+8*hi;
      #pragma unroll
      for(int j=0;j<8;++j) e[d0][j]*=rs*wp[j]; }
    if(q0>=256){ const int t=q0-256+wid*QBLK+r32; const float*rr=rope+((t>>6)*16+8*hi)*2,*rc=rope+((t&63)*16+8*hi)*2;
      #pragma unroll
      for(int j=0;j<8;++j){ const float cr=rr[2*j],sr=rr[2*j+1],cc=rc[2*j],sc=rc[2*j+1];
        const float a0=e[0][j],a1=e[1][j],a2=e[2][j],a3=e[3][j];
        e[0][j]=a0*cr-a1*sr; e[1][j]=a1*cr+a0*sr; e[2][j]=a2*cc-a3*sc; e[3][j]=a3*cc+a2*sc; } }
    #pragma unroll
    for(int d0=0;d0<4;++d0){ u32x4 w; w[0]=cvtpk_s(e[d0][0]*C2,e[d0][1]*C2); w[1]=cvtpk_s(e[d0][2]*C2,e[d0][3]*C2); w[2]=cvtpk_s(e[d0][4]*C2,e[d0][5]*C2); w[3]=cvtpk_s(e[d0][6]*C2,e[d0][7]*C2); qr[d0]=__builtin_bit_cast(bf16x8,w); }
  }
  float mhat=0.f,l_reg=0.f;f32x16 o[2];o[0]=f32x16{};o[1]=f32x16{};f32x16 negm=f32x16{};asm volatile("":"+v"(negm));
  const int qrel=wid*QBLK+r32;
  #define CMASK(P0,P1,t) do{}while(0)
  bool resc=false;
  #define START(P0,P1) do{ const float rm=rowmax(P0,P1); resc=false; \
    { const float dl=rm; mhat=fadd_s(mhat,dl); \
      _Pragma("unroll") for(int r=0;r<16;++r){P0[r]=fsub_s(P0[r],dl);P1[r]=fsub_s(P1[r],dl);} \
      _Pragma("unroll") for(int r=0;r<16;++r)negm[r]=-mhat; asm volatile("":"+v"(negm)); } \
    _Pragma("unroll") for(int r=0;r<16;++r)P0[r]=__builtin_amdgcn_exp2f(P0[r]); }while(0)
  #define RESC() do{ if(resc){ asm volatile("s_waitcnt lgkmcnt(0)":::"memory"); \
      _Pragma("unroll") for(int d_=0;d_<2;++d_) _Pragma("unroll") for(int r=0;r<16;++r)o[d_][r]*=wsf[crow(r,hi)]; } }while(0)
  f32x16 pA0,pA1,pB0,pB1;
  int sl_prev=0,sl_cur=0,sl_next=SLOTB;
  #define ROT() do{sl_prev=sl_cur;sl_cur=sl_next;sl_next=(sl_next==(NSLOT-1)*SLOTB)?0:sl_next+SLOTB;}while(0)
  DMA_K(2,2*SLOTB);
  WAIT_BAR(3);
  qkt(pA0,pA1,Kbase,qr,negm,r32,hi);asm volatile("s_nop 15\n\ts_nop 7":"+v"(pA0),"+v"(pA1));CMASK(pA0,pA1,0);
  START(pA0,pA1);
  _Pragma("unroll") for(int r=0;r<16;++r)pA1[r]=__builtin_amdgcn_exp2f(pA1[r]);
  WAIT_BAR(0);
  DMA_K(3,0);DMA_V(1,SLOTB);
  ROT();
  kload8(kf,kp0+sl_cur);
  WAIT_BAR(2);
  s16x4 vlo[8],vhi[8]; u32x4 pw0,pw1,pw2,pw3;
  #define PKW(P,B) cvtpk_s(P[B],P[B+1])
  #define PAF(k) __builtin_bit_cast(bf16x8,pw##k)
  #define VFR(i) (bf16x8){vlo[i][0],vlo[i][1],vlo[i][2],vlo[i][3],vhi[i][0],vhi[i][1],vhi[i][2],vhi[i][3]}
  #define PIN(x) asm volatile("":"+v"(x))
  #define MX3(a,b,c) __builtin_fmaxf(__builtin_fmaxf((a),(b)),(c))
  #define GAPA(MF,A0,A1,A2,A3,W0,W1,PW) do{ MF; sacc+=A0; sacc+=A1; sacc+=A2; sacc+=A3; PIN(sacc); W0; W1; PIN(PW); SBAR(); }while(0)
  #define EX(v) __builtin_amdgcn_exp2f(v)
  #define GAPB(MF,X,B) do{ MF; X[B]=EX(X[B]); X[B+1]=EX(X[B+1]); X[B+2]=EX(X[B+2]); X[B+3]=EX(X[B+3]); PIN(X); SBAR(); }while(0)
  #define VRD(i) do{ vlo[i]=vtr(vp_+(((i)>>2)*4096+((i)&3)*1024)); vhi[i]=vtr(vp_+(((i)>>2)*4096+((i)&3)*1024+512)); }while(0)
  #define KRD(G,j) do{ if(G){ kload2(kf,kp0+sl_next,j); SBAR(); } }while(0)
  #define STEP(C0,C1,P0,P1,t,GK,GV,GL) do{ SBAR(); \
    const lds_cptr vp_=vp0+sl_prev; \
    VRD(0); SBAR(); float sacc=(P0[0]+P0[1]); \
    GAPA(C0=__builtin_amdgcn_mfma_f32_32x32x16_bf16(kf[0],qr[0],negm,0,0,0), P0[2],P0[3],P0[4],P0[5],     pw0[0]=PKW(P0,0), pw0[1]=PKW(P0,2), pw0); \
    VRD(4); SBAR(); GAPA(C1=__builtin_amdgcn_mfma_f32_32x32x16_bf16(kf[1],qr[0],negm,0,0,0), P0[6],P0[7],P0[8],P0[9],     pw0[2]=PKW(P0,4), pw0[3]=PKW(P0,6), pw0); \
    VRD(1); SBAR(); GAPA(C0=__builtin_amdgcn_mfma_f32_32x32x16_bf16(kf[2],qr[1],C0,0,0,0),   P0[10],P0[11],P0[12],P0[13], pw1[0]=PKW(P0,8), pw1[1]=PKW(P0,10), pw1); \
    VRD(5); SBAR(); GAPA(C1=__builtin_amdgcn_mfma_f32_32x32x16_bf16(kf[3],qr[1],C1,0,0,0),   P0[14],P0[15],P1[0],P1[1],   pw1[2]=PKW(P0,12),pw1[3]=PKW(P0,14), pw1); \
    VRD(2); SBAR(); GAPA(C0=__builtin_amdgcn_mfma_f32_32x32x16_bf16(kf[4],qr[2],C0,0,0,0),   P1[2],P1[3],P1[4],P1[5],     pw2[0]=PKW(P1,0), pw2[1]=PKW(P1,2), pw2); \
    VRD(6); SBAR(); GAPA(C1=__builtin_amdgcn_mfma_f32_32x32x16_bf16(kf[5],qr[2],C1,0,0,0),   P1[6],P1[7],P1[8],P1[9],     pw2[2]=PKW(P1,4), pw2[3]=PKW(P1,6), pw2); \
    VRD(3); SBAR(); GAPA(C0=__builtin_amdgcn_mfma_f32_32x32x16_bf16(kf[6],qr[3],C0,0,0,0),   P1[10],P1[11],P1[12],P1[13], pw3[0]=PKW(P1,8), pw3[1]=PKW(P1,10), pw3); \
    VRD(7); SBAR(); GAPA(C1=__builtin_amdgcn_mfma_f32_32x32x16_bf16(kf[7],qr[3],C1,0,0,0),   P1[14],P1[15],0.f,0.f,       pw3[2]=PKW(P1,12),pw3[3]=PKW(P1,14), pw3); \
    l_reg+=sacc; \
    if(GK){DMA_K((t)+3,sl_cur);} if(GV){DMA_V((t)+1,sl_next);} \
    CMASK(C0,C1,t); \
    { float a=MX3(C0[0],C0[1],C1[0]),b=MX3(C0[2],C0[3],C1[1]); a=MX3(a,C1[2],C1[3]); \
      _Pragma("unroll") for(int r=4;r<16;r+=4){a=MX3(a,C0[r],C0[r+1]);b=MX3(b,C0[r+2],C0[r+3]);a=MX3(a,C1[r],C1[r+1]);b=MX3(b,C1[r+2],C1[r+3]);} \
      float rm=__builtin_fmaxf(a,b); { auto rr=__builtin_amdgcn_permlane32_swap(__float_as_uint(rm),__float_as_uint(rm),false,false); rm=__builtin_fmaxf(__uint_as_float(rr[0]),__uint_as_float(rr[1])); } \
      resc=false; \
      if(__builtin_expect(__any(rm>(float)THRL),0)){ const float dl=__builtin_fmaxf(rm,0.f); mhat+=dl; \
        _Pragma("unroll") for(int r=0;r<16;++r){C0[r]-=dl;C1[r]-=dl;} \
        _Pragma("unroll") for(int r=0;r<16;++r)negm[r]=-mhat; asm volatile("":"+v"(negm)); \
        const float f=__builtin_amdgcn_exp2f(-dl); l_reg*=f; if(hi==0)wsf[r32]=f; resc=true; } } \
    SBAR(); \
    GAPB(o[0]=__builtin_amdgcn_mfma_f32_32x32x16_bf16(PAF(0),VFR(0),o[0],0,0,0), C0,0); \
    GAPB(o[1]=__builtin_amdgcn_mfma_f32_32x32x16_bf16(PAF(0),VFR(4),o[1],0,0,0), C0,4); \
    KRD(GL,0); GAPB(o[0]=__builtin_amdgcn_mfma_f32_32x32x16_bf16(PAF(1),VFR(1),o[0],0,0,0), C0,8); \
    KRD(GL,1); GAPB(o[1]=__builtin_amdgcn_mfma_f32_32x32x16_bf16(PAF(1),VFR(5),o[1],0,0,0), C0,12); \
    KRD(GL,2); GAPB(o[0]=__builtin_amdgcn_mfma_f32_32x32x16_bf16(PAF(2),VFR(2),o[0],0,0,0), C1,0); \
    KRD(GL,3); GAPB(o[1]=__builtin_amdgcn_mfma_f32_32x32x16_bf16(PAF(2),VFR(6),o[1],0,0,0), C1,4); \
    GAPB(o[0]=__builtin_amdgcn_mfma_f32_32x32x16_bf16(PAF(3),VFR(3),o[0],0,0,0), C1,8); \
    GAPB(o[1]=__builtin_amdgcn_mfma_f32_32x32x16_bf16(PAF(3),VFR(7),o[1],0,0,0), C1,12); \
    }while(0)
  int t=1;
  #undef CMASK
  #define CMASK(P0,P1,t) do{}while(0)
  for(;t+5<NT;t+=2){
    STEP(pB0,pB1,pA0,pA1,t,true,true,true);     WAIT_BAR(2); RESC(); ROT();
    STEP(pA0,pA1,pB0,pB1,t+1,true,true,true);   WAIT_BAR(2); RESC(); ROT();
  }
  #undef CMASK
  #define CMASK(P0,P1,t) do{}while(0)
  #define ENDW(tt) do{ if((tt)+3<NT){WAIT_BAR(2);} else if((tt)+2<NT){WAIT_BAR(1);} else {WAIT_BAR(0);} }while(0)
  for(;t+1<NT;t+=2){
    STEP(pB0,pB1,pA0,pA1,t,(t+3<NT),(t+1<NT),(t+1<NT));       ENDW(t);   RESC(); ROT();
    STEP(pA0,pA1,pB0,pB1,t+1,(t+4<NT),(t+2<NT),(t+2<NT));     ENDW(t+1); RESC(); ROT();
  }
  STEP(pB0,pB1,pA0,pA1,NT-1,false,false,false); RESC();
  { float sacc=pB0[0]+pB0[1]; _Pragma("unroll") for(int r=2;r<16;++r)sacc+=pB0[r]; _Pragma("unroll") for(int r=0;r<16;++r)sacc+=pB1[r]; l_reg+=sacc;
    pw0=(u32x4){PKW(pB0,0),PKW(pB0,2),PKW(pB0,4),PKW(pB0,6)};pw1=(u32x4){PKW(pB0,8),PKW(pB0,10),PKW(pB0,12),PKW(pB0,14)};pw2=(u32x4){PKW(pB1,0),PKW(pB1,2),PKW(pB1,4),PKW(pB1,6)};pw3=(u32x4){PKW(pB1,8),PKW(pB1,10),PKW(pB1,12),PKW(pB1,14)};
    SBAR(); pv(o,vb0+sl_cur,PAF(0),PAF(1),PAF(2),PAF(3)); }
  #undef PKW
  #undef PAF
  #undef VFR
  #undef PIN
  #undef MX3
  #undef GAPA
  #undef GAPB
  #undef EX
  #undef VRD
  #undef KRD
  #undef STEP
  #undef ENDW
  {auto rr=__builtin_amdgcn_permlane32_swap(__float_as_uint(l_reg),__float_as_uint(l_reg),false,false);l_reg=__uint_as_float(rr[0])+__uint_as_float(rr[1]);}
  if(hi==0)wsf[32+r32]=l_reg;asm volatile("s_waitcnt lgkmcnt(0)":::"memory");
  float rli[16];
  #pragma unroll
  for(int r=0;r<16;++r)rli[r]=__builtin_amdgcn_rcpf(wsf[32+crow(r,hi)]);
  bf16*Ow=OB+(rowbase+q0+wid*QBLK)*512+h*D;
  { bf16*stg=(bf16*)(shm+LDS_OST)+wid*2048;
    #pragma unroll
    for(int r=0;r<16;++r){const int orow=crow(r,hi);
      #pragma unroll
      for(int d0=0;d0<2;++d0)stg[orow*64+d0*32+r32]=__float2bfloat16(o[d0][r]*rli[r]);}
    asm volatile("s_waitcnt lgkmcnt(0)":::"memory");
    #pragma unroll
    for(int i=0;i<4;++i){const int row=i*8+(lane>>3),ch=lane&7; const u32x4 v=*(const u32x4*)(stg+row*64+ch*8); ATTN_STORE16(Ow+(long)row*512+ch*8,v);} }
  asm volatile("s_waitcnt lgkmcnt(0)\n\ts_barrier":::"memory");
  #undef DMA_K
  #undef DMA_V
  #undef CMASK
  #undef START
  #undef RESC
  #undef ROT
}
constexpr int ATTN_LDS_BYTES=LDS_BYTES;
#undef SBAR
#undef WAIT_BAR
}
constexpr int NWAVES = 8;
#ifndef MK_PER_PHASE
#define MK_PER_PHASE 0
#endif
constexpr int NB = 8, NX = 4096, NCX = 256, LB = NX + NCX, R = NB * LB, DMODEL = 1024, NPROJ = 2048, NIN = 2056;
constexpr int QCOL = 0, KCOL = 512, VCOL = 640, XBCCOL = 768, ZCOL = 1280, UCOL = 1536, GCOL = 1792;
constexpr int NE = 16, FF = 2048, EROWS = 4352, RGROWS = NE * EROWS;
constexpr int NCH = 68;
constexpr float LN_EPS = 1e-6f, ALPHA = 1.41421356237309515f;
constexpr size_t MiB = 1u << 20;
constexpr size_t WS_CTL = 0, CTL_ZERO_BYTES = 128 * 1024;
constexpr size_t WS_MODP = 1 * MiB, WS_MOD = 5 * MiB, WS_ROPE = 6 * MiB, WS_DT = 7 * MiB, WS_AFF = 9 * MiB, WS_INV = 12 * MiB, WS_SRC = 15 * MiB, WS_GATE = 16 * MiB, WS_TOT = 17 * MiB,
                 WS_RGS = 18 * MiB, WS_RGC = 21 * MiB, WS_RGW = 23 * MiB, WS_WIN = 24 * MiB, WS_WOUT = 32 * MiB, WS_WGU = 36 * MiB, WS_WD = 164 * MiB, WS_XRES = 228 * MiB, WS_XRES2 = 296 * MiB  ,
                 WS_YPRE = 364 * MiB  , WS_HA = 500 * MiB, WS_PROJ = 568 * MiB, WS_MERGED = 704 * MiB,
                 WS_S = 772 * MiB, WS_HIN = 840 * MiB  , WS_KC = 876 * MiB, WS_VC = 886 * MiB  , WS_OB = 896 * MiB  , WS_HID = 568 * MiB  , WS_RGL = 932 * MiB  , WS_END = 1000 * MiB;
constexpr int CW_TMO = 0, CW_BAR = 4096, CW_QUEUE = 8192;
constexpr int RING_OFF = 0, LDSCTL_OFF = 147456  , MISC_OFF = LDSCTL_OFF + 320, LDS_BYTES = 151552;
constexpr int PH_PRO0 = 0, PH_PRO2 = 1, PH_L0 = 2, PH_PER_LAYER = 11, N_PHASES = PH_L0 + 2 * PH_PER_LAYER;
constexpr int PL_INPROJ = 0, PL_QKPOST = 1, PL_MIX1 = 2, PL_CARRY = 3, PL_MIX3 = 4, PL_OUTPROJ = 5, PL_LN1 = 6, PL_TOPK = 7, PL_GEMM1 = 8, PL_GEMM2 = 9, PL_LN2 = 10;

#define GAS __attribute__((address_space(1)))
#define LAS __attribute__((address_space(3)))
typedef unsigned short bf16;
typedef unsigned v4u __attribute__((ext_vector_type(4)));
typedef unsigned v2u __attribute__((ext_vector_type(2)));
typedef _Float16 f16x4 __attribute__((ext_vector_type(4)));
typedef float f32x2_t __attribute__((ext_vector_type(2)));
typedef float f32x4 __attribute__((ext_vector_type(4)));
__device__ __forceinline__ f32x4 h4f(f16x4 h) { return __builtin_convertvector(h, f32x4); }
__device__ __forceinline__ f16x4 f4h(f32x4 v) { return __builtin_convertvector(v, f16x4); }
typedef short bf16x8 __attribute__((ext_vector_type(8)));
typedef GAS unsigned gu32;
#define RLX_AGENT __ATOMIC_RELAXED, __HIP_MEMORY_SCOPE_AGENT
#define LDS_WAIT() asm volatile("s_waitcnt lgkmcnt(0)" ::: "memory")
__device__ __forceinline__ float bf2f(unsigned u) { return __uint_as_float(u << 16); }
__device__ __forceinline__ unsigned pk2(float lo, float hi) { unsigned r; asm("v_cvt_pk_bf16_f32 %0, %1, %2" : "=v"(r) : "v"(lo), "v"(hi)); return r; }
__device__ __forceinline__ unsigned f2bf(float f) { return pk2(f, f) & 0xffffu; }
__device__ __forceinline__ float rcp_f(float x) { return __builtin_amdgcn_rcpf(x); }
__device__ __forceinline__ float exp_f(float x) { return __builtin_amdgcn_exp2f(x * 1.4426950408889634f); }
__device__ __forceinline__ float sigmoid_f(float x) { return rcp_f(1.f + exp_f(-x)); }
__device__ __forceinline__ float silu_ff(float x) { return x * rcp_f(1.f + exp_f(-x)); }
__device__ __forceinline__ float softplus_f(float x) { return x > 20.f ? x : log1pf(__expf(x)); }
__device__ __forceinline__ float gelu_tanh_f(float x) { const float u = 0.7978845608028654f * (x + 0.044715f * x * x * x); return x * rcp_f(1.f + exp_f(-2.f * u)); }
__device__ __forceinline__ float wave_sum(float v) {
#pragma unroll
    for (int o = 1; o < 64; o <<= 1) v += __shfl_xor(v, o);
    return v;
}
__device__ __forceinline__ void unpack8(const v4u p, float (&f)[8]) { f[0] = bf2f(p.x & 0xffffu); f[1] = bf2f(p.x >> 16); f[2] = bf2f(p.y & 0xffffu); f[3] = bf2f(p.y >> 16); f[4] = bf2f(p.z & 0xffffu); f[5] = bf2f(p.z >> 16); f[6] = bf2f(p.w & 0xffffu); f[7] = bf2f(p.w >> 16); }
__device__ __forceinline__ float reduce8(const float (&v)[8], int lane) {
    float a[4], b[2], c;
    { const bool hi = lane & 32;
#pragma unroll
      for (int i = 0; i < 4; ++i) { const float send = hi ? v[i] : v[i + 4], keep = hi ? v[i + 4] : v[i]; a[i] = keep + __shfl_xor(send, 32); } }
    { const bool hi = lane & 16;
#pragma unroll
      for (int i = 0; i < 2; ++i) { const float send = hi ? a[i] : a[i + 2], keep = hi ? a[i + 2] : a[i]; b[i] = keep + __shfl_xor(send, 16); } }
    { const bool hi = lane & 8; const float send = hi ? b[0] : b[1], keep = hi ? b[1] : b[0]; c = keep + __shfl_xor(send, 8); }
    c += __shfl_xor(c, 4); c += __shfl_xor(c, 2); c += __shfl_xor(c, 1);
    return c;
}
__device__ __forceinline__ float reduce16(const float (&v)[16], int lane) {
    float a[8], b[4], c[2], d;
    { const bool hi = lane & 32;
#pragma unroll
      for (int i = 0; i < 8; ++i) { const float send = hi ? v[i] : v[i + 8], keep = hi ? v[i + 8] : v[i]; a[i] = keep + __shfl_xor(send, 32); } }
    { const bool hi = lane & 16;
#pragma unroll
      for (int i = 0; i < 4; ++i) { const float send = hi ? a[i] : a[i + 4], keep = hi ? a[i + 4] : a[i]; b[i] = keep + __shfl_xor(send, 16); } }
    { const bool hi = lane & 8;
#pragma unroll
      for (int i = 0; i < 2; ++i) { const float send = hi ? b[i] : b[i + 2], keep = hi ? b[i + 2] : b[i]; c[i] = keep + __shfl_xor(send, 8); } }
    { const bool hi = lane & 4; const float send = hi ? c[0] : c[1], keep = hi ? c[1] : c[0]; d = keep + __shfl_xor(send, 4); }
    d += __shfl_xor(d, 2); d += __shfl_xor(d, 1);
    return d;
}
__device__ __forceinline__ f32x4 mfma16(bf16x8 a, bf16x8 b, f32x4 c) { return __builtin_amdgcn_mfma_f32_16x16x32_bf16(a, b, c, 0, 0, 0); }
__device__ __forceinline__ bf16x8 lds_frag(const LAS bf16* T, int ld, int row0, int k0, int lane) { return *(const LAS bf16x8*)(T + (row0 + (lane & 15)) * ld + k0 + 8 * (lane >> 4)); }

#define XB_TMO      128
#define XB_XCNT(j)  (256  + 64 * (j))
#define XB_XSUB(j)  (1280 + 64 * (j))
#define XB_XGEN(j)  (2304 + 64 * (j))
#define XB_TOP      3328
#define XB_TOPGEN   3392
#define XCD_BAR_WORDS 3456
#define XB_SPIN_CAP (1u << 18)

__device__ __forceinline__ unsigned xb_ld(unsigned* p)              { return __hip_atomic_load(p, __ATOMIC_RELAXED, __HIP_MEMORY_SCOPE_AGENT); }
__device__ __forceinline__ unsigned xb_add(unsigned* p, unsigned v) { return __hip_atomic_fetch_add(p, v, __ATOMIC_RELAXED, __HIP_MEMORY_SCOPE_AGENT); }
__device__ __forceinline__ unsigned xb_xcc_id() { return (unsigned)__builtin_amdgcn_s_getreg((3 << 11) | 20) & 0xFu; }
#define XB_SPIN(cond, bar) do { unsigned _sp = 0; while (cond) { __builtin_amdgcn_s_sleep(1); \
    if ((++_sp & 255u) == 0u) { if (xb_ld(&(bar)[XB_TMO])) break; if (_sp > XB_SPIN_CAP) { atomicAdd(&(bar)[XB_TMO], 1u); break; } } } } while (0)

struct XcdBarrier {
    unsigned* bar; unsigned x;
    volatile LAS unsigned* st;
};

__device__ __forceinline__ XcdBarrier xcd_barrier_post(unsigned* bar, volatile LAS unsigned* st) {
    XcdBarrier b; b.bar = bar; b.x = xb_xcc_id(); b.st = st;
    if (threadIdx.x == 0) (void)xb_add(&bar[XB_XCNT(b.x)], 1u);
    return b;
}
__device__ __forceinline__ void xcd_barrier_complete(unsigned* bar, unsigned x, unsigned& nloc, unsigned& nx) {
    const unsigned G = gridDim.x * gridDim.y * gridDim.z;
    unsigned sum, cnt, mine, sp = 0u;
    for (;;) {
        sum = 0u; cnt = 0u; mine = 0u;
#pragma unroll
        for (unsigned j = 0; j < 16; ++j) { const unsigned c = xb_ld(&bar[XB_XCNT(j)]); sum += c; cnt += (c > 0u) ? 1u : 0u; mine = (j == x) ? c : mine; }
        if (sum == G) break;
        __builtin_amdgcn_s_sleep(1);
        if ((++sp & 255u) == 0u) { if (xb_ld(&bar[XB_TMO])) break; if (sp > XB_SPIN_CAP) { atomicAdd(&bar[XB_TMO], 1u); break; } }
    }
    nloc = mine > 0u ? mine : 1u; nx = cnt > 0u ? cnt : 1u;
}

__device__ __forceinline__ void xcd_barrier(const XcdBarrier& b) {
    asm volatile("s_waitcnt vmcnt(0)" ::: "memory");
    __syncthreads();
    if (threadIdx.x == 0) {
        unsigned* bar = b.bar;
        __builtin_amdgcn_s_waitcnt(0);
        unsigned nloc = b.st[0], nx = b.st[1];
        if (nloc == 0u) { xcd_barrier_complete(bar, b.x, nloc, nx); b.st[0] = nloc; b.st[1] = nx; }
        const unsigned old = xb_add(&bar[XB_XSUB(b.x)], 1u);
        const unsigned gen = old / nloc;
        if (old + 1u == (gen + 1u) * nloc) {
            __builtin_amdgcn_fence(__ATOMIC_RELEASE, "agent");
            asm volatile("s_waitcnt vmcnt(0)" ::: "memory");
            const unsigned og = xb_add(&bar[XB_TOP], 1u);
            const unsigned tg = og / nx;
            if (og + 1u == (tg + 1u) * nx) xb_add(&bar[XB_TOPGEN], 1u);
            else XB_SPIN(xb_ld(&bar[XB_TOPGEN]) == tg, bar);
            __builtin_amdgcn_fence(__ATOMIC_ACQUIRE, "agent");
            xb_add(&bar[XB_XGEN(b.x)], 1u);
            asm volatile("s_waitcnt vmcnt(0)" ::: "memory");
        } else {
            XB_SPIN(xb_ld(&bar[XB_XGEN(b.x)]) == gen, bar);
            __builtin_amdgcn_fence(__ATOMIC_ACQUIRE, "agent");
            asm volatile("s_waitcnt vmcnt(0)" ::: "memory");
        }
    }
    __syncthreads();
}

struct Frame { LAS unsigned char* lds; volatile LAS unsigned* MISC; int tid, lane, wave, vcu, G; };
struct Args { const float* in[33]; float* out; unsigned char* ws; int ph_lo, ph_hi; };
typedef const __attribute__((address_space(4))) Args& ArgsR;
#define PHASE_FN __device__ __forceinline__
__device__ __forceinline__ void make_frame(Frame& F, LAS unsigned char* lds);
enum { I_X = 0, I_C, I_CTX, I_CCTX, I_WMOD, I_BMOD, I_WIN, I_QNORM, I_KNORM, I_AONORM, I_SCONVW, I_SCONVB, I_SDTB, I_SALOG, I_SD, I_SNORM, I_RCONVW, I_RCONVB, I_RWA, I_RBA, I_RWX, I_RBX, I_RLAM, I_RONORM,
       I_WOUT, I_LN1W, I_LN1B, I_WROUTER, I_WGATE, I_WUP, I_WDOWN, I_LN2W, I_LN2B };
#define WSP(T, off) ((T*)(A.ws + (off)))

template <int MODE> __device__ __forceinline__ void transpose_item(const float* W, int K, int Nsrc, int kb, int ncol0, bf16* WT, int drow0, LAS float* scr, int lane) {
    const int k0 = 64 * kb;
    { f32x4 v[8]; const int kr = lane >> 3, nq = 4 * (lane & 7);
#pragma unroll
      for (int i = 0; i < 8; ++i) v[i] = __builtin_nontemporal_load((const f32x4*)(W + (size_t)(k0 + 8 * i + kr) * Nsrc + ncol0 + nq));
#pragma unroll
      for (int i = 0; i < 8; ++i) { LAS float* d = scr + (8 * i + kr) * 33 + nq; d[0] = v[i][0]; d[1] = v[i][1]; d[2] = v[i][2]; d[3] = v[i][3]; } }
    LDS_WAIT(); asm volatile("" ::: "memory");
    const int c = lane & 7;
#pragma unroll
    for (int j = 0; j < 4; ++j) { const int n = (lane >> 3) + 8 * j; const LAS float* s = scr + (8 * c) * 33 + n;
        const int row = MODE == 0 ? drow0 + n : drow0 + 128 * ((n >> 2) & 1) + 4 * (n >> 3) + (n & 3);
        v4u o; o.x = pk2(s[0 * 33], s[1 * 33]); o.y = pk2(s[2 * 33], s[3 * 33]); o.z = pk2(s[4 * 33], s[5 * 33]); o.w = pk2(s[6 * 33], s[7 * 33]);
        *(v4u*)(WT + (size_t)row * K + k0 + 8 * c) = o; }
    LDS_WAIT(); asm volatile("" ::: "memory");
}
__device__ __forceinline__ void convert_item(Frame& F, ArgsR A, int l, int it, LAS float* scr) {
    bf16* WGU = WSP(bf16, WS_WGU); bf16* WD = WSP(bf16, WS_WD);
    if (it < 32768) { const int up = it >> 14, id = it & 16383, e = id >> 10, rem = id & 1023, kb = rem >> 6, nb = rem & 63;
        const float* W = A.in[up ? I_WUP : I_WGATE] + (size_t)(l * 16 + e) * 1024 * 2048;
        transpose_item<1>(W, 1024, 2048, kb, 32 * nb, WGU + (size_t)e * 4096 * 1024, 256 * (nb >> 2) + 32 * (nb & 3) + 16 * up, scr, F.lane);
    } else { const int id = it - 32768, e = id >> 10, rem = id & 1023, kb = rem >> 5, nb = rem & 31;
        const float* W = A.in[I_WDOWN] + (size_t)(l * 16 + e) * 2048 * 1024;
        transpose_item<0>(W, 2048, 1024, kb, 32 * nb, WD + (size_t)e * 1024 * 2048, 32 * nb, scr, F.lane); }
}
__device__ __forceinline__ void conv_rounds(Frame& F, ArgsR A, int l, int quota, int limit) {
    gu32* cctr = (gu32*)(A.ws + WS_CTL) + 12288 + 64 * l; LAS float* scr = (LAS float*)(F.lds + RING_OFF + F.wave * 16384);
    for (int r = 0; r < quota; ++r) { __syncthreads(); if (F.tid == 0) F.MISC[1] = __hip_atomic_fetch_add(cctr, 8u, RLX_AGENT); __syncthreads();
        const int base = (int)F.MISC[1]; if (base >= limit) break; convert_item(F, A, l, base + F.wave, scr); }
}
__device__ __forceinline__ void p_pro0(Frame& F, ArgsR A) {
    LAS float* scr = (LAS float*)(F.lds + RING_OFF + F.wave * 16384);
    const int gw = F.vcu * NWAVES + F.wave, NGW = F.G * NWAVES;
    { const int gt = gw * 64 + F.lane; if (gt < 1024) { const int pos = gt >> 4, i = gt & 15; const float inv = powf(10000.0f, -(float)i / 16.0f); const float ang = (float)pos * inv;
        float* T = WSP(float, WS_ROPE); T[2 * gt] = cosf(ang); T[2 * gt + 1] = sinf(ang); } }
    for (int it = NGW - 1 - gw; it < 384; it += NGW) { const int l = it / 192, rem = it % 192, cb = rem >> 3, ks = rem & 7, col = cb * 256 + 4 * F.lane;
#pragma unroll
        for (int h = 0; h < 2; ++h) { const int kk = F.lane + 64 * h, k = ks * 128 + kk;
#pragma unroll
            for (int r = 0; r < 9; ++r) scr[kk * 12 + r] = silu_ff(r < 8 ? A.in[I_C][r * 1024 + k] : A.in[I_CCTX][k]); }
        LDS_WAIT(); asm volatile("" ::: "memory");
        f32x4 acc[9];
#pragma unroll
        for (int r = 0; r < 9; ++r) acc[r] = (f32x4){0.f, 0.f, 0.f, 0.f};
        const float* Wm = A.in[I_WMOD] + (size_t)l * 1024 * 6144 + col + (size_t)(ks * 128) * 6144;
        for (int k0 = 0; k0 < 128; k0 += 8) { f32x4 w4[8];
#pragma unroll
            for (int u = 0; u < 8; ++u) w4[u] = *(const f32x4*)(Wm + (size_t)(k0 + u) * 6144);
#pragma unroll
            for (int u = 0; u < 8; ++u) { const f32x4 s0 = *(const LAS f32x4*)(scr + (k0 + u) * 12), s1 = *(const LAS f32x4*)(scr + (k0 + u) * 12 + 4); const float s8 = scr[(k0 + u) * 12 + 8];
                acc[0] += w4[u] * s0[0]; acc[1] += w4[u] * s0[1]; acc[2] += w4[u] * s0[2]; acc[3] += w4[u] * s0[3]; acc[4] += w4[u] * s1[0]; acc[5] += w4[u] * s1[1]; acc[6] += w4[u] * s1[2]; acc[7] += w4[u] * s1[3]; acc[8] += w4[u] * s8; } }
        float* MP = WSP(float, WS_MODP) + (size_t)((ks * 2 + l) * 9) * 6144 + col;
#pragma unroll
        for (int r = 0; r < 9; ++r) *(f32x4*)(MP + (size_t)r * 6144) = acc[r];
        LDS_WAIT(); asm volatile("" ::: "memory"); }
    for (int it = gw; it < 2 * (1024 + 512 + 32); it += NGW) { const int l = it / 1568; int id = it % 1568;
        if (id < 1024) { const int kb = id >> 6, nb = id & 63; transpose_item<0>(A.in[I_WIN] + (size_t)l * 1024 * NIN, 1024, NIN, kb, 32 * nb + (32 * nb >= 1536 ? 8 : 0), WSP(bf16, WS_WIN) + (size_t)l * 2048 * 1024, 32 * nb, scr, F.lane); continue; }
        id -= 1024;
        if (id < 512) { const int kb = id >> 5, nb = id & 31; transpose_item<0>(A.in[I_WOUT] + (size_t)l * 1024 * 1024, 1024, 1024, kb, 32 * nb, WSP(bf16, WS_WOUT) + (size_t)l * 1024 * 1024, 32 * nb, scr, F.lane); continue; }
        id -= 512;
        { const int ty = id >> 4, d = (id >> 3) & 1, blk = (id >> 1) & 3, nb = id & 1;
          transpose_item<0>(A.in[ty ? I_RWX : I_RWA] + (size_t)((l * 2 + d) * 4 + blk) * 4096, 64, 64, 0, 32 * nb, WSP(bf16, WS_RGW) + (size_t)(((l * 2 + ty) * 2 + d) * 4 + blk) * 4096, 32 * nb, scr, F.lane); }
    }
}
__device__ __forceinline__ void stage_wdt(Frame& F, ArgsR A, int L, LAS float* wdt) {
    for (int idx = F.tid; idx < 8192; idx += NWAVES * 64) wdt[(idx & 7) * 1024 + (idx >> 3)] = A.in[I_WIN][((size_t)L * 1024 + (idx >> 3)) * NIN + 1536 + (idx & 7)];
}
template <int NV> __device__ __forceinline__ void stage_mod(Frame& F, ArgsR A, int L, int b0, int sec0, LAS float* dst) {
    const float* M = WSP(float, WS_MOD) + (size_t)L * 9 * 6144;
    for (int idx = F.tid; idx < 3 * NV * 1024; idx += NWAVES * 64) { const int slot = idx / (NV * 1024), rem = idx % (NV * 1024); const int mrow = slot == 0 ? 8 : (b0 + slot - 1 < NB ? b0 + slot - 1 : NB - 1);
        dst[idx] = M[(size_t)mrow * 6144 + sec0 * 1024 + rem]; }
}
__device__ __forceinline__ void emit_row(Frame& F, ArgsR A, int r, const f32x4 (&v)[4], const LAS float* wdt, const LAS float* msh, const LAS float* msc) {
    bf16* ha = WSP(bf16, WS_HA) + (size_t)r * 1024;
    float dd[8];
#pragma unroll
    for (int i = 0; i < 8; ++i) dd[i] = 0.f;
#pragma unroll
    for (int j = 0; j < 4; ++j) { const int k = 256 * j + 4 * F.lane;
        const f32x4 sh = *(const LAS f32x4*)(msh + k), sc = *(const LAS f32x4*)(msc + k); const f32x4 h = v[j] * (sc + 1.0f) + sh;
        v2u o; o.x = pk2(h[0], h[1]); o.y = pk2(h[2], h[3]); *(v2u*)(ha + k) = o;
#pragma unroll
        for (int i = 0; i < 8; ++i) { const f32x4 wv = *(const LAS f32x4*)(wdt + i * 1024 + k); dd[i] += (wv[0] * h[0] + wv[1] * h[1]) + (wv[2] * h[2] + wv[3] * h[3]); }
        __builtin_amdgcn_sched_barrier(0); }
    const float dsum = reduce8(dd, F.lane);
    if ((F.lane & 7) == 0) WSP(float, WS_DT)[(size_t)r * 8 + ((F.lane >> 5) & 1) * 4 + ((F.lane >> 4) & 1) * 2 + ((F.lane >> 3) & 1)] = dsum;
}
#define SRCROW(rr) (((rr) % LB) < NCX ? A.in[I_CTX] + (size_t)(((rr) / LB) * NCX + (rr) % LB) * 1024 : A.in[I_X] + (size_t)(((rr) / LB) * NX + (rr) % LB - NCX) * 1024)
__device__ __forceinline__ void p_pro2(Frame& F, ArgsR A) {
    LAS float* wdt = (LAS float*)(F.lds + RING_OFF); LAS float* mod = wdt + 8192;
    const int rpb = (R + F.G - 1) / F.G, rbeg = blockIdx.x * rpb, rend = rbeg + rpb < R ? rbeg + rpb : R, b0 = rbeg / LB;
    __syncthreads(); stage_wdt(F, A, 0, wdt);
    {
      const float* MP = WSP(float, WS_MODP); float* MOD = WSP(float, WS_MOD);
      for (int idx = blockIdx.x * (NWAVES * 64) + F.tid; idx < 2 * 9 * 6144; idx += F.G * NWAVES * 64) { const int l = idx / (9 * 6144), col = idx % 6144; float s = A.in[I_BMOD][l * 6144 + col];
#pragma unroll
          for (int ks = 0; ks < 8; ++ks) s += MP[(size_t)ks * (2 * 9 * 6144) + idx];
          MOD[idx] = s; }
      for (int idx = F.tid; idx < 3 * 2048; idx += NWAVES * 64) { const int slot = idx / 2048, rem = idx % 2048; const int mrow = slot == 0 ? 8 : (b0 + slot - 1 < NB ? b0 + slot - 1 : NB - 1); const int src = mrow * 6144 + rem;
          float s = A.in[I_BMOD][rem];
#pragma unroll
          for (int ks = 0; ks < 8; ++ks) s += MP[(size_t)ks * (2 * 9 * 6144) + src];
          mod[idx] = s; } }
    __syncthreads();
    const int rfirst = rbeg + F.wave;
    f32x4 vn[3][4];
#pragma unroll
    for (int p = 0; p < 3; ++p) { const int rp = rfirst + 8 * p < rend ? rfirst + 8 * p : rbeg; const float* src = SRCROW(rp);
#pragma unroll
        for (int j = 0; j < 4; ++j) vn[p][j] = *(const f32x4*)(src + 256 * j + 4 * F.lane); }
    for (int r = rfirst; r < rend; r += 8) {
        f32x4 v[4];
        { const int rp = r + 24 < rend ? r + 24 : rbeg; const float* src = SRCROW(rp);
#pragma unroll
          for (int j = 0; j < 4; ++j) { v[j] = vn[0][j]; vn[0][j] = vn[1][j]; vn[1][j] = vn[2][j]; vn[2][j] = *(const f32x4*)(src + 256 * j + 4 * F.lane); } }
        _Float16* xr = WSP(_Float16, WS_XRES) + (size_t)r * 1024;
#pragma unroll
        for (int j = 0; j < 4; ++j) *(f16x4*)(xr + 256 * j + 4 * F.lane) = f4h(v[j]);
        const int slot = (r % LB) < NCX ? 0 : 1 + r / LB - b0;
        emit_row(F, A, r, v, wdt, mod + slot * 2048, mod + slot * 2048 + 1024); }
}
__device__ __forceinline__ void ln_row(f32x4 (&v)[4], const LAS float* lnw, int lane) {
    float s = 0.f;
#pragma unroll
    for (int j = 0; j < 4; ++j) s += (v[j][0] + v[j][1]) + (v[j][2] + v[j][3]);
    const float mean = wave_sum(s) * (1.f / 1024.f); float s2 = 0.f;
#pragma unroll
    for (int j = 0; j < 4; ++j) { v[j] = v[j] - mean; s2 += (v[j][0] * v[j][0] + v[j][1] * v[j][1]) + (v[j][2] * v[j][2] + v[j][3] * v[j][3]); }
    const float rstd = 1.f / sqrtf(wave_sum(s2) * (1.f / 1024.f) + LN_EPS);
#pragma unroll
    for (int j = 0; j < 4; ++j) v[j] = v[j] * rstd * *(const LAS f32x4*)(lnw + 256 * j + 4 * lane) + *(const LAS f32x4*)(lnw + 1024 + 256 * j + 4 * lane);
}
__device__ __forceinline__ void p_ln1(Frame& F, ArgsR A, int L) {
    constexpr int LDA = 1032;
    LAS bf16* Ahi = (LAS bf16*)(F.lds + RING_OFF);
    LAS bf16* Alo = Ahi + 16 * LDA;
    LAS float* red = (LAS float*)(Alo + 16 * LDA);
    LAS float* lnw = red + 2048;
    LAS float* mod = lnw + 2048;
    const bool xonly = (L == 1); const int nrows = xonly ? NB * NX : R;
#define ROWOF1(qq) (xonly ? ((qq) / NX) * LB + NCX + (qq) % NX : (qq))
    const int rpb = (nrows + F.G - 1) / F.G, rbeg = blockIdx.x * rpb, rend = rbeg + rpb < nrows ? rbeg + rpb : nrows, b0 = ROWOF1(rbeg < nrows ? rbeg : 0) / LB;
    const int lane = F.lane, w = F.wave, q = lane >> 4, c16 = lane & 15;
    __syncthreads();
    for (int idx = F.tid; idx < 2048; idx += NWAVES * 64) lnw[idx] = idx < 1024 ? A.in[I_LN1W][L * 1024 + idx] : A.in[I_LN1B][L * 1024 + idx - 1024];
    stage_mod<3>(F, A, L, b0, 2, mod);
    bf16x8 bh[4], bl[4];
#pragma unroll
    for (int ks = 0; ks < 4; ++ks)
#pragma unroll
        for (int i = 0; i < 8; ++i) { const float wv = A.in[I_WROUTER][(size_t)L * 16384 + (size_t)(128 * w + 32 * ks + 8 * q + i) * 16 + c16]; const unsigned hi = f2bf(wv); bh[ks][i] = (short)hi; bl[ks][i] = (short)f2bf(wv - bf2f(hi)); }
    __syncthreads();
    const bf16* YP = WSP(bf16, WS_YPRE); const _Float16* XR = WSP(_Float16, WS_XRES);
    f16x4 vn[2][4]; v2u yn[2][4];
#pragma unroll
    for (int p = 0; p < 2; ++p) { const int rp = rbeg + 2 * w + p < rend ? rbeg + 2 * w + p : rbeg;
#pragma unroll
        for (int j = 0; j < 4; ++j) { vn[p][j] = *(const f16x4*)(XR + (size_t)ROWOF1(rp) * 1024 + 256 * j + 4 * lane); yn[p][j] = *(const v2u*)(YP + (size_t)ROWOF1(rp) * 1024 + 256 * j + 4 * lane); } }
    for (int g0 = rbeg; g0 < rend; g0 += 16) {
#pragma unroll
        for (int p = 0; p < 2; ++p) { const int rq = g0 + 2 * w + p, r = ROWOF1(rq < nrows ? rq : 0);
            f32x4 v[4]; v2u yb[4];
            { const int rp = rq + 16 < rend ? rq + 16 : rbeg;
#pragma unroll
              for (int j = 0; j < 4; ++j) { v[j] = h4f(vn[p][j]); yb[j] = yn[p][j]; vn[p][j] = *(const f16x4*)(XR + (size_t)ROWOF1(rp) * 1024 + 256 * j + 4 * lane); yn[p][j] = *(const v2u*)(YP + (size_t)ROWOF1(rp) * 1024 + 256 * j + 4 * lane); } }
            if (rq < rend) {
                const int slot = (r % LB) < NCX ? 0 : 1 + r / LB - b0; const LAS float* mg1 = mod + slot * 3072; const LAS float* msh = mg1 + 1024; const LAS float* msc = mg1 + 2048;
#pragma unroll
                for (int j = 0; j < 4; ++j) { const f32x4 g1 = *(const LAS f32x4*)(mg1 + 256 * j + 4 * lane);
                    v[j] = v[j] * ALPHA + g1 * (f32x4){bf2f(yb[j].x & 0xffffu), bf2f(yb[j].x >> 16), bf2f(yb[j].y & 0xffffu), bf2f(yb[j].y >> 16)}; }
                ln_row(v, lnw, lane);
                _Float16* xr = WSP(_Float16, WS_XRES2) + (size_t)r * 1024; bf16* ha = WSP(bf16, WS_HA) + (size_t)r * 1024;
#pragma unroll
                for (int j = 0; j < 4; ++j) { const int k = 256 * j + 4 * lane; *(f16x4*)(xr + k) = f4h(v[j]);
                    const f32x4 sh = *(const LAS f32x4*)(msh + k), sc = *(const LAS f32x4*)(msc + k); const f32x4 h = v[j] * (sc + 1.0f) + sh;
                    v2u o; o.x = pk2(h[0], h[1]); o.y = pk2(h[2], h[3]); *(v2u*)(ha + k) = o;
                    v2u lo; lo.x = pk2(h[0] - bf2f(o.x & 0xffffu), h[1] - bf2f(o.x >> 16)); lo.y = pk2(h[2] - bf2f(o.y & 0xffffu), h[3] - bf2f(o.y >> 16));
                    *(LAS v2u*)(Ahi + (2 * w + p) * LDA + k) = o; *(LAS v2u*)(Alo + (2 * w + p) * LDA + k) = lo; } } }
        __syncthreads();
        { f32x4 acc = {0.f, 0.f, 0.f, 0.f};
#pragma unroll
          for (int ks = 0; ks < 4; ++ks) { const bf16x8 ah = lds_frag(Ahi, LDA, 0, 128 * w + 32 * ks, lane), al = lds_frag(Alo, LDA, 0, 128 * w + 32 * ks, lane);
              acc = mfma16(ah, bh[ks], acc); acc = mfma16(ah, bl[ks], acc); acc = mfma16(al, bh[ks], acc); }
#pragma unroll
          for (int j = 0; j < 4; ++j) red[(w * 16 + 4 * q + j) * 16 + c16] = acc[j]; }
        __syncthreads();
        if (F.tid < 256) { const int i = F.tid >> 4, e = F.tid & 15, rq = g0 + i, r = ROWOF1(rq < nrows ? rq : 0); float lg = 0.f;
#pragma unroll
            for (int ww = 0; ww < 8; ++ww) lg += red[(ww * 16 + i) * 16 + e];
            float mx = lg; mx = fmaxf(mx, __shfl_xor(mx, 1)); mx = fmaxf(mx, __shfl_xor(mx, 2)); mx = fmaxf(mx, __shfl_xor(mx, 4)); mx = fmaxf(mx, __shfl_xor(mx, 8));
            const float ex = expf(lg - mx); float sum = ex; sum += __shfl_xor(sum, 1); sum += __shfl_xor(sum, 2); sum += __shfl_xor(sum, 4); sum += __shfl_xor(sum, 8);
            if (rq < rend) WSP(float, WS_AFF)[(size_t)r * 16 + e] = ex / sum; }
    }
#undef ROWOF1
}
__device__ __forceinline__ void p_ln2(Frame& F, ArgsR A, int L) {
    const bool last = (L == 1);
    LAS float* wdt = (LAS float*)(F.lds + RING_OFF); LAS float* lnw = wdt + 8192; LAS float* modg = lnw + 2048; LAS float* modn = modg + 3 * 1024;
    const int nrows = last ? NB * NX : R;
#define ROWOF(qq) (last ? ((qq) / NX) * LB + NCX + (qq) % NX : (qq))
    const int rpb = (nrows + F.G - 1) / F.G, qbeg = blockIdx.x * rpb, qend = qbeg + rpb < nrows ? qbeg + rpb : nrows, b0 = ROWOF(qbeg < nrows ? qbeg : 0) / LB;
    __syncthreads();
    if (!last) { stage_wdt(F, A, L + 1, wdt); stage_mod<2>(F, A, L + 1, b0, 0, modn); }
    stage_mod<1>(F, A, L, b0, 5, modg);
    for (int idx = F.tid; idx < 2048; idx += NWAVES * 64) lnw[idx] = idx < 1024 ? A.in[I_LN2W][L * 1024 + idx] : A.in[I_LN2B][L * 1024 + idx - 1024];
    __syncthreads();
    const bf16* YS = WSP(bf16, WS_YPRE); const _Float16* XR = WSP(_Float16, WS_XRES2); const int* INV = WSP(int, WS_INV);
    const int qfirst = qbeg + F.wave;
    f16x4 vn[3][4]; int invn[3];
#pragma unroll
    for (int p = 0; p < 3; ++p) { const int qp = qfirst + 8 * p < qend ? qfirst + 8 * p : qbeg; const int rp = ROWOF(qp); invn[p] = INV[(size_t)rp * 16 + (F.lane & 15)];
#pragma unroll
        for (int j = 0; j < 4; ++j) vn[p][j] = *(const f16x4*)(XR + (size_t)rp * 1024 + 256 * j + 4 * F.lane); }
    for (int qq = qfirst; qq < qend; qq += 8) { const int r = ROWOF(qq), b = r / LB, s = r % LB;
        f32x4 moe[4];
#pragma unroll
        for (int j = 0; j < 4; ++j) moe[j] = (f32x4){0.f, 0.f, 0.f, 0.f};
        const int myinv = invn[0];
        unsigned long long msk = __ballot(myinv >= 0 && F.lane < 16);
        while (msk) { int e0 = __builtin_ctzll(msk); msk &= msk - 1; int e1 = -1; if (msk) { e1 = __builtin_ctzll(msk); msk &= msk - 1; }
            const int i0 = __builtin_amdgcn_readlane(myinv, e0); const int i1 = e1 >= 0 ? __builtin_amdgcn_readlane(myinv, e1) : i0;
            v2u p0[4], p1[4];
#pragma unroll
            for (int j = 0; j < 4; ++j) { p0[j] = *(const v2u*)(YS + (size_t)i0 * 1024 + 256 * j + 4 * F.lane); p1[j] = *(const v2u*)(YS + (size_t)i1 * 1024 + 256 * j + 4 * F.lane); }
            const float w1 = e1 >= 0 ? 1.f : 0.f;
#pragma unroll
            for (int j = 0; j < 4; ++j) { moe[j][0] += bf2f(p0[j].x & 0xffffu) + w1 * bf2f(p1[j].x & 0xffffu); moe[j][1] += bf2f(p0[j].x >> 16) + w1 * bf2f(p1[j].x >> 16);
                moe[j][2] += bf2f(p0[j].y & 0xffffu) + w1 * bf2f(p1[j].y & 0xffffu); moe[j][3] += bf2f(p0[j].y >> 16) + w1 * bf2f(p1[j].y >> 16); } }
        __builtin_amdgcn_sched_barrier(0);
        f32x4 v[4];
        { const int qp = qq + 24 < qend ? qq + 24 : qbeg; const int rn = ROWOF(qp); invn[0] = invn[1]; invn[1] = invn[2]; invn[2] = INV[(size_t)rn * 16 + (F.lane & 15)];
#pragma unroll
          for (int j = 0; j < 4; ++j) { v[j] = h4f(vn[0][j]); vn[0][j] = vn[1][j]; vn[1][j] = vn[2][j]; vn[2][j] = *(const f16x4*)(XR + (size_t)rn * 1024 + 256 * j + 4 * F.lane); } }
        const int slot = s < NCX ? 0 : 1 + b - b0;
#pragma unroll
        for (int j = 0; j < 4; ++j) { const f32x4 g2 = *(const LAS f32x4*)(modg + slot * 1024 + 256 * j + 4 * F.lane); v[j] = v[j] * ALPHA + g2 * moe[j]; }
        ln_row(v, lnw, F.lane);
        if (last) { float* o = A.out + (size_t)(b * NX + s - NCX) * 1024;
#pragma unroll
            for (int j = 0; j < 4; ++j) *(f32x4*)(o + 256 * j + 4 * F.lane) = v[j]; }
        else { _Float16* xr = WSP(_Float16, WS_XRES) + (size_t)r * 1024;
#pragma unroll
            for (int j = 0; j < 4; ++j) *(f16x4*)(xr + 256 * j + 4 * F.lane) = f4h(v[j]);
            emit_row(F, A, r, v, wdt, modn + slot * 2048, modn + slot * 2048 + 1024); } }
#undef ROWOF
}
__device__ __forceinline__ void p_qkpost(Frame& F, ArgsR A, int L) {
    const bf16* PROJ = WSP(bf16, WS_PROJ); const float* ROPE = WSP(float, WS_ROPE);
    const int gw = F.vcu * NWAVES + F.wave, NGW = F.G * NWAVES, m = F.lane & 7;
    bf16* KC = WSP(bf16, WS_KC); bf16* VC = WSP(bf16, WS_VC);
    const float* nwp = A.in[I_KNORM] + L * 64 + 8 * m; const f32x4 n0 = *(const f32x4*)nwp, n1 = *(const f32x4*)(nwp + 4);
    for (int it0 = gw * 8; it0 < R * 4; it0 += NGW * 8 * 3) {
        v4u raws[3]; f32x4 rc[3][4];
#pragma unroll
        for (int p = 0; p < 3; ++p) { const int it = it0 + p * NGW * 8, item = (it < R * 4 ? it : gw * 8) + (F.lane >> 3), r = item >> 2, sl = item & 3, s = r % LB;
            raws[p] = *(const v4u*)(PROJ + (size_t)r * NPROJ + KCOL + sl * 64 + 8 * m);
            const int t = s >= NCX ? s - NCX : 0, pos = (m >> 2) ? (t & 63) : (t >> 6); const float* rp = ROPE + (size_t)(pos * 16 + 8 * (m & 1)) * 2;
#pragma unroll
            for (int q = 0; q < 4; ++q) rc[p][q] = *(const f32x4*)(rp + 4 * q); }
#pragma unroll
        for (int p = 0; p < 3; ++p) { const int it = it0 + p * NGW * 8; if (it < R * 4) { const int item = it + (F.lane >> 3), r = item >> 2, sl = item & 3, s = r % LB; const bool lat = s >= NCX;
            const v4u raw = raws[p]; float e[8]; unpack8(raw, e);
            float ss = 0.f;
#pragma unroll
            for (int i = 0; i < 8; ++i) ss += e[i] * e[i];
            ss += __shfl_xor(ss, 1); ss += __shfl_xor(ss, 2); ss += __shfl_xor(ss, 4);
            const float rs = 1.f / sqrtf(ss * (1.f / 64.f) + LN_EPS);
            e[0] *= rs * n0[0]; e[1] *= rs * n0[1]; e[2] *= rs * n0[2]; e[3] *= rs * n0[3]; e[4] *= rs * n1[0]; e[5] *= rs * n1[1]; e[6] *= rs * n1[2]; e[7] *= rs * n1[3];
            const f32x4 c0 = rc[p][0], c1 = rc[p][1], c2 = rc[p][2], c3 = rc[p][3];
            const float cs[8] = {c0[0], c0[2], c1[0], c1[2], c2[0], c2[2], c3[0], c3[2]}, sn[8] = {c0[1], c0[3], c1[1], c1[3], c2[1], c2[3], c3[1], c3[3]};
            const float sgn = (m & 2) ? 1.f : -1.f; float o[8];
#pragma unroll
            for (int i = 0; i < 8; ++i) { const float pe = __shfl_xor(e[i], 2); o[i] = lat ? e[i] * cs[i] + sgn * pe * sn[i] : e[i]; }
            const v4u outv = (v4u){pk2(o[0], o[1]), pk2(o[2], o[3]), pk2(o[4], o[5]), pk2(o[6], o[7])};
            const int bb = r / LB, tl = s >> 6, rr = s & 63;
            if (sl < 2) *(v4u*)(KC + ((size_t)(bb * (LB / 64) + tl) * 2 + sl) * 4096 + (m * 64 + rr) * 8) = outv;
            else *(v4u*)(VC + ((size_t)(bb * (LB / 64) + tl) * 2 + (sl - 2)) * 4096 + ((((rr >> 4) + 4 * (m >> 2)) * 64) + (rr & 15) * 4 + (m & 3)) * 8) = raw; } }
    }
}
template <int MODE> __device__ __forceinline__ void ssd_unit(Frame& F, ArgsR A, int L, int b, int c) {
    constexpr int LD = 72;
    LAS bf16* XT = (LAS bf16*)(F.lds + RING_OFF);
    LAS bf16* Brow = XT + 4 * 64 * LD;
    LAS bf16* CB = Brow + 2 * 64 * LD;
    LAS bf16* Msl = CB + 2 * 64 * LD;
    LAS float* dtv = (LAS float*)(Msl + 8 * 16 * LD);
    LAS float* csv = dtv + 512;
    LAS float* ssq = csv + 512;
    LAS bf16* YO = (LAS bf16*)(ssq + 128);
    const int tid = F.tid, lane = F.lane, w = F.wave, q = lane >> 4, c16 = lane & 15;
    const bf16* PROJ = WSP(bf16, WS_PROJ);
    const int r0 = b * LB + 64 * c, seg_lo = (c < 4) ? b * LB : b * LB + NCX, seg_hi = (c < 4) ? b * LB + NCX : (b + 1) * LB;
    __syncthreads();
    { const int cg = tid & 63, ro = tid >> 6, ch0 = 8 * cg;
      if (MODE == 3 || cg < 48) {
        v4u raw[11];
#pragma unroll
        for (int i = 0; i < 11; ++i) { const int rr = r0 + 8 * ro - 1 + i, rc = rr < seg_lo ? seg_lo : (rr >= seg_hi ? seg_hi - 1 : rr);
            v4u p = *(const v4u*)(PROJ + (size_t)rc * NPROJ + XBCCOL + ch0); if (rr < seg_lo || rr >= seg_hi) p = (v4u){0u, 0u, 0u, 0u}; raw[i] = p; }
        float wt[4][8], bs[8];
        { const float* cw = A.in[I_SCONVW] + (size_t)L * 4 * 512 + ch0;
#pragma unroll
          for (int j = 0; j < 4; ++j) { const f32x4 a0 = *(const f32x4*)(cw + j * 512), a1 = *(const f32x4*)(cw + j * 512 + 4); wt[j][0] = a0[0]; wt[j][1] = a0[1]; wt[j][2] = a0[2]; wt[j][3] = a0[3]; wt[j][4] = a1[0]; wt[j][5] = a1[1]; wt[j][6] = a1[2]; wt[j][7] = a1[3]; }
          const f32x4 b0 = *(const f32x4*)(A.in[I_SCONVB] + L * 512 + ch0), b1 = *(const f32x4*)(A.in[I_SCONVB] + L * 512 + ch0 + 4); bs[0] = b0[0]; bs[1] = b0[1]; bs[2] = b0[2]; bs[3] = b0[3]; bs[4] = b1[0]; bs[5] = b1[1]; bs[6] = b1[2]; bs[7] = b1[3]; }
        v4u rp[8];
        { float w0[8], w1[8], w2[8], w3[8]; unpack8(raw[0], w0); unpack8(raw[1], w1); unpack8(raw[2], w2);
#pragma unroll
          for (int l = 0; l < 8; ++l) { unpack8(raw[l + 3], w3); float y[8];
#pragma unroll
              for (int cc = 0; cc < 8; ++cc) { y[cc] = silu_ff(wt[0][cc] * w0[cc] + wt[1][cc] * w1[cc] + wt[2][cc] * w2[cc] + wt[3][cc] * w3[cc] + bs[cc]); w0[cc] = w1[cc]; w1[cc] = w2[cc]; w2[cc] = w3[cc]; }
              rp[l] = (v4u){pk2(y[0], y[1]), pk2(y[2], y[3]), pk2(y[4], y[5]), pk2(y[6], y[7])}; } }
#define ROWPK(l) (rp[l])
#define CPAIR(cc, i) (((cc) & 1) ? ((rp[2 * (i)][(cc) >> 1] >> 16) | (rp[2 * (i) + 1][(cc) >> 1] & 0xffff0000u)) : ((rp[2 * (i)][(cc) >> 1] & 0xffffu) | (rp[2 * (i) + 1][(cc) >> 1] << 16)))
#define COLPK(cc) ((v4u){CPAIR(cc, 0), CPAIR(cc, 1), CPAIR(cc, 2), CPAIR(cc, 3)})
        if (ch0 < 256) { const int h = ch0 >> 6, p0 = ch0 & 63;
#pragma unroll
            for (int cc = 0; cc < 8; ++cc) *(LAS v4u*)(XT + (h * 64 + p0 + cc) * LD + 8 * ro) = COLPK(cc);
        } else if (ch0 < 384) { const int g = (ch0 - 256) >> 6, n0 = ch0 & 63;
#pragma unroll
            for (int l = 0; l < 8; ++l) *(LAS v4u*)(Brow + (g * 64 + 8 * ro + l) * LD + n0) = ROWPK(l);
            if (MODE == 1) {
#pragma unroll
                for (int cc = 0; cc < 8; ++cc) *(LAS v4u*)(CB + (g * 64 + n0 + cc) * LD + 8 * ro) = COLPK(cc); }
        } else { const int g = (ch0 - 384) >> 6, n0 = ch0 & 63;
#pragma unroll
            for (int l = 0; l < 8; ++l) *(LAS v4u*)(CB + (g * 64 + 8 * ro + l) * LD + n0) = ROWPK(l); }
#undef ROWPK
#undef COLPK
#undef CPAIR
      } }
    { const int dh = tid >> 6, l = tid & 63;
      const float dt = softplus_f(WSP(float, WS_DT)[(size_t)(r0 + l) * 8 + dh] + A.in[I_SDTB][L * 8 + dh]); const float a = -__expf(A.in[I_SALOG][L * 8 + dh]);
      dtv[dh * 64 + l] = dt; csv[dh * 64 + l] = dt * a; }
    __syncthreads();
    { const int dh = tid >> 6, l = tid & 63; float s = 0.f;
      if (dh < 4) { for (int j = 0; j <= l; ++j) s += csv[dh * 64 + j]; } else { for (int j = l; j < 64; ++j) s += csv[dh * 64 + j]; }
      __syncthreads(); csv[dh * 64 + l] = s; }
    __syncthreads();
    if (MODE == 1) {
        const int d = w >> 2, h = w & 3, g = h >> 1, dh = w;
        const float cs_end = d == 0 ? csv[dh * 64 + 63] : csv[dh * 64];
        const size_t chain = (size_t)((b * 2 + d) * 4 + h) * NCH + c;
        float* S = WSP(float, WS_S) + chain * 4096;
        float wg[2][8];
#pragma unroll
        for (int ks = 0; ks < 2; ++ks)
#pragma unroll
            for (int i = 0; i < 8; ++i) { const int k = 32 * ks + 8 * q + i; wg[ks][i] = __expf(cs_end - csv[dh * 64 + k]) * dtv[dh * 64 + k]; }
#pragma unroll
        for (int pt = 0; pt < 4; ++pt) { f32x4 acc[4];
#pragma unroll
            for (int nt = 0; nt < 4; ++nt) acc[nt] = (f32x4){0.f, 0.f, 0.f, 0.f};
#pragma unroll
            for (int ks = 0; ks < 2; ++ks) { const bf16x8 a0 = lds_frag(XT + h * 64 * LD, LD, 16 * pt, 32 * ks, lane); bf16x8 a;
#pragma unroll
                for (int i = 0; i < 8; ++i) a[i] = (short)f2bf(bf2f((unsigned short)a0[i]) * wg[ks][i]);
#pragma unroll
                for (int nt = 0; nt < 4; ++nt) acc[nt] = mfma16(a, lds_frag(CB + g * 64 * LD, LD, 16 * nt, 32 * ks, lane), acc[nt]); }
#pragma unroll
            for (int nt = 0; nt < 4; ++nt)
#pragma unroll
                for (int j = 0; j < 4; ++j) S[(16 * pt + 4 * q + j) * 64 + 16 * nt + c16] = acc[nt][j]; }
        if (lane == 0) WSP(float, WS_TOT)[chain] = __expf(cs_end);
    } else {
        {
          const int h = w & 3, rh = w >> 2, g2 = h >> 1; const LAS bf16* Cg2 = CB + g2 * 64 * LD;
          f32x4 yo[2][4];
#pragma unroll
          for (int r2 = 0; r2 < 2; ++r2)
#pragma unroll
              for (int pt = 0; pt < 4; ++pt) yo[r2][pt] = (f32x4){0.f, 0.f, 0.f, 0.f};
#pragma unroll
          for (int d = 0; d < 2; ++d) { const int dh = d * 4 + h; const bf16* Hin = WSP(bf16, WS_HIN) + ((size_t)((b * 2 + d) * 4 + h) * NCH + c) * 4096;
              bf16x8 hq[4][2];
#pragma unroll
              for (int pt = 0; pt < 4; ++pt)
#pragma unroll
                  for (int ks = 0; ks < 2; ++ks) hq[pt][ks] = *(const bf16x8*)(Hin + (16 * pt + c16) * 64 + 32 * ks + 8 * q);
#pragma unroll
              for (int r2 = 0; r2 < 2; ++r2) { const int rt = 2 * rh + r2; const bf16x8 a0 = lds_frag(Cg2, LD, 16 * rt, 0, lane), a1 = lds_frag(Cg2, LD, 16 * rt, 32, lane);
                  float ec[4];
#pragma unroll
                  for (int j = 0; j < 4; ++j) ec[j] = exp_f(csv[dh * 64 + 16 * rt + 4 * q + j]);
#pragma unroll
                  for (int pt = 0; pt < 4; ++pt) { f32x4 off = {0.f, 0.f, 0.f, 0.f}; off = mfma16(a0, hq[pt][0], off); off = mfma16(a1, hq[pt][1], off);
#pragma unroll
                      for (int j = 0; j < 4; ++j) yo[r2][pt][j] += off[j] * ec[j]; } } }
#pragma unroll
          for (int r2 = 0; r2 < 2; ++r2)
#pragma unroll
              for (int pt = 0; pt < 4; ++pt)
#pragma unroll
                  for (int j = 0; j < 4; ++j) YO[(h * 64 + 16 * (2 * rh + r2) + 4 * q + j) * LD + 16 * pt + c16] = (bf16)f2bf(yo[r2][pt][j]);
        }
        __syncthreads();
        const int rt = w & 3, g = w >> 2;
        const LAS bf16* Cg = CB + g * 64 * LD; const LAS bf16* Bg = Brow + g * 64 * LD; LAS bf16* Mw = Msl + w * 16 * LD;
        f32x4 G[4];
#pragma unroll
        for (int st = 0; st < 4; ++st) { G[st] = (f32x4){0.f, 0.f, 0.f, 0.f};
#pragma unroll
            for (int ks = 0; ks < 2; ++ks) G[st] = mfma16(lds_frag(Bg, LD, 16 * st, 32 * ks, lane), lds_frag(Cg, LD, 16 * rt, 32 * ks, lane), G[st]); }
        f32x4 y[2][4];
#pragma unroll
        for (int hh = 0; hh < 2; ++hh)
#pragma unroll
            for (int pt = 0; pt < 4; ++pt) y[hh][pt] = (f32x4){0.f, 0.f, 0.f, 0.f};
#pragma unroll
        for (int hh = 0; hh < 2; ++hh) { const int h = 2 * g + hh; const LAS bf16* XTh = XT + h * 64 * LD;
#pragma unroll
            for (int d = 0; d < 2; ++d) { const int dh = d * 4 + h;
                float csl[4];
#pragma unroll
                for (int j = 0; j < 4; ++j) csl[j] = csv[dh * 64 + 16 * rt + 4 * q + j];
                { const int l = 16 * rt + c16; const float csm = csv[dh * 64 + l];
#pragma unroll
                  for (int st = 0; st < 4; ++st) { const f32x4 css = *(const LAS f32x4*)(csv + dh * 64 + 16 * st + 4 * q), dts = *(const LAS f32x4*)(dtv + dh * 64 + 16 * st + 4 * q); float val[4];
#pragma unroll
                      for (int j = 0; j < 4; ++j) { const int s = 16 * st + 4 * q + j; const bool valid = d == 0 ? (s <= l) : (s >= l);
                          val[j] = valid ? G[st][j] * exp_f(fminf(csm - css[j], 0.f)) * dts[j] : 0.f; }
                      *(LAS v2u*)(Mw + c16 * LD + 16 * st + 4 * q) = (v2u){pk2(val[0], val[1]), pk2(val[2], val[3])}; } }
                LDS_WAIT();
#pragma unroll
                for (int ks = 0; ks < 2; ++ks) { const bf16x8 a = lds_frag(Mw, LD, 0, 32 * ks, lane);
#pragma unroll
                    for (int pt = 0; pt < 4; ++pt) y[hh][pt] = mfma16(a, lds_frag(XTh, LD, 16 * pt, 32 * ks, lane), y[hh][pt]); }
                LDS_WAIT();
            }
            const float Dv = A.in[I_SD][L * 4 + h];
#pragma unroll
            for (int pt = 0; pt < 4; ++pt)
#pragma unroll
                for (int j = 0; j < 4; ++j) y[hh][pt][j] += Dv * bf2f(XTh[(16 * pt + c16) * LD + 16 * rt + 4 * q + j]) + bf2f(YO[(h * 64 + 16 * rt + 4 * q + j) * LD + 16 * pt + c16]);
        }
        float ss[4] = {0.f, 0.f, 0.f, 0.f};
#pragma unroll
        for (int hh = 0; hh < 2; ++hh)
#pragma unroll
            for (int pt = 0; pt < 4; ++pt)
#pragma unroll
                for (int j = 0; j < 4; ++j) { const int r = r0 + 16 * rt + 4 * q + j; const float z = bf2f(PROJ[(size_t)r * NPROJ + ZCOL + (2 * g + hh) * 64 + 16 * pt + c16]);
                    const float v = y[hh][pt][j] * silu_ff(z); y[hh][pt][j] = v; ss[j] += v * v; }
#pragma unroll
        for (int j = 0; j < 4; ++j) { float s = ss[j]; s += __shfl_xor(s, 1); s += __shfl_xor(s, 2); s += __shfl_xor(s, 4); s += __shfl_xor(s, 8); if (c16 == 0) ssq[g * 64 + 16 * rt + 4 * q + j] = s; }
        __syncthreads();
        bf16* MG = WSP(bf16, WS_MERGED);
#pragma unroll
        for (int j = 0; j < 4; ++j) { const int l = 16 * rt + 4 * q + j; const float rs = 1.f / sqrtf((ssq[l] + ssq[64 + l]) * (1.f / 256.f) + LN_EPS);
#pragma unroll
            for (int hh = 0; hh < 2; ++hh)
#pragma unroll
                for (int pt = 0; pt < 4; ++pt) { const int chn = (2 * g + hh) * 64 + 16 * pt + c16; MG[(size_t)(r0 + l) * 1024 + 512 + chn] = (bf16)f2bf(y[hh][pt][j] * rs * A.in[I_SNORM][L * 256 + chn]); } }
    }
}
template <int MODE> __device__ __forceinline__ void rg_unit(Frame& F, ArgsR A, int L, int b, int c) {
    constexpr int LDU = 264, LDQ = 68;
    LAS bf16* U = (LAS bf16*)(F.lds + RING_OFF);
    LAS unsigned* QT = (LAS unsigned*)(F.lds + RING_OFF + 33792);
    const int tid = F.tid, lane = F.lane, w = F.wave, q = lane >> 4, c16 = lane & 15;
    const bf16* PROJ = WSP(bf16, WS_PROJ);
    const int r0 = b * LB + 64 * c, seg_lo = (c < 4) ? b * LB : b * LB + NCX, seg_hi = (c < 4) ? b * LB + NCX : (b + 1) * LB;
    __syncthreads();
    { const int cg = tid & 31, rq = tid >> 5, ch0 = 8 * cg;
      v4u raw[7];
#pragma unroll
      for (int i = 0; i < 7; ++i) { const int rr = r0 + 4 * rq - 1 + i, rc = rr < seg_lo ? seg_lo : (rr >= seg_hi ? seg_hi - 1 : rr);
          v4u p = *(const v4u*)(PROJ + (size_t)rc * NPROJ + UCOL + ch0); if (rr < seg_lo || rr >= seg_hi) p = (v4u){0u, 0u, 0u, 0u}; raw[i] = p; }
      float wt[4][8], bs[8];
      { const float* cw = A.in[I_RCONVW] + (size_t)L * 4 * 256 + ch0;
#pragma unroll
        for (int j = 0; j < 4; ++j) { const f32x4 a0 = *(const f32x4*)(cw + j * 256), a1 = *(const f32x4*)(cw + j * 256 + 4); wt[j][0] = a0[0]; wt[j][1] = a0[1]; wt[j][2] = a0[2]; wt[j][3] = a0[3]; wt[j][4] = a1[0]; wt[j][5] = a1[1]; wt[j][6] = a1[2]; wt[j][7] = a1[3]; }
        const f32x4 b0 = *(const f32x4*)(A.in[I_RCONVB] + L * 256 + ch0), b1 = *(const f32x4*)(A.in[I_RCONVB] + L * 256 + ch0 + 4); bs[0] = b0[0]; bs[1] = b0[1]; bs[2] = b0[2]; bs[3] = b0[3]; bs[4] = b1[0]; bs[5] = b1[1]; bs[6] = b1[2]; bs[7] = b1[3]; }
      float w0[8], w1[8], w2[8], w3[8]; unpack8(raw[0], w0); unpack8(raw[1], w1); unpack8(raw[2], w2);
#pragma unroll
      for (int l = 0; l < 4; ++l) { unpack8(raw[l + 3], w3); float yv[8];
#pragma unroll
          for (int cc = 0; cc < 8; ++cc) { yv[cc] = wt[0][cc] * w0[cc] + wt[1][cc] * w1[cc] + wt[2][cc] * w2[cc] + wt[3][cc] * w3[cc] + bs[cc]; w0[cc] = w1[cc]; w1[cc] = w2[cc]; w2[cc] = w3[cc]; }
          *(LAS v4u*)(U + (4 * rq + l) * LDU + ch0) = (v4u){pk2(yv[0], yv[1]), pk2(yv[2], yv[3]), pk2(yv[4], yv[5]), pk2(yv[6], yv[7])}; }
    }
    __syncthreads();
    LAS bf16* P16 = (LAS bf16*)(F.lds + RING_OFF + 33792 + 69632);
#pragma unroll 1
    for (int d = 0; d < 2; ++d) {
        { const int blk = w & 3, eh = w >> 2;
          const bf16* WA = WSP(bf16, WS_RGW) + (size_t)(((L * 2 + 0) * 2 + d) * 4 + blk) * 4096; const bf16* WX = WSP(bf16, WS_RGW) + (size_t)(((L * 2 + 1) * 2 + d) * 4 + blk) * 4096;
          bf16x8 wa0[2], wa1[2], wx0[2], wx1[2]; float ba[2], bx[2], sp[2];
#pragma unroll
          for (int n2 = 0; n2 < 2; ++n2) { const int e = 32 * eh + 16 * n2 + c16, ch = blk * 64 + e;
              wa0[n2] = *(const bf16x8*)(WA + e * 64 + 8 * q); wa1[n2] = *(const bf16x8*)(WA + e * 64 + 32 + 8 * q); wx0[n2] = *(const bf16x8*)(WX + e * 64 + 8 * q); wx1[n2] = *(const bf16x8*)(WX + e * 64 + 32 + 8 * q);
              ba[n2] = A.in[I_RBA][(L * 2 + d) * 256 + ch]; bx[n2] = A.in[I_RBX][(L * 2 + d) * 256 + ch]; sp[n2] = A.in[I_RLAM][(L * 2 + d) * 256 + ch]; }
          sp[0] = softplus_f(-sp[0]); sp[1] = softplus_f(-sp[1]);
#pragma unroll
          for (int rt = 0; rt < 4; ++rt) {
              const bf16x8 a0 = lds_frag(U, LDU, 16 * rt, blk * 64, lane), a1 = lds_frag(U, LDU, 16 * rt, blk * 64 + 32, lane);
#pragma unroll
              for (int n2 = 0; n2 < 2; ++n2) { const int ch = blk * 64 + 32 * eh + 16 * n2 + c16;
                  f32x4 pa = {0.f, 0.f, 0.f, 0.f}, px = {0.f, 0.f, 0.f, 0.f};
                  pa = mfma16(a0, wa0[n2], pa); pa = mfma16(a1, wa1[n2], pa); px = mfma16(a0, wx0[n2], px); px = mfma16(a1, wx1[n2], px);
                  v4u pk;
#pragma unroll
                  for (int j = 0; j < 4; ++j) { const int l = 16 * rt + 4 * q + j; const float la = -8.0f * sigmoid_f(pa[j] + ba[n2]) * sp[n2];
                      const float inp = __builtin_amdgcn_sqrtf(fmaxf(1.0f - exp_f(2.0f * la), 0.f)) * sigmoid_f(px[j] + bx[n2]) * bf2f(U[l * LDU + ch]);
                      pk[j] = pk2(la, inp); }
                  if (d == 1) pk = (v4u){pk[3], pk[2], pk[1], pk[0]};
                  *(LAS v4u*)(QT + ch * LDQ + (d == 0 ? 16 * rt + 4 * q : 60 - 16 * rt - 4 * q)) = pk; } } }
        __syncthreads();
        if (tid < 256) { const int ch = tid; const size_t o = (size_t)((b * NCH + c) * 2 + d) * 256 + ch;
            float h = MODE == 1 ? 0.f : WSP(float, WS_RGC)[o], ls = 0.f;
#pragma unroll 1
            for (int g = 0; g < 4; ++g) { v4u qv[4];
#pragma unroll
                for (int i = 0; i < 4; ++i) qv[i] = *(const LAS v4u*)(QT + ch * LDQ + 16 * g + 4 * i);
#pragma unroll
                for (int kk = 0; kk < 16; ++kk) { const unsigned e = qv[kk >> 2][kk & 3]; const float la = bf2f(e & 0xffffu); h = exp_f(la) * h + __uint_as_float(e & 0xffff0000u); ls += la;
                    if (MODE == 1) { const int k = 16 * g + kk, l = d == 0 ? k : 63 - k;
                        WSP(unsigned, WS_RGL)[((size_t)(b * 2 + d) * LB + 64 * c + l) * 256 + ch] = pk2(h, exp_f(ls)); }
                    if (MODE == 3) { const int k = 16 * g + kk; if (d == 0) P16[k * 256 + ch] = (bf16)f2bf(h); else P16[(63 - k) * 256 + ch] = (bf16)f2bf(h + bf2f(P16[(63 - k) * 256 + ch])); } } }
            if (MODE == 1) { float* RS = WSP(float, WS_RGS); *(f32x2_t*)(RS + 2 * o) = (f32x2_t){__expf(ls), h}; } }
        __syncthreads();
    }
    if (MODE == 3) {
        bf16* MG = WSP(bf16, WS_MERGED);
        const f32x4 nwr = *(const f32x4*)(A.in[I_RONORM] + L * 256 + 4 * lane); const f32x4 nwa0 = *(const f32x4*)(A.in[I_AONORM] + L * 512 + 8 * lane), nwa1 = *(const f32x4*)(A.in[I_AONORM] + L * 512 + 8 * lane + 4);
#pragma unroll 1
        for (int r4 = 0; r4 < 8; r4 += 4) {
        v2u gp[4]; v4u op[4];
#pragma unroll
        for (int rr = 0; rr < 4; ++rr) { const size_t r = (size_t)(r0 + 8 * w + r4 + rr); gp[rr] = *(const v2u*)(PROJ + r * NPROJ + GCOL + 4 * lane); op[rr] = *(const v4u*)(WSP(bf16, WS_OB) + r * 512 + 8 * lane); }
#pragma unroll
        for (int rr = 0; rr < 4; ++rr) { const int l = 8 * w + r4 + rr; const size_t r = (size_t)(r0 + l);
            { const v2u hp = *(const LAS v2u*)(P16 + l * 256 + 4 * lane); const f32x4 hv = {bf2f(hp.x & 0xffffu), bf2f(hp.x >> 16), bf2f(hp.y & 0xffffu), bf2f(hp.y >> 16)};
              float v[4]; v[0] = hv[0] * gelu_tanh_f(bf2f(gp[rr].x & 0xffffu)); v[1] = hv[1] * gelu_tanh_f(bf2f(gp[rr].x >> 16)); v[2] = hv[2] * gelu_tanh_f(bf2f(gp[rr].y & 0xffffu)); v[3] = hv[3] * gelu_tanh_f(bf2f(gp[rr].y >> 16));
              const float rs = 1.f / sqrtf(wave_sum((v[0] * v[0] + v[1] * v[1]) + (v[2] * v[2] + v[3] * v[3])) * (1.f / 256.f) + LN_EPS);
              v2u o; o.x = pk2(v[0] * rs * nwr[0], v[1] * rs * nwr[1]); o.y = pk2(v[2] * rs * nwr[2], v[3] * rs * nwr[3]); *(v2u*)(MG + r * 1024 + 768 + 4 * lane) = o; }
            { float v[8]; unpack8(op[rr], v); float s = 0.f;
#pragma unroll
              for (int i = 0; i < 8; ++i) s += v[i] * v[i];
              const float rs = 1.f / sqrtf(wave_sum(s) * (1.f / 512.f) + LN_EPS);
              v4u o; o.x = pk2(v[0] * rs * nwa0[0], v[1] * rs * nwa0[1]); o.y = pk2(v[2] * rs * nwa0[2], v[3] * rs * nwa0[3]); o.z = pk2(v[4] * rs * nwa1[0], v[5] * rs * nwa1[1]); o.w = pk2(v[6] * rs * nwa1[2], v[7] * rs * nwa1[3]);
              *(v4u*)(MG + r * 1024 + 8 * lane) = o; } }
        }
    }
}
__device__ __forceinline__ void p_carry(Frame& F, ArgsR A) {
    typedef float f32x2 __attribute__((ext_vector_type(2)));
    const int gt = blockIdx.x * (NWAVES * 64) + F.tid, NT = F.G * NWAVES * 64;
    for (int idx = gt; idx < 64 * 2048; idx += NT) { const int chain = idx >> 11, e2 = idx & 2047, d = (chain >> 2) & 1;
        const f32x2* S = (const f32x2*)(WSP(float, WS_S) + (size_t)chain * NCH * 4096) + e2; unsigned* H = WSP(unsigned, WS_HIN) + (size_t)chain * NCH * 2048 + e2; const float* T = WSP(float, WS_TOT) + chain * NCH;
        f32x2 st = {0.f, 0.f};
        for (int k0 = 0; k0 < NCH; k0 += 4) { f32x2 s[4]; float tt[4]; int cc[4];
#pragma unroll
            for (int i = 0; i < 4; ++i) { const int k = k0 + i; cc[i] = d == 0 ? k : (k < 4 ? 3 - k : 71 - k); s[i] = S[(size_t)cc[i] * 2048]; tt[i] = T[cc[i]]; }
#pragma unroll
            for (int i = 0; i < 4; ++i) { H[(size_t)cc[i] * 2048] = pk2(st[0], st[1]); st = st * tt[i] + s[i]; } } }
    for (int idx = gt; idx < 4096; idx += NT) { const int b = idx >> 9, d = (idx >> 8) & 1, ch = idx & 255; float st = 0.f;
        for (int k0 = 0; k0 < NCH; k0 += 4) { f32x2 av[4]; size_t oo[4];
#pragma unroll
            for (int i = 0; i < 4; ++i) { const int k = k0 + i, c = d == 0 ? k : (k < 4 ? 3 - k : 71 - k); oo[i] = (size_t)((b * NCH + c) * 2 + d) * 256 + ch; av[i] = *(const f32x2*)(WSP(float, WS_RGS) + 2 * oo[i]); }
#pragma unroll
            for (int i = 0; i < 4; ++i) { WSP(float, WS_RGC)[oo[i]] = st; st = av[i][0] * st + av[i][1]; } } }
}
__device__ __forceinline__ unsigned block_sum_u(Frame& F, unsigned v, LAS unsigned* red) {
#pragma unroll
    for (int o = 1; o < 64; o <<= 1) v += __shfl_xor(v, o);
    __syncthreads();
    if (F.lane == 0) red[F.wave] = v;
    __syncthreads();
    unsigned s = 0;
#pragma unroll
    for (int i = 0; i < 8; ++i) s += red[i];
    return s;
}
__device__ __forceinline__ unsigned block_excl_scan_u(Frame& F, unsigned v, LAS unsigned* red) {
    unsigned inc = v;
#pragma unroll
    for (int o = 1; o < 64; o <<= 1) { const unsigned t = __shfl_up(inc, o); if (F.lane >= o) inc += t; }
    __syncthreads();
    if (F.lane == 63) red[F.wave] = inc;
    __syncthreads();
    unsigned base = 0;
#pragma unroll
    for (int i = 0; i < 8; ++i) base += (i < F.wave) ? red[i] : 0u;
    return base + inc - v;
}
__device__ __forceinline__ void topk_unit(Frame& F, ArgsR A, int set, int b, int e) {
    LAS unsigned* red = (LAS unsigned*)(F.lds + RING_OFF);
    const int n = set == 0 ? NX : NCX, cap = set == 0 ? 512 : 32, row0 = b * LB + (set == 0 ? NCX : 0);
    const float* AFF = WSP(float, WS_AFF);
    unsigned key[8];
#pragma unroll
    for (int j = 0; j < 8; ++j) { const int t = 8 * F.tid + j, tc = t < n ? t : n - 1; const unsigned kv = __float_as_uint(AFF[(size_t)(row0 + tc) * 16 + e]); key[j] = t < n ? kv : 0u; }
    unsigned prefix = 0u;
    for (int it = 0; it < 15; ++it) { const int sh = 28 - 2 * it; const unsigned c1 = prefix | (1u << sh), c2 = prefix | (2u << sh), c3 = prefix | (3u << sh); unsigned pk = 0;
#pragma unroll
        for (int j = 0; j < 8; ++j) pk += (key[j] >= c1 ? 1u : 0u) + (key[j] >= c2 ? 1u << 10 : 0u) + (key[j] >= c3 ? 1u << 20 : 0u);
#pragma unroll
        for (int o = 1; o < 64; o <<= 1) pk += __shfl_xor(pk, o);
        LAS unsigned* rb = red + 16 + 8 * (it & 1);
        if (F.lane == 0) rb[F.wave] = pk;
        __syncthreads();
        unsigned n1 = 0, n2 = 0, n3 = 0;
#pragma unroll
        for (int i = 0; i < 8; ++i) { const unsigned v = rb[i]; n1 += v & 1023u; n2 += (v >> 10) & 1023u; n3 += v >> 20; }
        prefix = n3 >= (unsigned)cap ? c3 : (n2 >= (unsigned)cap ? c2 : (n1 >= (unsigned)cap ? c1 : prefix)); }
    const unsigned T = prefix; unsigned ngt = 0, neq = 0;
#pragma unroll
    for (int j = 0; j < 8; ++j) { ngt += key[j] > T ? 1u : 0u; neq += key[j] == T ? 1u : 0u; }
    const unsigned tot_gt = block_sum_u(F, ngt, red); const unsigned need = (unsigned)cap - tot_gt;
    unsigned tie = block_excl_scan_u(F, neq, red);
    unsigned selmask = 0, nsel = 0;
#pragma unroll
    for (int j = 0; j < 8; ++j) { bool sel = key[j] > T; if (key[j] == T) { sel = tie < need; ++tie; } if (sel) { selmask |= 1u << j; ++nsel; } }
    unsigned slot = block_excl_scan_u(F, nsel, red);
    int* INV = WSP(int, WS_INV); int* SRC = WSP(int, WS_SRC); float* GATE = WSP(float, WS_GATE);
#pragma unroll
    for (int j = 0; j < 8; ++j) { const int t = 8 * F.tid + j; if (t < n) { const int r = row0 + t;
        if ((selmask >> j) & 1u) { const int rg = e * EROWS + (set == 0 ? b * 512 : 4096 + b * 32) + (int)slot; ++slot; SRC[rg] = r; GATE[rg] = __uint_as_float(key[j]); INV[(size_t)r * 16 + e] = rg; }
        else INV[(size_t)r * 16 + e] = -1; } }
}
__device__ __forceinline__ void p_topk(Frame& F, ArgsR A, int L) {
    const int nu = L == 0 ? 256 : 128;
    for (int u = blockIdx.x; u < nu; u += F.G) { __syncthreads(); topk_unit(F, A, u >> 7, (u & 127) >> 4, u & 15); }
}
__device__ __forceinline__ int queue_next(Frame& F, gu32* ctr) { __syncthreads(); if (F.tid == 0) F.MISC[0] = __hip_atomic_fetch_add(ctr, 1u, RLX_AGENT); __syncthreads(); return (int)F.MISC[0]; }
__device__ __forceinline__ void p_x1(Frame& F, ArgsR A, int L) {
    gu32* ctr = (gu32*)(A.ws + WS_CTL) + CW_QUEUE + 64 * (2 * L);
    for (;;) { const int u = queue_next(F, ctr); if (u >= 2 * NB * NCH) break;
        if (u < NB * NCH) rg_unit<1>(F, A, L, u / NCH, u % NCH); else ssd_unit<1>(F, A, L, (u - NB * NCH) / NCH, (u - NB * NCH) % NCH); }
}
__device__ __forceinline__ void p_x3(Frame& F0, ArgsR A, int L) {
    const int par = F0.vcu & 1;
#pragma unroll 1
    for (int step = 0; step < 2; ++step) { Frame F; make_frame(F, F0.lds);
      if ((step ^ par) == 0) {
    gu32* ctr = (gu32*)(A.ws + WS_CTL) + CW_QUEUE + 64 * (2 * L + 1);
    for (;;) { const int u = queue_next(F, ctr); if (u >= NB * NCH) break; if (L == 1 && u % NCH < NCX / 64) continue; ssd_unit<3>(F, A, L, u / NCH, u % NCH); }
      } else {
    const int gw = F.vcu * NWAVES + F.wave, NGW = F.G * NWAVES, lane = F.lane;
    const bf16* PROJ = WSP(bf16, WS_PROJ); bf16* MG = WSP(bf16, WS_MERGED); const unsigned* RGL = WSP(unsigned, WS_RGL); const float* RGC = WSP(float, WS_RGC); const bf16* OB = WSP(bf16, WS_OB);
    const f32x4 nwr = *(const f32x4*)(A.in[I_RONORM] + L * 256 + 4 * lane); const f32x4 nwa0 = *(const f32x4*)(A.in[I_AONORM] + L * 512 + 8 * lane), nwa1 = *(const f32x4*)(A.in[I_AONORM] + L * 512 + 8 * lane + 4);
    const int nrows3 = L == 1 ? NB * NX : R;
    for (int q0 = 2 * gw; q0 < nrows3; q0 += 2 * NGW) { const int r0 = L == 1 ? (q0 / NX) * LB + NCX + q0 % NX : q0;
        v4u sp[2][2]; f32x4 cr[2][2]; v2u gp[2]; v4u op[2];
#pragma unroll
        for (int p = 0; p < 2; ++p) { const int r = r0 + p, b = r / LB, s = r % LB, c = s >> 6;
#pragma unroll
            for (int d = 0; d < 2; ++d) { sp[p][d] = *(const v4u*)(RGL + ((size_t)(b * 2 + d) * LB + s) * 256 + 4 * lane); cr[p][d] = *(const f32x4*)(RGC + (size_t)((b * NCH + c) * 2 + d) * 256 + 4 * lane); }
            gp[p] = *(const v2u*)(PROJ + (size_t)r * NPROJ + GCOL + 4 * lane); op[p] = *(const v4u*)(OB + (size_t)r * 512 + 8 * lane); }
#pragma unroll
        for (int p = 0; p < 2; ++p) { const size_t r = (size_t)(r0 + p);
            { float hv[4];
#pragma unroll
              for (int i = 0; i < 4; ++i) hv[i] = (bf2f(sp[p][0][i] & 0xffffu) + __uint_as_float(sp[p][0][i] & 0xffff0000u) * cr[p][0][i]) + (bf2f(sp[p][1][i] & 0xffffu) + __uint_as_float(sp[p][1][i] & 0xffff0000u) * cr[p][1][i]);
              float v[4]; v[0] = hv[0] * gelu_tanh_f(bf2f(gp[p].x & 0xffffu)); v[1] = hv[1] * gelu_tanh_f(bf2f(gp[p].x >> 16)); v[2] = hv[2] * gelu_tanh_f(bf2f(gp[p].y & 0xffffu)); v[3] = hv[3] * gelu_tanh_f(bf2f(gp[p].y >> 16));
              const float rs = 1.f / sqrtf(wave_sum((v[0] * v[0] + v[1] * v[1]) + (v[2] * v[2] + v[3] * v[3])) * (1.f / 256.f) + LN_EPS);
              v2u o; o.x = pk2(v[0] * rs * nwr[0], v[1] * rs * nwr[1]); o.y = pk2(v[2] * rs * nwr[2], v[3] * rs * nwr[3]); *(v2u*)(MG + r * 1024 + 768 + 4 * lane) = o; }
            { float v[8]; unpack8(op[p], v); float s = 0.f;
#pragma unroll
              for (int i = 0; i < 8; ++i) s += v[i] * v[i];
              const float rs = 1.f / sqrtf(wave_sum(s) * (1.f / 512.f) + LN_EPS);
              v4u o; o.x = pk2(v[0] * rs * nwa0[0], v[1] * rs * nwa0[1]); o.y = pk2(v[2] * rs * nwa0[2], v[3] * rs * nwa0[3]); o.z = pk2(v[4] * rs * nwa1[0], v[5] * rs * nwa1[1]); o.w = pk2(v[6] * rs * nwa1[2], v[7] * rs * nwa1[3]);
              *(v4u*)(MG + r * 1024 + 8 * lane) = o; } } }
      }
      __syncthreads(); }
}
__device__ __forceinline__ void p_attn(Frame& F, ArgsR A, int L, unsigned char* lds_generic) {
    attn_body::bf16* P = (attn_body::bf16*)WSP(bf16, WS_PROJ);
    const int nun = L == 0 ? 1024 + 64 : 1024;
    const int slot = (F.vcu >> 5) & 3;
    for (int a = F.vcu, i = 0; a < nun; a += F.G, ++i) { int b, h, q0, nt;
        if (L == 0 && i == slot) { conv_rounds(F, A, 0, 14, 49152); __syncthreads(); }
        if (a < 1024) { b = a >> 7; h = (a & 127) >> 4; q0 = NCX + 256 * (a & 15); nt = 68; } else { b = (a - 1024) >> 3; h = (a - 1024) & 7; q0 = 0; nt = 4; }
        attn_body::attn_unit<8>(b, h, q0, nt, P, (const attn_body::bf16*)WSP(bf16, WS_KC), (const attn_body::bf16*)WSP(bf16, WS_VC), (attn_body::bf16*)WSP(bf16, WS_OB), A.in[I_QNORM] + L * 64, WSP(float, WS_ROPE), (char*)lds_generic + RING_OFF); }
}
__device__ __forceinline__ void make_frame(Frame& F, LAS unsigned char* lds) {
    F.lds = lds; F.MISC = (volatile LAS unsigned*)(lds + MISC_OFF);
    int tid = threadIdx.x; asm volatile("" : "+v"(tid));
    F.tid = tid; F.lane = F.tid & 63; F.wave = __builtin_amdgcn_readfirstlane(F.tid >> 6);
    int g = gridDim.x, bx = blockIdx.x; asm volatile("" : "+s"(g), "+s"(bx));
    F.G = g; F.vcu = (F.G % 8 == 0) ? (bx % 8) * (F.G / 8) + bx / 8 : bx;
}
__device__ __forceinline__ const __attribute__((address_space(4))) Args* kargs_ptr() { auto p = __builtin_amdgcn_kernarg_segment_ptr(); asm volatile("" : "+s"(p)); return (const __attribute__((address_space(4))) Args*)p; }
#define KARGS (*kargs_ptr())
PHASE_FN void ph_pro0(LAS unsigned char* lds) { Frame F; make_frame(F, lds); p_pro0(F, KARGS); }
PHASE_FN void ph_pro2(LAS unsigned char* lds) { Frame F; make_frame(F, lds); p_pro2(F, KARGS); }
PHASE_FN void ph_inproj(LAS unsigned char* lds, int L) { Frame F; make_frame(F, lds); ArgsR A = KARGS;
    pg8::Gemm g{WSP(bf16, WS_HA), WSP(bf16, WS_WIN) + (size_t)L * 2048 * 1024, R, NPROJ, 1024}; pg8::StaticOrder S; S.init(R, NPROJ, F.G, (int)blockIdx.x);
    pg8::EpiStoreBf16 E{WSP(bf16, WS_PROJ), NPROJ, nullptr};
    pg8::gemm_phase<pg8::EpiStoreBf16, pg8::StaticOrder, true, true>(F.lds + RING_OFF, g, S, E);
    if (blockIdx.x >= 64) conv_rounds(F, A, L, 6, 49152); }
PHASE_FN void ph_qkpost(LAS unsigned char* lds, int L) { Frame F; make_frame(F, lds); p_qkpost(F, KARGS, L); }
PHASE_FN void ph_x1(LAS unsigned char* lds, int L) { Frame F; make_frame(F, lds); p_x1(F, KARGS, L); }
PHASE_FN void ph_attn(LAS unsigned char* lds, unsigned char* lds_generic, int L) { Frame F; make_frame(F, lds); p_attn(F, KARGS, L, lds_generic); }
PHASE_FN void ph_carry(LAS unsigned char* lds, int L) { Frame F; make_frame(F, lds); p_carry(F, KARGS); if (L == 1) { __syncthreads(); conv_rounds(F, KARGS, 1, 1 << 20, 49152); } }
PHASE_FN void ph_x3(LAS unsigned char* lds, int L) { Frame F; make_frame(F, lds); p_x3(F, KARGS, L); }
PHASE_FN void ph_outproj(LAS unsigned char* lds, int L) { Frame F; make_frame(F, lds); ArgsR A = KARGS;
    pg8::Gemm g{WSP(bf16, WS_MERGED), WSP(bf16, WS_WOUT) + (size_t)L * 1024 * 1024, R, 1024, 1024}; pg8::RowOrder S{L == 1, F.G, F.vcu};
    pg8::EpiStoreBf16 E{WSP(bf16, WS_YPRE), 1024, nullptr};
    pg8::gemm_phase<pg8::EpiStoreBf16, pg8::RowOrder, true, true>(F.lds + RING_OFF, g, S, E);
    if (L == 0 && F.vcu >= 32) conv_rounds(F, A, 0, 6, 49152); }
PHASE_FN void ph_ln1(LAS unsigned char* lds, int L) { Frame F; make_frame(F, lds); if (L == 0) conv_rounds(F, KARGS, 0, 1 << 20, 49152); p_ln1(F, KARGS, L); }
PHASE_FN void ph_topk(LAS unsigned char* lds, int L) { Frame F; make_frame(F, lds); p_topk(F, KARGS, L); }
PHASE_FN void ph_gemm1(LAS unsigned char* lds, int L) { Frame F; make_frame(F, lds); ArgsR A = KARGS;
    pg8::Gemm g{WSP(bf16, WS_HA), WSP(bf16, WS_WGU), RGROWS, 4096, 1024, WSP(int, WS_SRC)}; pg8::MoeOrder S{L == 0 ? 17 : 16, 16, F.G, F.vcu};
    pg8::EpiSwiGlu E{WSP(bf16, WS_HID), FF};
    pg8::gemm_phase<pg8::EpiSwiGlu, pg8::MoeOrder, true, true, true>(F.lds + RING_OFF, g, S, E); }
PHASE_FN void ph_gemm2(LAS unsigned char* lds, int L) { Frame F; make_frame(F, lds); ArgsR A = KARGS;
    pg8::Gemm g{WSP(bf16, WS_HID), WSP(bf16, WS_WD), RGROWS, 1024, FF}; pg8::MoeOrder S{L == 0 ? 17 : 16, 4, F.G, F.vcu};
    pg8::EpiStoreBf16 E{WSP(bf16, WS_YPRE), 1024, WSP(float, WS_GATE)};
    pg8::gemm_phase<pg8::EpiStoreBf16, pg8::MoeOrder, true, true>(F.lds + RING_OFF, g, S, E);
    if (L == 0 && F.vcu >= 64) { const int qmax = 32768 / (8 * (F.G > 64 ? F.G - 64 : 1)); conv_rounds(F, A, 1, qmax < 20 ? qmax : 20, 32768); } }
PHASE_FN void ph_ln2(LAS unsigned char* lds, int L) { Frame F; make_frame(F, lds); p_ln2(F, KARGS, L); }

__global__ void __launch_bounds__(NWAVES * 64, 2) mk_fwd(Args A) {
    extern __shared__ __attribute__((aligned(16))) unsigned char lds[];
    LAS unsigned char* L3 = (LAS unsigned char*)lds;
    volatile LAS unsigned* MISC = (volatile LAS unsigned*)(L3 + MISC_OFF);
    gu32* ctl = (gu32*)(A.ws + WS_CTL);
    for (int u = threadIdx.x; u < (LDS_BYTES - LDSCTL_OFF) / 4; u += NWAVES * 64) ((LAS unsigned*)(L3 + LDSCTL_OFF))[u] = 0u;
    __syncthreads();
    const int lo = A.ph_lo, hi = A.ph_hi;
    XcdBarrier bar; bar.bar = (unsigned*)(ctl + CW_BAR); bar.x = 0; bar.st = nullptr;
    if (hi - lo > 1) bar = xcd_barrier_post((unsigned*)(ctl + CW_BAR), MISC + 8);
#ifndef PHMASK
#define PHMASK 0xfffff
#endif
#define EN(bit) (((PHMASK) >> (bit)) & 1)
#ifndef DUPMASK
#define DUPMASK 0
#endif
#define DUP(bit, call) do { if (((DUPMASK) >> (bit)) & 1) { __syncthreads(); call; } } while (0)
#define IN(k) (lo <= (k) && (k) < hi)
#define SEAM(k) do { if (IN(k) && IN((k) + 1)) xcd_barrier(bar); else __syncthreads(); } while (0)
    if (EN(0) && IN(PH_PRO0)) { ph_pro0(L3); DUP(0, ph_pro0(L3)); } SEAM(PH_PRO0);
    if (EN(2) && IN(PH_PRO2)) { ph_pro2(L3); DUP(2, ph_pro2(L3)); } SEAM(PH_PRO2);
#pragma unroll 1
    for (int L = 0; L < 2; ++L) {
        const int pb = PH_L0 + PH_PER_LAYER * L;
        if (EN(3) && IN(pb + PL_INPROJ)) { ph_inproj(L3, L); DUP(3, ph_inproj(L3, L)); } SEAM(pb + PL_INPROJ);
        if (EN(4) && IN(pb + PL_QKPOST)) ph_qkpost(L3, L); SEAM(pb + PL_QKPOST);
        if (IN(pb + PL_MIX1)) { if (EN(15)) { ph_attn(L3, lds, L); DUP(15, ph_attn(L3, lds, L)); } __syncthreads(); if (EN(5)) ph_x1(L3, L); } SEAM(pb + PL_MIX1);
        if (EN(6) && IN(pb + PL_CARRY)) { ph_carry(L3, L); DUP(6, ph_carry(L3, L)); } SEAM(pb + PL_CARRY);
        if (EN(7) && IN(pb + PL_MIX3)) ph_x3(L3, L); SEAM(pb + PL_MIX3);
        if (EN(8) && IN(pb + PL_OUTPROJ)) { ph_outproj(L3, L); DUP(8, ph_outproj(L3, L)); } SEAM(pb + PL_OUTPROJ);
        if (EN(9) && IN(pb + PL_LN1)) { ph_ln1(L3, L); DUP(9, ph_ln1(L3, L)); } SEAM(pb + PL_LN1);
        if (EN(10) && IN(pb + PL_TOPK)) { ph_topk(L3, L); DUP(10, ph_topk(L3, L)); } SEAM(pb + PL_TOPK);
        if (EN(12) && IN(pb + PL_GEMM1)) { ph_gemm1(L3, L); DUP(12, ph_gemm1(L3, L)); } SEAM(pb + PL_GEMM1);
        if (EN(13) && IN(pb + PL_GEMM2)) { ph_gemm2(L3, L); DUP(13, ph_gemm2(L3, L)); } SEAM(pb + PL_GEMM2);
        if (EN(14) && IN(pb + PL_LN2)) { ph_ln2(L3, L); if (L == 1) DUP(14, ph_ln2(L3, L)); } SEAM(pb + PL_LN2);
    }
#undef IN
#undef SEAM
}

extern "C" void kernel_launch(void* const* d_in, const int* in_sizes, int n_in, void* d_out, int out_size, void* d_ws, size_t ws_size, hipStream_t stream) {
    static int grid = 0;
    if (grid == 0) {
        if (n_in != 33 || out_size != NB * NX * DMODEL || ws_size < WS_END) { fprintf(stderr, "kernel_launch: unexpected problem (n_in %d, out %d, ws %zu)\n", n_in, out_size, ws_size); grid = -1; return; }
        int dev = 0, cus = 0, per_cu = 0;
        if (hipGetDevice(&dev) != hipSuccess || hipDeviceGetAttribute(&cus, hipDeviceAttributeMultiprocessorCount, dev) != hipSuccess) { grid = -1; return; }
        if (hipFuncSetAttribute((const void*)mk_fwd, hipFuncAttributeMaxDynamicSharedMemorySize, LDS_BYTES) != hipSuccess) { fprintf(stderr, "kernel_launch: hipFuncSetAttribute failed\n"); grid = -1; return; }
        if (hipOccupancyMaxActiveBlocksPerMultiprocessor(&per_cu, (const void*)mk_fwd, NWAVES * 64, LDS_BYTES) != hipSuccess || per_cu < 1) fprintf(stderr, "kernel_launch: occupancy query reports %d\n", per_cu);
        (void)hipGetLastError();
        grid = cus;
    }
    if (grid < 0) return;
    if (hipMemsetAsync((char*)d_ws + WS_CTL, 0, CTL_ZERO_BYTES, stream) != hipSuccess) return;
    Args a{};
    for (int i = 0; i < 33; ++i) a.in[i] = (const float*)d_in[i];
    a.out = (float*)d_out; a.ws = (unsigned char*)d_ws;
#if MK_PER_PHASE
    for (int p = 0; p < N_PHASES; ++p) { a.ph_lo = p; a.ph_hi = p + 1; hipLaunchKernelGGL(mk_fwd, dim3(grid), dim3(NWAVES * 64), LDS_BYTES, stream, a); }
#else
    a.ph_lo = 0; a.ph_hi = N_PHASES; hipLaunchKernelGGL(mk_fwd, dim3(grid), dim3(NWAVES * 64), LDS_BYTES, stream, a);
#endif
}
```

```cpp
#include <hip/hip_runtime.h>
#include <hip/hip_bf16.h>
#include <cstdio>
#include <cstdint>
#include <cmath>
namespace pg8 {
#define PG8_LAS __attribute__((address_space(3)))
typedef unsigned short bf16_t;
typedef short bf16x8 __attribute__((ext_vector_type(8)));
typedef float f32x4 __attribute__((ext_vector_type(4)));
typedef unsigned u32x4 __attribute__((ext_vector_type(4)));
constexpr int BM = 256, BK = 64, HALF = 128, HTB = HALF * BK * 2  , STAGE_BYTES = 8 * HTB, NXCD = 8, WGM = 8;

__host__ __device__ __forceinline__ int lds_byte(int r, int c) { const int st = (r >> 4) * 2 + (c >> 5), rr = r & 15, cc = c & 31, ob = rr * 64 + cc * 2; return st * 1024 + (ob ^ (((ob >> 9) & 1) << 5)); }
__host__ __device__ __forceinline__ void stage_rc(int b, int& R, int& C) { const int st = b / 1024, sb = b % 1024, swz = sb ^ (((sb >> 9) & 1) << 5); R = (st >> 1) * 16 + swz / 64; C = (st & 1) * 32 + (swz % 64) / 2; }
__host__ __device__ __forceinline__ int perm32(int rho) { const int n = rho >> 4, i = rho & 15; return 8 * (i >> 2) + 4 * n + (i & 3); }

struct Unit { int pm, pn, pa, pb; };
struct Gemm { const bf16_t* A; const bf16_t* Bt; int M, N, K; const int* rowsrc = nullptr; };

struct StaticOrder {
    int nM, nN, nwg, G, c;
    __host__ __device__ void init(int M, int N, int G_, int c_) { nM = M / BM; nN = N / BM; nwg = nM * nN; G = G_; c = c_; }
    __host__ __device__ bool next(int i, Unit& u) const {
        const long L = (long)i * G + c; if (L >= nwg) return false;
        int wgid = (int)L; { const int q = nwg / NXCD, r = nwg % NXCD, xcd = wgid % NXCD, off = wgid / NXCD; wgid = (xcd < r ? xcd * (q + 1) : r * (q + 1) + (xcd - r) * q) + off; }
        const int nig = WGM * nN, gid = wgid / nig, fm = gid * WGM, gsz = (nM - fm) < WGM ? (nM - fm) : WGM;
        u.pm = fm + ((wgid % nig) % gsz); u.pn = (wgid % nig) / gsz; u.pa = u.pm; u.pb = u.pn; return true;
    }
    __device__ __forceinline__ void a_ready(const Unit&) const {}
    __device__ __forceinline__ void done(const Unit&) const {}
};

__device__ __forceinline__ unsigned cvt_pk_bf16(float lo, float hi) { unsigned r; asm volatile("v_cvt_pk_bf16_f32 %0, %1, %2" : "=v"(r) : "v"(lo), "v"(hi)); return r; }
__device__ __forceinline__ float silu_f(float x) { return x * __builtin_amdgcn_rcpf(1.f + __builtin_amdgcn_exp2f(x * -1.4426950408889634f)); }
struct EpiStoreBf16 {
    static constexpr bool PERM = true, AFTER_DRAIN = false;
    bf16_t* O; int ldc; const float* rowscale;
    __device__ __forceinline__ void operator()(const f32x4 (&acc)[2][2][4][2], const Unit& u, int wr, int wc, int fr, int fq) const {
        const int row0 = u.pm * BM + wr * 64 + fr; const int col0 = u.pn * BM + wc * 32 + 8 * fq;
#pragma unroll
        for (int ai = 0; ai < 2; ++ai)
#pragma unroll
            for (int m = 0; m < 4; ++m) { const int row = row0 + ai * HALF + m * 16; bf16_t* rowp = O + (size_t)row * ldc + col0;
                const float sc = rowscale ? rowscale[row] : 1.f;
#pragma unroll
                for (int bj = 0; bj < 2; ++bj) { const f32x4 v0 = acc[ai][bj][m][0] * sc, v1 = acc[ai][bj][m][1] * sc;
                    u32x4 w; w.x = cvt_pk_bf16(v0[0], v0[1]); w.y = cvt_pk_bf16(v0[2], v0[3]); w.z = cvt_pk_bf16(v1[0], v1[1]); w.w = cvt_pk_bf16(v1[2], v1[3]);
                    *(u32x4*)(rowp + bj * HALF) = w; } }
    }
};
struct EpiSwiGlu {
    static constexpr bool PERM = false, AFTER_DRAIN = false;
    bf16_t* O; int ldc;
    __device__ __forceinline__ void operator()(const f32x4 (&acc)[2][2][4][2], const Unit& u, int wr, int wc, int fr, int fq) const {
#pragma unroll
        for (int ai = 0; ai < 2; ++ai)
#pragma unroll
            for (int m = 0; m < 4; ++m) { const int row = u.pm * BM + ai * HALF + wr * 64 + m * 16 + fr; const int col = u.pn * 128 + wc * 32 + 8 * fq;
                const f32x4 g0 = acc[ai][0][m][0], u0 = acc[ai][0][m][1], g1 = acc[ai][1][m][0], u1 = acc[ai][1][m][1];
                u32x4 w; w.x = cvt_pk_bf16(silu_f(g0[0]) * u0[0], silu_f(g0[1]) * u0[1]); w.y = cvt_pk_bf16(silu_f(g0[2]) * u0[2], silu_f(g0[3]) * u0[3]);
                w.z = cvt_pk_bf16(silu_f(g1[0]) * u1[0], silu_f(g1[1]) * u1[1]); w.w = cvt_pk_bf16(silu_f(g1[2]) * u1[2], silu_f(g1[3]) * u1[3]);
                *(u32x4*)(O + (size_t)row * ldc + col) = w; }
    }
};
struct EpiResid {
    static constexpr bool PERM = false, AFTER_DRAIN = false;
    const float* xres; float* out; const float* g1base; float alpha;
    __device__ __forceinline__ void operator()(const f32x4 (&acc)[2][2][4][2], const Unit& u, int wr, int wc, int fr, int fq) const {
        const int mrow = (u.pm % 17 == 0) ? 8 : (u.pm / 17); const float* g1 = g1base + (size_t)mrow * 6144;
        const int col0 = u.pn * BM + wc * 32 + 4 * fq;
        f32x4 gv[2][2];
#pragma unroll
        for (int bj = 0; bj < 2; ++bj)
#pragma unroll
            for (int n = 0; n < 2; ++n) gv[bj][n] = *(const f32x4*)(g1 + col0 + bj * HALF + n * 16);
#pragma unroll
        for (int ai = 0; ai < 2; ++ai)
#pragma unroll
            for (int m = 0; m < 4; ++m) { const size_t off = (size_t)(u.pm * BM + ai * HALF + wr * 64 + m * 16 + fr) * 1024 + col0;
#pragma unroll
                for (int bj = 0; bj < 2; ++bj)
#pragma unroll
                    for (int n = 0; n < 2; ++n) { const f32x4 xr = *(const f32x4*)(xres + off + bj * HALF + n * 16);
                        *(f32x4*)(out + off + bj * HALF + n * 16) = acc[ai][bj][m][n] * gv[bj][n] + xr * alpha; } }
    }
};
struct RowOrder {
    bool xonly; int G, c;
    __device__ __forceinline__ bool next(int i, Unit& u) const {
        const long L = (long)i * G + c; const int ntiles = xonly ? 128 : 136; if (L >= (long)ntiles * 4) return false;
        const int U = (int)L, xt = U >> 2; u.pm = xonly ? (xt >> 4) * 17 + 1 + (xt & 15) : xt; u.pn = U & 3; u.pa = u.pm; u.pb = u.pn; return true;
    }
    __device__ __forceinline__ void a_ready(const Unit&) const {}
    __device__ __forceinline__ void done(const Unit&) const {}
};
struct MoeOrder {
    int MT, NTB, G, c;
    __device__ __forceinline__ bool next(int i, Unit& u) const {
        const long L = (long)i * G + c; if (L >= (long)16 * MT * NTB) return false;
        const int U = (int)L, per = MT * NTB, e = U / per, rem = U % per; int mt = rem / NTB, nt = rem % NTB;
        if (MT == 16 && NTB == 16) { const int x = rem >> 5, sl = rem & 31; mt = 4 * (x >> 1) + (sl >> 3); nt = 8 * (x & 1) + (sl & 7); }
        u.pa = e * 17 + mt; u.pb = e * NTB + nt; u.pm = u.pa; u.pn = nt; return true;
    }
    __device__ __forceinline__ void a_ready(const Unit&) const {}
    __device__ __forceinline__ void done(const Unit&) const {}
};
template <class Epi, class Sched, bool ALIGN_EPI = false, bool SP2 = false, bool GATHER = false>
__device__ __forceinline__ void gemm_phase(PG8_LAS unsigned char* lds, const Gemm g, const Sched& S, const Epi& E) {
    int tid_ = threadIdx.x; asm volatile("" : "+v"(tid_));
    const int tid = tid_, wid = __builtin_amdgcn_readfirstlane(tid >> 6), lane = tid & 63, wr = wid >> 2, wc = wid & 3, fr = lane & 15, fq = lane >> 4;
    const int K = g.K, nt = K / BK;
    static_assert(!GATHER || SP2, "the gathered A path is written for the SP2 loop only");
    unsigned voffA[2], voffB[2], ccol[2] = {0u, 0u}; int rrow[2] = {0, 0};
#pragma unroll
    for (int i = 0; i < 2; ++i) { int R, C; stage_rc(tid * 16 + i * 8192, R, C); const int Rb = Epi::PERM ? ((R & ~31) + perm32(R & 31)) : R;
        voffA[i] = (unsigned)(R * K + C) * 2u; voffB[i] = (unsigned)(Rb * K + C) * 2u; ccol[i] = (unsigned)C * 2u; rrow[i] = R; }
    const size_t kstep = (size_t)(BK * 2);
    const size_t hstep = (size_t)HALF * K * 2;
    const size_t tstep = 2 * hstep;
    const unsigned ldsw = (unsigned)wid * 1024u;
    const int aoff = lds_byte(wr * 64 + fr, fq * 8), boff = lds_byte(wc * 32 + fr, fq * 8);
#define PG8_SA(b, h) (((b) * 2 + (h)) * HTB)
#define PG8_SB(b, h) ((4 + (b) * 2 + (h)) * HTB)
    const char* gA = (const char*)g.A; PG8_LAS unsigned* idxl = (PG8_LAS unsigned*)(lds + STAGE_BYTES);
#define PG8_IDX(buf, hi) (idxl[((buf) * 4 + (hi)) * 512 + wid * 64 + lane])
#define PG8_STA(bufoff, gbase, gptr, w0, w1) do { if constexpr (GATHER) { const unsigned vo_[2] = {(w0) * (unsigned)(K * 2) + ccol[0], (w1) * (unsigned)(K * 2) + ccol[1]}; PG8_STAGE(bufoff, gptr, vo_); } else { PG8_STAGE(bufoff, gbase, voffA); } } while (0)
#define PG8_WAIT_VX() do { if constexpr (GATHER) asm volatile("s_waitcnt vmcnt(12)" ::: "memory"); else asm volatile("s_waitcnt vmcnt(8)" ::: "memory"); } while (0)
#define PG8_STAGE(bufoff, gbase, voff) do { _Pragma("unroll") for (int _i = 0; _i < 2; ++_i) \
        __builtin_amdgcn_global_load_lds((const unsigned*)((const char*)(gbase) + (voff)[_i]), (PG8_LAS unsigned*)(lds + (bufoff) + ldsw + _i * 8192), 16, 0, 0); } while (0)
#define PG8_LDA(dst, b, h) do { _Pragma("unroll") for (int m = 0; m < 4; ++m) _Pragma("unroll") for (int k = 0; k < 2; ++k) dst[m][k] = *(const PG8_LAS bf16x8*)(lds + PG8_SA(b, h) + aoff + m * 2048 + k * 1024); } while (0)
#define PG8_LDB(dst, b, h) do { _Pragma("unroll") for (int n = 0; n < 2; ++n) _Pragma("unroll") for (int k = 0; k < 2; ++k) dst[n][k] = *(const PG8_LAS bf16x8*)(lds + PG8_SB(b, h) + boff + n * 2048 + k * 1024); } while (0)
#define PG8_MMA(ai, bj, At, Bt) do { __builtin_amdgcn_s_setprio(1); _Pragma("unroll") for (int m = 0; m < 4; ++m) _Pragma("unroll") for (int n = 0; n < 2; ++n) _Pragma("unroll") for (int k = 0; k < 2; ++k) \
        acc[ai][bj][m][n] = __builtin_amdgcn_mfma_f32_16x16x32_bf16(Bt[n][k], At[m][k], acc[ai][bj][m][n], 0, 0, 0); __builtin_amdgcn_s_setprio(0); } while (0)
#define PG8_WAIT_V(n) asm volatile("s_waitcnt vmcnt(" #n ")" ::: "memory")
#define PG8_WAIT_L(n) asm volatile("s_waitcnt lgkmcnt(" #n ")" ::: "memory")
#define PG8_BAR __builtin_amdgcn_s_barrier()
#define PG8_SCHED __builtin_amdgcn_sched_barrier(0)
    Unit cur, nxt; int ui = 0;
    if (!S.next(0, cur)) return;
    f32x4 acc[2][2][4][2];
#pragma unroll
    for (int a = 0; a < 2; ++a)
#pragma unroll
        for (int b = 0; b < 2; ++b)
#pragma unroll
            for (int m = 0; m < 4; ++m)
#pragma unroll
                for (int n = 0; n < 2; ++n) acc[a][b][m][n] = (f32x4){0.f, 0.f, 0.f, 0.f};
    bf16x8 At[4][2], B0[2][2], B1[2][2];
    const char* cA = (const char*)g.A + (size_t)cur.pa * tstep; const char* cB = (const char*)g.Bt + (size_t)cur.pb * tstep;
    unsigned w00 = 0u, w01 = 0u, w10 = 0u, w11 = 0u;
    if constexpr (GATHER) { const int* rs = g.rowsrc + (size_t)cur.pa * 256; w00 = (unsigned)rs[rrow[0]]; w01 = (unsigned)rs[rrow[1]]; w10 = (unsigned)rs[128 + rrow[0]]; w11 = (unsigned)rs[128 + rrow[1]];
        PG8_IDX(0, 0) = w00; PG8_IDX(0, 1) = w01; PG8_IDX(0, 2) = w10; PG8_IDX(0, 3) = w11; }
    S.a_ready(cur);
    if constexpr (SP2) {
        PG8_STAGE(PG8_SB(0, 0), cB, voffB); PG8_STAGE(PG8_SB(0, 1), cB + hstep, voffB); PG8_STA(PG8_SA(0, 0), cA, gA, w00, w01); PG8_STA(PG8_SA(0, 1), cA + hstep, gA, w10, w11);
        if (wr == 1) PG8_BAR;
        PG8_WAIT_V(2); PG8_BAR;
        PG8_STAGE(PG8_SB(1, 0), cB + kstep, voffB); PG8_STA(PG8_SA(1, 0), cA + kstep, gA + kstep, w00, w01); PG8_STAGE(PG8_SB(1, 1), cB + hstep + kstep, voffB);
        PG8_WAIT_V(6); PG8_BAR;
    } else {
        PG8_STAGE(PG8_SB(0, 0), cB, voffB); PG8_STAGE(PG8_SA(0, 0), cA, voffA); PG8_STAGE(PG8_SB(0, 1), cB + hstep, voffB); PG8_STAGE(PG8_SA(0, 1), cA + hstep, voffA);
        if (wr == 1) PG8_BAR;
        PG8_WAIT_V(4); PG8_BAR;
        PG8_STAGE(PG8_SB(1, 0), cB + kstep, voffB); PG8_STAGE(PG8_SA(1, 0), cA + kstep, voffA); PG8_STAGE(PG8_SB(1, 1), cB + hstep + kstep, voffB);
        PG8_WAIT_V(6); PG8_BAR;
    }
    for (;;) {
        const bool has_next = S.next(ui + 1, nxt);
        const char* nA = has_next ? (const char*)g.A + (size_t)nxt.pa * tstep : cA; const char* nB = has_next ? (const char*)g.Bt + (size_t)nxt.pb * tstep : cB;
        for (int t = 0; t < nt; t += 2) {
            const bool last = (t == nt - 2);
            const char* a1 = cA + (size_t)(t + 1) * kstep;
            const char* a2 = last ? nA : cA + (size_t)(t + 2) * kstep; const char* b2 = last ? nB : cB + (size_t)(t + 2) * kstep;
            const char* a3 = a2 + kstep; const char* b3 = b2 + kstep;
            if (last && has_next) S.a_ready(nxt);
            const int cbuf = ui & 1, xbuf = (last && has_next) ? (cbuf ^ 1) : cbuf;
            const char* ga1 = gA + (size_t)(t + 1) * kstep; const char* ga2 = last ? gA : gA + (size_t)(t + 2) * kstep; const char* ga3 = ga2 + kstep;
            unsigned c10 = 0u, c11 = 0u, x00 = 0u, x01 = 0u, x10 = 0u, x11 = 0u;
            if constexpr (GATHER) {
                { const int* rs = g.rowsrc + (size_t)(has_next ? nxt.pa : cur.pa) * 256;
                    __builtin_amdgcn_global_load_lds((const unsigned*)(rs + rrow[0]), &PG8_IDX(cbuf ^ 1, 0) - lane, 4, 0, 0); __builtin_amdgcn_global_load_lds((const unsigned*)(rs + rrow[1]), &PG8_IDX(cbuf ^ 1, 1) - lane, 4, 0, 0);
                    __builtin_amdgcn_global_load_lds((const unsigned*)(rs + 128 + rrow[0]), &PG8_IDX(cbuf ^ 1, 2) - lane, 4, 0, 0); __builtin_amdgcn_global_load_lds((const unsigned*)(rs + 128 + rrow[1]), &PG8_IDX(cbuf ^ 1, 3) - lane, 4, 0, 0); }
                c10 = PG8_IDX(cbuf, 2); c11 = PG8_IDX(cbuf, 3); x00 = PG8_IDX(xbuf, 0); x01 = PG8_IDX(xbuf, 1); x10 = PG8_IDX(xbuf, 2); x11 = PG8_IDX(xbuf, 3);
            }
            if constexpr (SP2) {
            PG8_LDB(B0, 0, 0); PG8_LDB(B1, 0, 1); PG8_SCHED; PG8_LDA(At, 0, 0); PG8_STA(PG8_SA(1, 1), a1 + hstep, ga1, c10, c11);
            PG8_WAIT_VX(); PG8_WAIT_L(0); PG8_BAR; PG8_MMA(0, 0, At, B0); PG8_MMA(0, 1, At, B1); PG8_BAR; PG8_SCHED;
            PG8_LDA(At, 0, 1); PG8_STAGE(PG8_SB(0, 0), b2, voffB); PG8_STAGE(PG8_SB(0, 1), b2 + hstep, voffB); PG8_STA(PG8_SA(0, 0), a2, ga2, x00, x01);
            PG8_WAIT_VX(); PG8_WAIT_L(0); PG8_BAR; PG8_MMA(1, 0, At, B0); PG8_MMA(1, 1, At, B1); PG8_BAR; PG8_SCHED;
            PG8_LDB(B0, 1, 0); PG8_LDB(B1, 1, 1); PG8_SCHED; PG8_LDA(At, 1, 0); PG8_STA(PG8_SA(0, 1), a2 + hstep, ga2, x10, x11);
            PG8_WAIT_V(8); PG8_WAIT_L(0); PG8_BAR; PG8_MMA(0, 0, At, B0); PG8_MMA(0, 1, At, B1); PG8_BAR; PG8_SCHED;
            PG8_LDA(At, 1, 1); PG8_STAGE(PG8_SB(1, 0), b3, voffB); PG8_STAGE(PG8_SB(1, 1), b3 + hstep, voffB); PG8_STA(PG8_SA(1, 0), a3, ga3, x00, x01);
            PG8_WAIT_V(8); PG8_WAIT_L(0); PG8_BAR; PG8_MMA(1, 0, At, B0); PG8_MMA(1, 1, At, B1); PG8_BAR; PG8_SCHED;
            } else {
            PG8_LDB(B0, 0, 0); PG8_SCHED; PG8_LDA(At, 0, 0); PG8_STAGE(PG8_SA(1, 1), a1 + hstep, voffA);
            PG8_WAIT_L(8); PG8_BAR; PG8_WAIT_L(0); PG8_MMA(0, 0, At, B0); PG8_BAR; PG8_SCHED;
            PG8_LDB(B1, 0, 1); PG8_STAGE(PG8_SB(0, 0), b2, voffB);
            PG8_BAR; PG8_WAIT_L(0); PG8_MMA(0, 1, At, B1); PG8_BAR;
            PG8_LDA(At, 0, 1); PG8_STAGE(PG8_SA(0, 0), a2, voffA);
            PG8_BAR; PG8_WAIT_L(0); PG8_MMA(1, 0, At, B0); PG8_BAR; PG8_SCHED;
            PG8_STAGE(PG8_SB(0, 1), b2 + hstep, voffB);
            PG8_WAIT_V(6); PG8_BAR; PG8_MMA(1, 1, At, B1); PG8_BAR;
            PG8_LDB(B0, 1, 0); PG8_SCHED; PG8_LDA(At, 1, 0); PG8_STAGE(PG8_SA(0, 1), a2 + hstep, voffA);
            PG8_WAIT_L(8); PG8_BAR; PG8_WAIT_L(0); PG8_MMA(0, 0, At, B0); PG8_BAR; PG8_SCHED;
            PG8_LDB(B1, 1, 1); PG8_STAGE(PG8_SB(1, 0), b3, voffB);
            PG8_BAR; PG8_WAIT_L(0); PG8_MMA(0, 1, At, B1); PG8_BAR;
            PG8_LDA(At, 1, 1); PG8_STAGE(PG8_SA(1, 0), a3, voffA);
            PG8_BAR; PG8_WAIT_L(0); PG8_MMA(1, 0, At, B0); PG8_BAR; PG8_SCHED;
            PG8_STAGE(PG8_SB(1, 1), b3 + hstep, voffB);
            PG8_WAIT_V(6); PG8_BAR; PG8_MMA(1, 1, At, B1); PG8_BAR;
            }
        }
        if constexpr (ALIGN_EPI) { if (wr == 0) PG8_BAR; }
        if constexpr (!Epi::AFTER_DRAIN) { E(acc, cur, wr, wc, fr, fq); S.done(cur); }
        if (!has_next) break;
#pragma unroll
        for (int a = 0; a < 2; ++a)
#pragma unroll
            for (int b = 0; b < 2; ++b)
#pragma unroll
                for (int m = 0; m < 4; ++m)
#pragma unroll
                    for (int n = 0; n < 2; ++n) acc[a][b][m][n] = (f32x4){0.f, 0.f, 0.f, 0.f};
        cur = nxt; cA = nA; cB = nB; ++ui;
        if constexpr (ALIGN_EPI) { if (wr == 1) PG8_BAR; }
    }
    PG8_WAIT_V(0);
    if constexpr (!ALIGN_EPI) { if (wr == 0) PG8_BAR; }
    PG8_BAR;
    if constexpr (Epi::AFTER_DRAIN) { E.fused(acc, cur, wr, wc, fr, fq, lds, wid, lane); S.done(cur); }
#undef PG8_SA
#undef PG8_SB
#undef PG8_STAGE
#undef PG8_STA
#undef PG8_IDX
#undef PG8_WAIT_VX
#undef PG8_LDA
#undef PG8_LDB
#undef PG8_MMA
#undef PG8_WAIT_V
#undef PG8_WAIT_L
#undef PG8_BAR
#undef PG8_SCHED
}
}
namespace attn_body {
using bf16=__hip_bfloat16;
using bf16x8=__attribute__((ext_vector_type(8)))short;
using s16x4=__attribute__((ext_vector_type(4)))short;
using f32x16=__attribute__((ext_vector_type(16)))float;
using u32x4=__attribute__((ext_vector_type(4)))unsigned;
constexpr int D=64,DM=2048,DMK=128,LBROWS=4352;
constexpr int NW=8,QBLK=32,QB=QBLK*NW,KVBLK=64;
__device__ __forceinline__ int crow(int r,int hi){return (r&3)+8*(r>>2)+4*hi;}
#define SBAR() __builtin_amdgcn_sched_barrier(0)
__device__ __forceinline__ void cmask(f32x16&p0,f32x16&p1,int jb,int qrel,int hi){
  const float NEG=-INFINITY; int kb=64*jb+4*hi;
  #pragma unroll
  for(int r=0;r<16;++r){int kv=kb+(r&3)+8*(r>>2); if(kv>qrel)p0[r]=NEG; if(kv+32>qrel)p1[r]=NEG;}
}

constexpr int NSLOT=3, SLOTB=8192;
constexpr int LDS_K=0, LDS_V=NSLOT*SLOTB, LDS_WS=2*NSLOT*SLOTB, LDS_OST=LDS_WS+NW*64*4, LDS_BYTES=LDS_OST+NW*4096;
constexpr float C2=0.125f*1.4426950408889634f;
__device__ __forceinline__ void glds16(const void*gsrc,unsigned lds_dst){unsigned keep;
  asm volatile("s_mov_b32 %0, m0\n\ts_mov_b32 m0, %2\n\ts_nop 0\n\tglobal_load_lds_dwordx4 %1, off\n\ts_mov_b32 m0, %0":"=&s"(keep):"v"(gsrc),"s"(lds_dst):"memory");}
__device__ __forceinline__ float max3f(float a,float b,float c){float r;asm("v_max3_f32 %0, %1, %2, %3":"=v"(r):"v"(a),"v"(b),"v"(c));return r;}
__device__ __forceinline__ float max2f(float a,float b){float r;asm("v_max_f32_e32 %0, %1, %2":"=v"(r):"v"(a),"v"(b));return r;}
__device__ __forceinline__ float fadd_s(float a,float b){float r;asm("v_add_f32_e32 %0, %1, %2":"=v"(r):"v"(a),"v"(b));return r;}
__device__ __forceinline__ float fsub_s(float a,float b){float r;asm("v_sub_f32_e32 %0, %1, %2":"=v"(r):"v"(a),"v"(b));return r;}
typedef float f32x2_t __attribute__((ext_vector_type(2))); typedef __bf16 bf16x2_t __attribute__((ext_vector_type(2)));
__device__ __forceinline__ unsigned cvtpk_s(float lo,float hi){f32x2_t v={lo,hi};bf16x2_t b=__builtin_convertvector(v,bf16x2_t);return __builtin_bit_cast(unsigned,b);}
#define WAIT_BAR(N) asm volatile("s_waitcnt vmcnt(" #N ") lgkmcnt(0)\n\ts_barrier":::"memory")

__device__ __forceinline__ void qkt(f32x16&p0,f32x16&p1,const char*Kslot,const bf16x8*qr,const f32x16&negm,int r32,int hi){
  const char*kb=Kslot+hi*1024+r32*16;
  #pragma unroll
  for(int d0=0;d0<4;++d0){
    const bf16x8 b0=*reinterpret_cast<const bf16x8*>(kb+d0*2048);
    const bf16x8 b1=*reinterpret_cast<const bf16x8*>(kb+d0*2048+512);
    if(d0==0){p0=__builtin_amdgcn_mfma_f32_32x32x16_bf16(b0,qr[0],negm,0,0,0);p1=__builtin_amdgcn_mfma_f32_32x32x16_bf16(b1,qr[0],negm,0,0,0);}
    else{p0=__builtin_amdgcn_mfma_f32_32x32x16_bf16(b0,qr[d0],p0,0,0,0);p1=__builtin_amdgcn_mfma_f32_32x32x16_bf16(b1,qr[d0],p1,0,0,0);}}
}
typedef __attribute__((address_space(3))) const char* lds_cptr;
typedef short v4i16_t __attribute__((ext_vector_type(4)));
__device__ __forceinline__ void kload8(bf16x8*kf,lds_cptr kp){
  kf[0]=*(const __attribute__((address_space(3))) bf16x8*)(kp);      kf[1]=*(const __attribute__((address_space(3))) bf16x8*)(kp+512);
  kf[2]=*(const __attribute__((address_space(3))) bf16x8*)(kp+2048); kf[3]=*(const __attribute__((address_space(3))) bf16x8*)(kp+2560);
  kf[4]=*(const __attribute__((address_space(3))) bf16x8*)(kp+4096); kf[5]=*(const __attribute__((address_space(3))) bf16x8*)(kp+4608);
  kf[6]=*(const __attribute__((address_space(3))) bf16x8*)(kp+6144); kf[7]=*(const __attribute__((address_space(3))) bf16x8*)(kp+6656);
}
__device__ __forceinline__ void kload2(bf16x8*kf,lds_cptr kp,int j){ kf[2*j]=*(const __attribute__((address_space(3))) bf16x8*)(kp+j*2048); kf[2*j+1]=*(const __attribute__((address_space(3))) bf16x8*)(kp+j*2048+512); }
__device__ __forceinline__ s16x4 vtr(lds_cptr p){ return __builtin_bit_cast(s16x4,__builtin_amdgcn_ds_read_tr16_b64_v4i16((__attribute__((address_space(3))) v4i16_t*)p)); }
__device__ __forceinline__ float rowmax(const f32x16&p0,const f32x16&p1){
  float a=max3f(p0[0],p0[1],p1[0]),b=max3f(p0[2],p0[3],p1[1]);a=max3f(a,p1[2],p1[3]);
  #pragma unroll
  for(int r=4;r<16;r+=4){a=max3f(a,p0[r],p0[r+1]);b=max3f(b,p0[r+2],p0[r+3]);a=max3f(a,p1[r],p1[r+1]);b=max3f(b,p1[r+2],p1[r+3]);}
  const float m=max2f(a,b);
  auto rr=__builtin_amdgcn_permlane32_swap(__float_as_uint(m),__float_as_uint(m),false,false);
  return max2f(__uint_as_float(rr[0]),__uint_as_float(rr[1]));
}
__device__ __forceinline__ void pv(f32x16*o,int vb,bf16x8 pa0,bf16x8 pa1,bf16x8 pa2,bf16x8 pa3){
  #pragma unroll
  for(int d0=0;d0<2;++d0){s16x4 lo[4],hi[4];
    #pragma unroll
    for(int ks=0;ks<4;++ks){
      asm volatile("ds_read_b64_tr_b16 %0,%1 offset:%c2":"=&v"(lo[ks]):"v"(vb),"i"(d0*4096+ks*1024):"memory");
      asm volatile("ds_read_b64_tr_b16 %0,%1 offset:%c2":"=&v"(hi[ks]):"v"(vb),"i"(d0*4096+ks*1024+512):"memory");}
    asm volatile("s_waitcnt lgkmcnt(0)":::"memory");SBAR();
    #define PK(k) (bf16x8){lo[k][0],lo[k][1],lo[k][2],lo[k][3],hi[k][0],hi[k][1],hi[k][2],hi[k][3]}
    o[d0]=__builtin_amdgcn_mfma_f32_32x32x16_bf16(pa0,PK(0),o[d0],0,0,0);
    o[d0]=__builtin_amdgcn_mfma_f32_32x32x16_bf16(pa1,PK(1),o[d0],0,0,0);
    o[d0]=__builtin_amdgcn_mfma_f32_32x32x16_bf16(pa2,PK(2),o[d0],0,0,0);
    o[d0]=__builtin_amdgcn_mfma_f32_32x32x16_bf16(pa3,PK(3),o[d0],0,0,0);
    #undef PK
  }
}

#ifndef ATTN_STORE16
#define ATTN_STORE16(p,v) (*(u32x4*)(p)=(v))
#endif
template<int THRL> __device__ __forceinline__ void attn_unit(int b,int h,int q0,int NT,const bf16*P,const bf16*KC,const bf16*VC,bf16*OB,const float*qnw,const float*rope,char*shm){
  int tid_=threadIdx.x; asm volatile("":"+v"(tid_)); const int tid=tid_,lane=tid&63,r32=lane&31,hi=lane>>5; const int wid=__builtin_amdgcn_readfirstlane(tid>>6);
  const long rowbase=(long)b*LBROWS;
  const bf16*Qw=P+(rowbase+q0+wid*QBLK)*DM+h*D;
  const bf16*Kh=KC+((long)b*(LBROWS/64)*2+(h>>2))*4096,*Vh=VC+((long)b*(LBROWS/64)*2+(h>>2))*4096;
  const unsigned lds0=(unsigned)(uintptr_t)shm;
  float*wsf=(float*)(shm+LDS_WS)+wid*64;
  const bf16*ksrc=Kh+(wid*64+lane)*8;
  const bf16*vsrc=Vh+(wid*64+lane)*8;
  const unsigned kdst=lds0+LDS_K+wid*1024, vdst=lds0+LDS_V+wid*1024;
  #define DMA_K(t,slot) glds16(ksrc+(long)(t)*8192,(unsigned)__builtin_amdgcn_readfirstlane(kdst+(slot)))
  #define DMA_V(t,slot) glds16(vsrc+(long)(t)*8192,(unsigned)__builtin_amdgcn_readfirstlane(vdst+(slot)))
  const int vb0=(int)(lds0+LDS_V)+((lane>>4)&1)*32+(lane&3)*8+(4*hi+((lane&15)>>2))*64;
  const char*Kbase=shm+LDS_K; bf16x8 kf[8];
  const lds_cptr shm3=(lds_cptr)shm; const lds_cptr kp0=shm3+LDS_K+hi*1024+r32*16; const lds_cptr vp0=shm3+LDS_V+((lane>>4)&1)*32+(lane&3)*8+(4*hi+((lane&15)>>2))*64;
  DMA_K(0,0);DMA_V(0,0);DMA_K(1,SLOTB);
  bf16x8 qr[4];
  #pragma unroll
  for(int d0=0;d0<4;++d0)qr[d0]=*reinterpret_cast<const bf16x8*>(&Qw[(long)r32*DM+d0*16+hi*8]);
  {
    float e[4][8]; float ss=0.f;
    #pragma unroll
    for(int d0=0;d0<4;++d0){
      #pragma unroll
      for(int j=0;j<8;++j){ e[d0][j]=__uint_as_float((unsigned)(unsigned short)qr[d0][j]<<16); ss+=e[d0][j]*e[d0][j]; } }
    ss+=__shfl_xor(ss,32);
    const float rs=1.f/sqrtf(ss*(1.f/64.f)+1e-6f);
    #pragma unroll
    for(int d0=0;d0<4;++d0){ const float*wp=qnw+16*d0+8*hi;
      #pragma unroll
      for(int j=0;j<8;++j) e[d0][j]*=rs*wp[j]; }
    if(q0>=256){ const int t=q0-256+wid*QBLK+r32; const float*rr=rope+((t>>6)*16+8*hi)*2,*rc=rope+((t&63)*16+8*hi)*2;
      #pragma unroll
      for(int j=0;j<8;++j){ const float cr=rr[2*j],sr=rr[2*j+1],cc=rc[2*j],sc=rc[2*j+1];
        const float a0=e[0][j],a1=e[1][j],a2=e[2][j],a3=e[3][j];
        e[0][j]=a0*cr-a1*sr; e[1][j]=a1*cr+a0*sr; e[2][j]=a2*cc-a3*sc; e[3][j]=a3*cc+a2*sc; } }
    #pragma unroll
    for(int d0=0;d0<4;++d0){ u32x4 w; w[0]=cvtpk_s(e[d0][0]*C2,e[d0][1]*C2); w[1]=cvtpk_s(e[d0][2]*C2,e[d0][3]*C2); w[2]=cvtpk_s(e[d0][4]*C2,e[d0][5]*C2); w[3]=cvtpk_s(e[d0][6]*C2,e[d0][7]*C2); qr[d0]=__builtin_bit_cast(bf16x8,w); }
  }
  float mhat=0.f,l_reg=0.f;f32x16 o[2];o[0]=f32x16{};o[1]=f32x16{};f32x16 negm=f32x16{};asm volatile("":"+v"(negm));
  const int qrel=wid*QBLK+r32;
  #define CMASK(P0,P1,t) do{}while(0)
  bool resc=false;
  #define START(P0,P1) do{ const float rm=rowmax(P0,P1); resc=false; \
    { const float dl=rm; mhat=fadd_s(mhat,dl); \
      _Pragma("unroll") for(int r=0;r<16;++r){P0[r]=fsub_s(P0[r],dl);P1[r]=fsub_s(P1[r],dl);} \
      _Pragma("unroll") for(int r=0;r<16;++r)negm[r]=-mhat; asm volatile("":"+v"(negm)); } \
    _Pragma("unroll") for(int r=0;r<16;++r)P0[r]=__builtin_amdgcn_exp2f(P0[r]); }while(0)
  #define RESC() do{ if(resc){ asm volatile("s_waitcnt lgkmcnt(0)":::"memory"); \
      _Pragma("unroll") for(int d_=0;d_<2;++d_) _Pragma("unroll") for(int r=0;r<16;++r)o[d_][r]*=wsf[crow(r,hi)]; } }while(0)
  f32x16 pA0,pA1,pB0,pB1;
  int sl_prev=0,sl_cur=0,sl_next=SLOTB;
  #define ROT() do{sl_prev=sl_cur;sl_cur=sl_next;sl_next=(sl_next==(NSLOT-1)*SLOTB)?0:sl_next+SLOTB;}while(0)
  DMA_K(2,2*SLOTB);
  WAIT_BAR(3);
  qkt(pA0,pA1,Kbase,qr,negm,r32,hi);asm volatile("s_nop 15\n\ts_nop 7":"+v"(pA0),"+v"(pA1));CMASK(pA0,pA1,0);
  START(pA0,pA1);
  _Pragma("unroll") for(int r=0;r<16;++r)pA1[r]=__builtin_amdgcn_exp2f(pA1[r]);
  WAIT_BAR(0);
  DMA_K(3,0);DMA_V(1,SLOTB);
  ROT();
  kload8(kf,kp0+sl_cur);
  WAIT_BAR(2);
  s16x4 vlo[8],vhi[8]; u32x4 pw0,pw1,pw2,pw3;
  #define PKW(P,B) cvtpk_s(P[B],P[B+1])
  #define PAF(k) __builtin_bit_cast(bf16x8,pw##k)
  #define VFR(i) (bf16x8){vlo[i][0],vlo[i][1],vlo[i][2],vlo[i][3],vhi[i][0],vhi[i][1],vhi[i][2],vhi[i][3]}
  #define PIN(x) asm volatile("":"+v"(x))
  #define MX3(a,b,c) __builtin_fmaxf(__builtin_fmaxf((a),(b)),(c))
  #define GAPA(MF,A0,A1,A2,A3,W0,W1,PW) do{ MF; sacc+=A0; sacc+=A1; sacc+=A2; sacc+=A3; PIN(sacc); W0; W1; PIN(PW); SBAR(); }while(0)
  #define EX(v) __builtin_amdgcn_exp2f(v)
  #define GAPB(MF,X,B) do{ MF; X[B]=EX(X[B]); X[B+1]=EX(X[B+1]); X[B+2]=EX(X[B+2]); X[B+3]=EX(X[B+3]); PIN(X); SBAR(); }while(0)
  #define VRD(i) do{ vlo[i]=vtr(vp_+(((i)>>2)*4096+((i)&3)*1024)); vhi[i]=vtr(vp_+(((i)>>2)*4096+((i)&3)*1024+512)); }while(0)
  #define KRD(G,j) do{ if(G){ kload2(kf,kp0+sl_next,j); SBAR(); } }while(0)
  #define STEP(C0,C1,P0,P1,t,GK,GV,GL) do{ SBAR(); \
    const lds_cptr vp_=vp0+sl_prev; \
    VRD(0); SBAR(); float sacc=(P0[0]+P0[1]); \
    GAPA(C0=__builtin_amdgcn_mfma_f32_32x32x16_bf16(kf[0],qr[0],negm,0,0,0), P0[2],P0[3],P0[4],P0[5],     pw0[0]=PKW(P0,0), pw0[1]=PKW(P0,2), pw0); \
    VRD(4); SBAR(); GAPA(C1=__builtin_amdgcn_mfma_f32_32x32x16_bf16(kf[1],qr[0],negm,0,0,0), P0[6],P0[7],P0[8],P0[9],     pw0[2]=PKW(P0,4), pw0[3]=PKW(P0,6), pw0); \
    VRD(1); SBAR(); GAPA(C0=__builtin_amdgcn_mfma_f32_32x32x16_bf16(kf[2],qr[1],C0,0,0,0),   P0[10],P0[11],P0[12],P0[13], pw1[0]=PKW(P0,8), pw1[1]=PKW(P0,10), pw1); \
    VRD(5); SBAR(); GAPA(C1=__builtin_amdgcn_mfma_f32_32x32x16_bf16(kf[3],qr[1],C1,0,0,0),   P0[14],P0[15],P1[0],P1[1],   pw1[2]=PKW(P0,12),pw1[3]=PKW(P0,14), pw1); \
    VRD(2); SBAR(); GAPA(C0=__builtin_amdgcn_mfma_f32_32x32x16_bf16(kf[4],qr[2],C0,0,0,0),   P1[2],P1[3],P1[4],P1[5],     pw2[0]=PKW(P1,0), pw2[1]=PKW(P1,2), pw2); \
    VRD(6); SBAR(); GAPA(C1=__builtin_amdgcn_mfma_f32_32x32x16_bf16(kf[5],qr[2],C1,0,0,0),   P1[6],P1[7],P1[8],P1[9],     pw2[2]=PKW(P1,4), pw2[3]=PKW(P1,6), pw2); \
    VRD(3); SBAR(); GAPA(C0=__builtin_amdgcn_mfma_f32_32x32x16_bf16(kf[6],qr[3],C0,0,0,0),   P1[10],P1[11],P1[12],P1[13], pw3[0]=PKW(P1,8), pw3[1]=PKW(P1,10), pw3); \
    VRD(7); SBAR(); GAPA(C1=__builtin_amdgcn_mfma_f32_32x32x16_bf16(kf[7],qr[3],C1,0,0,0),   P1[14],P1[15],0.f,0.f,       pw3[2]=PKW(P1,12),pw3[3]=PKW(P1,14), pw3); \
    l_reg+=sacc; \
    if(GK){DMA_K((t)+3,sl_cur);} if(GV){DMA_V((t)+1,sl_next);} \
    CMASK(C0,C1,t); \
    { float a=MX3(C0[0],C0[1],C1[0]),b=MX3(C0[2],C0[3],C1[1]); a=MX3(a,C1[2],C1[3]); \
      _Pragma("unroll") for(int r=4;r<16;r+=4){a=MX3(a,C0[r],C0[r+1]);b=MX3(b,C0[r+2],C0[r+3]);a=MX3(a,C1[r],C1[r+1]);b=MX3(b,C1[r+2],C1[r+3]);} \
      float rm=__builtin_fmaxf(a,b); { auto rr=__builtin_amdgcn_permlane32_swap(__float_as_uint(rm),__float_as_uint(rm),false,false); rm=__builtin_fmaxf(__uint_as_float(rr[0]),__uint_as_float(rr[1])); } \
      resc=false; \
      if(__builtin_expect(__any(rm>(float)THRL),0)){ const float dl=__builtin_fmaxf(rm,0.f); mhat+=dl; \
        _Pragma("unroll") for(int r=0;r<16;++r){C0[r]-=dl;C1[r]-=dl;} \
        _Pragma("unroll") for(int r=0;r<16;++r)negm[r]=-mhat; asm volatile("":"+v"(negm)); \
        const float f=__builtin_amdgcn_exp2f(-dl); l_reg*=f; if(hi==0)wsf[r32]=f; resc=true; } } \
    SBAR(); \
    GAPB(o[0]=__builtin_amdgcn_mfma_f32_32x32x16_bf16(PAF(0),VFR(0),o[0],0,0,0), C0,0); \
    GAPB(o[1]=__builtin_amdgcn_mfma_f32_32x32x16_bf16(PAF(0),VFR(4),o[1],0,0,0), C0,4); \
    KRD(GL,0); GAPB(o[0]=__builtin_amdgcn_mfma_f32_32x32x16_bf16(PAF(1),VFR(1),o[0],0,0,0), C0,8); \
    KRD(GL,1); GAPB(o[1]=__builtin_amdgcn_mfma_f32_32x32x16_bf16(PAF(1),VFR(5),o[1],0,0,0), C0,12); \
    KRD(GL,2); GAPB(o[0]=__builtin_amdgcn_mfma_f32_32x32x16_bf16(PAF(2),VFR(2),o[0],0,0,0), C1,0); \
    KRD(GL,3); GAPB(o[1]=__builtin_amdgcn_mfma_f32_32x32x16_bf16(PAF(2),VFR(6),o[1],0,0,0), C1,4); \
    GAPB(o[0]=__builtin_amdgcn_mfma_f32_32x32x16_bf16(PAF(3),VFR(3),o[0],0,0,0), C1,8); \
    GAPB(o[1]=__builtin_amdgcn_mfma_f32_32x32x16_bf16(PAF(3),VFR(7),o[1],0,0,0), C1,12); \
    }while(0)
  int t=1;
  #undef CMASK
  #define CMASK(P0,P1,t) do{}while(0)
  for(;t+5<NT;t+=2){
    STEP(pB0,pB1,pA0,pA1,t,true,true,true);     WAIT_BAR(2); RESC(); ROT();
    STEP(pA0,pA1,pB0,pB1,t+1,true,true,true);   WAIT_BAR(2); RESC(); ROT();
  }
  #undef CMASK
  #define CMASK(P0,P1,t) do{}while(0)
  #define ENDW(tt) do{ if((tt)+3<NT){WAIT_BAR(2);} else if((tt)+2<NT){WAIT_BAR(1);} else {WAIT_BAR(0);} }while(0)
  for(;t+1<NT;t+=2){
    STEP(pB0,pB1,pA0,pA1,t,(t+3<NT),(t+1<NT),(t+1<NT));       ENDW(t);   RESC(); ROT();
    STEP(pA0,pA1,pB0,pB1,t+1,(t+4<NT),(t+2<NT),(t+2<NT));     ENDW(t+1); RESC(); ROT();
  }
  STEP(pB0,pB1,pA0,pA1,NT-1,false,false,false); RESC();
  { float sacc=pB0[0]+pB0[1]; _Pragma("unroll") for(int r=2;r<16;++r)sacc+=pB0[r]; _Pragma("unroll") for(int r=0;r<16;++r)sacc+=pB1[r]; l_reg+=sacc;
    pw0=(u32x4){PKW(pB0,0),PKW(pB0,2),PKW(pB0,4),PKW(pB0,6)};pw1=(u32x4){PKW(pB0,8),PKW(pB0,10),PKW(pB0,12),PKW(pB0,14)};pw2=(u32x4){PKW(pB1,0),PKW(pB1,2),PKW(pB1,4),PKW(pB1,6)};pw3=(u32x4){PKW(pB1,8),PKW(pB1,10),PKW(pB1,12),PKW(pB1,14)};
    SBAR(); pv(o,vb0+sl_cur,PAF(0),PAF(1),PAF(2),PAF(3)); }
  #undef PKW
  #undef PAF
  #undef VFR
  #undef PIN
  #undef MX3
  #undef GAPA
  #undef GAPB
  #undef EX
  #undef VRD
  #undef KRD
  #undef STEP
  #undef ENDW
  {auto rr=__builtin_amdgcn_permlane32_swap(__float_as_uint(l_reg),__float_as_uint(l_reg),false,false);l_reg=__uint_as_float(rr[0])+__uint_as_float(rr[1]);}
  if(hi==0)wsf[32+r32]=l_reg;asm volatile("s_waitcnt lgkmcnt(0)":::"memory");
  float rli[16];
  #pragma unroll
  for(int r=0;r<16;++r)rli[r]=__builtin_amdgcn_rcpf(wsf[32+crow(r,hi)]);
  bf16*Ow=OB+(rowbase+q0+wid*QBLK)*512+h*D;
  { bf16*stg=(bf16*)(shm+LDS_OST)+wid*2048;
    #pragma unroll
    for(int r=0;r<16;++r){const int orow=crow(r,hi);
      #pragma unroll
      for(int d0=0;d0<2;++d0)stg[orow*64+d0*32+r32]=__float2bfloat16(o[d0][r]*rli[r]);}
    asm volatile("s_waitcnt lgkmcnt(0)":::"memory");
    #pragma unroll
    for(int i=0;i<4;++i){const int row=i*8+(lane>>3),ch=lane&7; const u32x4 v=*(const u32x4*)(stg+row*64+ch*8); ATTN_STORE16(Ow+(long)row*512+ch*8,v);} }
  asm volatile("s_waitcnt lgkmcnt(0)\n\ts_barrier":::"memory");
  #undef DMA_K
  #undef DMA_V
  #undef CMASK
  #undef START
  #undef RESC
  #undef ROT
}
constexpr int ATTN_LDS_BYTES=LDS_BYTES;
#undef SBAR
#undef WAIT_BAR
}
constexpr int NWAVES = 8;
#ifndef MK_PER_PHASE
#define MK_PER_PHASE 0
#endif
constexpr int NB = 8, NX = 4096, NCX = 256, LB = NX + NCX, R = NB * LB, DMODEL = 1024, NPROJ = 2048, NIN = 2056;
constexpr int QCOL = 0, KCOL = 512, VCOL = 640, XBCCOL = 768, ZCOL = 1280, UCOL = 1536, GCOL = 1792;
constexpr int NE = 16, FF = 2048, EROWS = 4352, RGROWS = NE * EROWS;
constexpr int NCH = 68;
constexpr float LN_EPS = 1e-6f, ALPHA = 1.41421356237309515f;
constexpr size_t MiB = 1u << 20;
constexpr size_t WS_CTL = 0, CTL_ZERO_BYTES = 128 * 1024;
constexpr size_t WS_MODP = 1 * MiB, WS_MOD = 5 * MiB, WS_ROPE = 6 * MiB, WS_DT = 7 * MiB, WS_AFF = 9 * MiB, WS_INV = 12 * MiB, WS_SRC = 15 * MiB, WS_GATE = 16 * MiB, WS_TOT = 17 * MiB,
                 WS_RGS = 18 * MiB, WS_RGC = 21 * MiB, WS_RGW = 23 * MiB, WS_WIN = 24 * MiB, WS_WOUT = 32 * MiB, WS_WGU = 36 * MiB, WS_WD = 164 * MiB, WS_XRES = 228 * MiB, WS_XRES2 = 296 * MiB  ,
                 WS_YPRE = 364 * MiB  , WS_HA = 500 * MiB, WS_PROJ = 568 * MiB, WS_MERGED = 704 * MiB,
                 WS_S = 772 * MiB, WS_HIN = 840 * MiB  , WS_KC = 876 * MiB, WS_VC = 886 * MiB  , WS_OB = 896 * MiB  , WS_HID = 568 * MiB  , WS_RGL = 932 * MiB  , WS_END = 1000 * MiB;
constexpr int CW_TMO = 0, CW_BAR = 4096, CW_QUEUE = 8192;
constexpr int RING_OFF = 0, LDSCTL_OFF = 147456  , MISC_OFF = LDSCTL_OFF + 320, LDS_BYTES = 151552;
constexpr int PH_PRO0 = 0, PH_PRO2 = 1, PH_L0 = 2, PH_PER_LAYER = 11, N_PHASES = PH_L0 + 2 * PH_PER_LAYER;
constexpr int PL_INPROJ = 0, PL_QKPOST = 1, PL_MIX1 = 2, PL_CARRY = 3, PL_MIX3 = 4, PL_OUTPROJ = 5, PL_LN1 = 6, PL_TOPK = 7, PL_GEMM1 = 8, PL_GEMM2 = 9, PL_LN2 = 10;

#define GAS __attribute__((address_space(1)))
#define LAS __attribute__((address_space(3)))
typedef unsigned short bf16;
typedef unsigned v4u __attribute__((ext_vector_type(4)));
typedef unsigned v2u __attribute__((ext_vector_type(2)));
typedef _Float16 f16x4 __attribute__((ext_vector_type(4)));
typedef float f32x2_t __attribute__((ext_vector_type(2)));
typedef float f32x4 __attribute__((ext_vector_type(4)));
__device__ __forceinline__ f32x4 h4f(f16x4 h) { return __builtin_convertvector(h, f32x4); }
__device__ __forceinline__ f16x4 f4h(f32x4 v) { return __builtin_convertvector(v, f16x4); }
typedef short bf16x8 __attribute__((ext_vector_type(8)));
typedef GAS unsigned gu32;
#define RLX_AGENT __ATOMIC_RELAXED, __HIP_MEMORY_SCOPE_AGENT
#define LDS_WAIT() asm volatile("s_waitcnt lgkmcnt(0)" ::: "memory")
__device__ __forceinline__ float bf2f(unsigned u) { return __uint_as_float(u << 16); }
__device__ __forceinline__ unsigned pk2(float lo, float hi) { unsigned r; asm("v_cvt_pk_bf16_f32 %0, %1, %2" : "=v"(r) : "v"(lo), "v"(hi)); return r; }
__device__ __forceinline__ unsigned f2bf(float f) { return pk2(f, f) & 0xffffu; }
__device__ __forceinline__ float rcp_f(float x) { return __builtin_amdgcn_rcpf(x); }
__device__ __forceinline__ float exp_f(float x) { return __builtin_amdgcn_exp2f(x * 1.4426950408889634f); }
__device__ __forceinline__ float sigmoid_f(float x) { return rcp_f(1.f + exp_f(-x)); }
__device__ __forceinline__ float silu_ff(float x) { return x * rcp_f(1.f + exp_f(-x)); }
__device__ __forceinline__ float softplus_f(float x) { return x > 20.f ? x : log1pf(__expf(x)); }
__device__ __forceinline__ float gelu_tanh_f(float x) { const float u = 0.7978845608028654f * (x + 0.044715f * x * x * x); return x * rcp_f(1.f + exp_f(-2.f * u)); }
__device__ __forceinline__ float wave_sum(float v) {
#pragma unroll
    for (int o = 1; o < 64; o <<= 1) v += __shfl_xor(v, o);
    return v;
}
__device__ __forceinline__ void unpack8(const v4u p, float (&f)[8]) { f[0] = bf2f(p.x & 0xffffu); f[1] = bf2f(p.x >> 16); f[2] = bf2f(p.y & 0xffffu); f[3] = bf2f(p.y >> 16); f[4] = bf2f(p.z & 0xffffu); f[5] = bf2f(p.z >> 16); f[6] = bf2f(p.w & 0xffffu); f[7] = bf2f(p.w >> 16); }
__device__ __forceinline__ float reduce8(const float (&v)[8], int lane) {
    float a[4], b[2], c;
    { const bool hi = lane & 32;
#pragma unroll
      for (int i = 0; i < 4; ++i) { const float send = hi ? v[i] : v[i + 4], keep = hi ? v[i + 4] : v[i]; a[i] = keep + __shfl_xor(send, 32); } }
    { const bool hi = lane & 16;
#pragma unroll
      for (int i = 0; i < 2; ++i) { const float send = hi ? a[i] : a[i + 2], keep = hi ? a[i + 2] : a[i]; b[i] = keep + __shfl_xor(send, 16); } }
    { const bool hi = lane & 8; const float send = hi ? b[0] : b[1], keep = hi ? b[1] : b[0]; c = keep + __shfl_xor(send, 8); }
    c += __shfl_xor(c, 4); c += __shfl_xor(c, 2); c += __shfl_xor(c, 1);
    return c;
}
__device__ __forceinline__ float reduce16(const float (&v)[16], int lane) {
    float a[8], b[4], c[2], d;
    { const bool hi = lane & 32;
#pragma unroll
      for (int i = 0; i < 8; ++i) { const float send = hi ? v[i] : v[i + 8], keep = hi ? v[i + 8] : v[i]; a[i] = keep + __shfl_xor(send, 32); } }
    { const bool hi = lane & 16;
#pragma unroll
      for (int i = 0; i < 4; ++i) { const float send = hi ? a[i] : a[i + 4], keep = hi ? a[i + 4] : a[i]; b[i] = keep + __shfl_xor(send, 16); } }
    { const bool hi = lane & 8;
#pragma unroll
      for (int i = 0; i < 2; ++i) { const float send = hi ? b[i] : b[i + 2], keep = hi ? b[i + 2] : b[i]; c[i] = keep + __shfl_xor(send, 8); } }
    { const bool hi = lane & 4; const float send = hi ? c[0] : c[1], keep = hi ? c[1] : c[0]; d = keep + __shfl_xor(send, 4); }
    d += __shfl_xor(d, 2); d += __shfl_xor(d, 1);
    return d;
}
__device__ __forceinline__ f32x4 mfma16(bf16x8 a, bf16x8 b, f32x4 c) { return __builtin_amdgcn_mfma_f32_16x16x32_bf16(a, b, c, 0, 0, 0); }
__device__ __forceinline__ bf16x8 lds_frag(const LAS bf16* T, int ld, int row0, int k0, int lane) { return *(const LAS bf16x8*)(T + (row0 + (lane & 15)) * ld + k0 + 8 * (lane >> 4)); }

#define XB_TMO      128
#define XB_XCNT(j)  (256  + 64 * (j))
#define XB_XSUB(j)  (1280 + 64 * (j))
#define XB_XGEN(j)  (2304 + 64 * (j))
#define XB_TOP      3328
#define XB_TOPGEN   3392
#define XCD_BAR_WORDS 3456
#define XB_SPIN_CAP (1u << 18)

__device__ __forceinline__ unsigned xb_ld(unsigned* p)              { return __hip_atomic_load(p, __ATOMIC_RELAXED, __HIP_MEMORY_SCOPE_AGENT); }
__device__ __forceinline__ unsigned xb_add(unsigned* p, unsigned v) { return __hip_atomic_fetch_add(p, v, __ATOMIC_RELAXED, __HIP_MEMORY_SCOPE_AGENT); }
__device__ __forceinline__ unsigned xb_xcc_id() { return (unsigned)__builtin_amdgcn_s_getreg((3 << 11) | 20) & 0xFu; }
#define XB_SPIN(cond, bar) do { unsigned _sp = 0; while (cond) { __builtin_amdgcn_s_sleep(1); \
    if ((++_sp & 255u) == 0u) { if (xb_ld(&(bar)[XB_TMO])) break; if (_sp > XB_SPIN_CAP) { atomicAdd(&(bar)[XB_TMO], 1u); break; } } } } while (0)

struct XcdBarrier {
    unsigned* bar; unsigned x;
    volatile LAS unsigned* st;
};

__device__ __forceinline__ XcdBarrier xcd_barrier_post(unsigned* bar, volatile LAS unsigned* st) {
    XcdBarrier b; b.bar = bar; b.x = xb_xcc_id(); b.st = st;
    if (threadIdx.x == 0) (void)xb_add(&bar[XB_XCNT(b.x)], 1u);
    return b;
}
__device__ __forceinline__ void xcd_barrier_complete(unsigned* bar, unsigned x, unsigned& nloc, unsigned& nx) {
    const unsigned G = gridDim.x * gridDim.y * gridDim.z;
    unsigned sum, cnt, mine, sp = 0u;
    for (;;) {
        sum = 0u; cnt = 0u; mine = 0u;
#pragma unroll
        for (unsigned j = 0; j < 16; ++j) { const unsigned c = xb_ld(&bar[XB_XCNT(j)]); sum += c; cnt += (c > 0u) ? 1u : 0u; mine = (j == x) ? c : mine; }
        if (sum == G) break;
        __builtin_amdgcn_s_sleep(1);
        if ((++sp & 255u) == 0u) { if (xb_ld(&bar[XB_TMO])) break; if (sp > XB_SPIN_CAP) { atomicAdd(&bar[XB_TMO], 1u); break; } }
    }
    nloc = mine > 0u ? mine : 1u; nx = cnt > 0u ? cnt : 1u;
}

__device__ __forceinline__ void xcd_barrier(const XcdBarrier& b) {
    asm volatile("s_waitcnt vmcnt(0)" ::: "memory");
    __syncthreads();
    if (threadIdx.x == 0) {
        unsigned* bar = b.bar;
        __builtin_amdgcn_s_waitcnt(0);
        unsigned nloc = b.st[0], nx = b.st[1];
        if (nloc == 0u) { xcd_barrier_complete(bar, b.x, nloc, nx); b.st[0] = nloc; b.st[1] = nx; }
        const unsigned old = xb_add(&bar[XB_XSUB(b.x)], 1u);
        const unsigned gen = old / nloc;
        if (old + 1u == (gen + 1u) * nloc) {
            __builtin_amdgcn_fence(__ATOMIC_RELEASE, "agent");
            asm volatile("s_waitcnt vmcnt(0)" ::: "memory");
            const unsigned og = xb_add(&bar[XB_TOP], 1u);
            const unsigned tg = og / nx;
            if (og + 1u == (tg + 1u) * nx) xb_add(&bar[XB_TOPGEN], 1u);
            else XB_SPIN(xb_ld(&bar[XB_TOPGEN]) == tg, bar);
            __builtin_amdgcn_fence(__ATOMIC_ACQUIRE, "agent");
            xb_add(&bar[XB_XGEN(b.x)], 1u);
            asm volatile("s_waitcnt vmcnt(0)" ::: "memory");
        } else {
            XB_SPIN(xb_ld(&bar[XB_XGEN(b.x)]) == gen, bar);
            __builtin_amdgcn_fence(__ATOMIC_ACQUIRE, "agent");
            asm volatile("s_waitcnt vmcnt(0)" ::: "memory");
        }
    }
    __syncthreads();
}

struct Frame { LAS unsigned char* lds; volatile LAS unsigned* MISC; int tid, lane, wave, vcu, G; };
struct Args { const float* in[33]; float* out; unsigned char* ws; int ph_lo, ph_hi; };
typedef const __attribute__((address_space(4))) Args& ArgsR;
#define PHASE_FN __device__ __forceinline__
__device__ __forceinline__ void make_frame(Frame& F, LAS unsigned char* lds);
enum { I_X = 0, I_C, I_CTX, I_CCTX, I_WMOD, I_BMOD, I_WIN, I_QNORM, I_KNORM, I_AONORM, I_SCONVW, I_SCONVB, I_SDTB, I_SALOG, I_SD, I_SNORM, I_RCONVW, I_RCONVB, I_RWA, I_RBA, I_RWX, I_RBX, I_RLAM, I_RONORM,
       I_WOUT, I_LN1W, I_LN1B, I_WROUTER, I_WGATE, I_WUP, I_WDOWN, I_LN2W, I_LN2B };
#define WSP(T, off) ((T*)(A.ws + (off)))

template <int MODE> __device__ __forceinline__ void transpose_item(const float* W, int K, int Nsrc, int kb, int ncol0, bf16* WT, int drow0, LAS float* scr, int lane) {
    const int k0 = 64 * kb;
    { f32x4 v[8]; const int kr = lane >> 3, nq = 4 * (lane & 7);
#pragma unroll
      for (int i = 0; i < 8; ++i) v[i] = __builtin_nontemporal_load((const f32x4*)(W + (size_t)(k0 + 8 * i + kr) * Nsrc + ncol0 + nq));
#pragma unroll
      for (int i = 0; i < 8; ++i) { LAS float* d = scr + (8 * i + kr) * 33 + nq; d[0] = v[i][0]; d[1] = v[i][1]; d[2] = v[i][2]; d[3] = v[i][3]; } }
    LDS_WAIT(); asm volatile("" ::: "memory");
    const int c = lane & 7;
#pragma unroll
    for (int j = 0; j < 4; ++j) { const int n = (lane >> 3) + 8 * j; const LAS float* s = scr + (8 * c) * 33 + n;
        const int row = MODE == 0 ? drow0 + n : drow0 + 128 * ((n >> 2) & 1) + 4 * (n >> 3) + (n & 3);
        v4u o; o.x = pk2(s[0 * 33], s[1 * 33]); o.y = pk2(s[2 * 33], s[3 * 33]); o.z = pk2(s[4 * 33], s[5 * 33]); o.w = pk2(s[6 * 33], s[7 * 33]);
        *(v4u*)(WT + (size_t)row * K + k0 + 8 * c) = o; }
    LDS_WAIT(); asm volatile("" ::: "memory");
}
__device__ __forceinline__ void convert_item(Frame& F, ArgsR A, int l, int it, LAS float* scr) {
    bf16* WGU = WSP(bf16, WS_WGU); bf16* WD = WSP(bf16, WS_WD);
    if (it < 32768) { const int up = it >> 14, id = it & 16383, e = id >> 10, rem = id & 1023, kb = rem >> 6, nb = rem & 63;
        const float* W = A.in[up ? I_WUP : I_WGATE] + (size_t)(l * 16 + e) * 1024 * 2048;
        transpose_item<1>(W, 1024, 2048, kb, 32 * nb, WGU + (size_t)e * 4096 * 1024, 256 * (nb >> 2) + 32 * (nb & 3) + 16 * up, scr, F.lane);
    } else { const int id = it - 32768, e = id >> 10, rem = id & 1023, kb = rem >> 5, nb = rem & 31;
        const float* W = A.in[I_WDOWN] + (size_t)(l * 16 + e) * 2048 * 1024;
        transpose_item<0>(W, 2048, 1024, kb, 32 * nb, WD + (size_t)e * 1024 * 2048, 32 * nb, scr, F.lane); }
}
__device__ __forceinline__ void conv_rounds(Frame& F, ArgsR A, int l, int quota, int limit) {
    gu32* cctr = (gu32*)(A.ws + WS_CTL) + 12288 + 64 * l; LAS float* scr = (LAS float*)(F.lds + RING_OFF + F.wave * 16384);
    for (int r = 0; r < quota; ++r) { __syncthreads(); if (F.tid == 0) F.MISC[1] = __hip_atomic_fetch_add(cctr, 8u, RLX_AGENT); __syncthreads();
        const int base = (int)F.MISC[1]; if (base >= limit) break; convert_item(F, A, l, base + F.wave, scr); }
}
__device__ __forceinline__ void p_pro0(Frame& F, ArgsR A) {
    LAS float* scr = (LAS float*)(F.lds + RING_OFF + F.wave * 16384);
    const int gw = F.vcu * NWAVES + F.wave, NGW = F.G * NWAVES;
    { const int gt = gw * 64 + F.lane; if (gt < 1024) { const int pos = gt >> 4, i = gt & 15; const float inv = powf(10000.0f, -(float)i / 16.0f); const float ang = (float)pos * inv;
        float* T = WSP(float, WS_ROPE); T[2 * gt] = cosf(ang); T[2 * gt + 1] = sinf(ang); } }
    for (int it = NGW - 1 - gw; it < 384; it += NGW) { const int l = it / 192, rem = it % 192, cb = rem >> 3, ks = rem & 7, col = cb * 256 + 4 * F.lane;
#pragma unroll
        for (int h = 0; h < 2; ++h) { const int kk = F.lane + 64 * h, k = ks * 128 + kk;
#pragma unroll
            for (int r = 0; r < 9; ++r) scr[kk * 12 + r] = silu_ff(r < 8 ? A.in[I_C][r * 1024 + k] : A.in[I_CCTX][k]); }
        LDS_WAIT(); asm volatile("" ::: "memory");
        f32x4 acc[9];
#pragma unroll
        for (int r = 0; r < 9; ++r) acc[r] = (f32x4){0.f, 0.f, 0.f, 0.f};
        const float* Wm = A.in[I_WMOD] + (size_t)l * 1024 * 6144 + col + (size_t)(ks * 128) * 6144;
        for (int k0 = 0; k0 < 128; k0 += 8) { f32x4 w4[8];
#pragma unroll
            for (int u = 0; u < 8; ++u) w4[u] = *(const f32x4*)(Wm + (size_t)(k0 + u) * 6144);
#pragma unroll
            for (int u = 0; u < 8; ++u) { const f32x4 s0 = *(const LAS f32x4*)(scr + (k0 + u) * 12), s1 = *(const LAS f32x4*)(scr + (k0 + u) * 12 + 4); const float s8 = scr[(k0 + u) * 12 + 8];
                acc[0] += w4[u] * s0[0]; acc[1] += w4[u] * s0[1]; acc[2] += w4[u] * s0[2]; acc[3] += w4[u] * s0[3]; acc[4] += w4[u] * s1[0]; acc[5] += w4[u] * s1[1]; acc[6] += w4[u] * s1[2]; acc[7] += w4[u] * s1[3]; acc[8] += w4[u] * s8; } }
        float* MP = WSP(float, WS_MODP) + (size_t)((ks * 2 + l) * 9) * 6144 + col;
#pragma unroll
        for (int r = 0; r < 9; ++r) *(f32x4*)(MP + (size_t)r * 6144) = acc[r];
        LDS_WAIT(); asm volatile("" ::: "memory"); }
    for (int it = gw; it < 2 * (1024 + 512 + 32); it += NGW) { const int l = it / 1568; int id = it % 1568;
        if (id < 1024) { const int kb = id >> 6, nb = id & 63; transpose_item<0>(A.in[I_WIN] + (size_t)l * 1024 * NIN, 1024, NIN, kb, 32 * nb + (32 * nb >= 1536 ? 8 : 0), WSP(bf16, WS_WIN) + (size_t)l * 2048 * 1024, 32 * nb, scr, F.lane); continue; }
        id -= 1024;
        if (id < 512) { const int kb = id >> 5, nb = id & 31; transpose_item<0>(A.in[I_WOUT] + (size_t)l * 1024 * 1024, 1024, 1024, kb, 32 * nb, WSP(bf16, WS_WOUT) + (size_t)l * 1024 * 1024, 32 * nb, scr, F.lane); continue; }
        id -= 512;
        { const int ty = id >> 4, d = (id >> 3) & 1, blk = (id >> 1) & 3, nb = id & 1;
          transpose_item<0>(A.in[ty ? I_RWX : I_RWA] + (size_t)((l * 2 + d) * 4 + blk) * 4096, 64, 64, 0, 32 * nb, WSP(bf16, WS_RGW) + (size_t)(((l * 2 + ty) * 2 + d) * 4 + blk) * 4096, 32 * nb, scr, F.lane); }
    }
}
__device__ __forceinline__ void stage_wdt(Frame& F, ArgsR A, int L, LAS float* wdt) {
    for (int idx = F.tid; idx < 8192; idx += NWAVES * 64) wdt[(idx & 7) * 1024 + (idx >> 3)] = A.in[I_WIN][((size_t)L * 1024 + (idx >> 3)) * NIN + 1536 + (idx & 7)];
}
template <int NV> __device__ __forceinline__ void stage_mod(Frame& F, ArgsR A, int L, int b0, int sec0, LAS float* dst) {
    const float* M = WSP(float, WS_MOD) + (size_t)L * 9 * 6144;
    for (int idx = F.tid; idx < 3 * NV * 1024; idx += NWAVES * 64) { const int slot = idx / (NV * 1024), rem = idx % (NV * 1024); const int mrow = slot == 0 ? 8 : (b0 + slot - 1 < NB ? b0 + slot - 1 : NB - 1);
        dst[idx] = M[(size_t)mrow * 6144 + sec0 * 1024 + rem]; }
}
__device__ __forceinline__ void emit_row(Frame& F, ArgsR A, int r, const f32x4 (&v)[4], const LAS float* wdt, const LAS float* msh, const LAS float* msc) {
    bf16* ha = WSP(bf16, WS_HA) + (size_t)r * 1024;
    float dd[8];
#pragma unroll
    for (int i = 0; i < 8; ++i) dd[i] = 0.f;
#pragma unroll
    for (int j = 0; j < 4; ++j) { const int k = 256 * j + 4 * F.lane;
        const f32x4 sh = *(const LAS f32x4*)(msh + k), sc = *(const LAS f32x4*)(msc + k); const f32x4 h = v[j] * (sc + 1.0f) + sh;
        v2u o; o.x = pk2(h[0], h[1]); o.y = pk2(h[2], h[3]); *(v2u*)(ha + k) = o;
#pragma unroll
        for (int i = 0; i < 8; ++i) { const f32x4 wv = *(const LAS f32x4*)(wdt + i * 1024 + k); dd[i] += (wv[0] * h[0] + wv[1] * h[1]) + (wv[2] * h[2] + wv[3] * h[3]); }
        __builtin_amdgcn_sched_barrier(0); }
    const float dsum = reduce8(dd, F.lane);
    if ((F.lane & 7) == 0) WSP(float, WS_DT)[(size_t)r * 8 + ((F.lane >> 5) & 1) * 4 + ((F.lane >> 4) & 1) * 2 + ((F.lane >> 3) & 1)] = dsum;
}
#define SRCROW(rr) (((rr) % LB) < NCX ? A.in[I_CTX] + (size_t)(((rr) / LB) * NCX + (rr) % LB) * 1024 : A.in[I_X] + (size_t)(((rr) / LB) * NX + (rr) % LB - NCX) * 1024)
__device__ __forceinline__ void p_pro2(Frame& F, ArgsR A) {
    LAS float* wdt = (LAS float*)(F.lds + RING_OFF); LAS float* mod = wdt + 8192;
    const int rpb = (R + F.G - 1) / F.G, rbeg = blockIdx.x * rpb, rend = rbeg + rpb < R ? rbeg + rpb : R, b0 = rbeg / LB;
    __syncthreads(); stage_wdt(F, A, 0, wdt);
    {
      const float* MP = WSP(float, WS_MODP); float* MOD = WSP(float, WS_MOD);
      for (int idx = blockIdx.x * (NWAVES * 64) + F.tid; idx < 2 * 9 * 6144; idx += F.G * NWAVES * 64) { const int l = idx / (9 * 6144), col = idx % 6144; float s = A.in[I_BMOD][l * 6144 + col];
#pragma unroll
          for (int ks = 0; ks < 8; ++ks) s += MP[(size_t)ks * (2 * 9 * 6144) + idx];
          MOD[idx] = s; }
      for (int idx = F.tid; idx < 3 * 2048; idx += NWAVES * 64) { const int slot = idx / 2048, rem = idx % 2048; const int mrow = slot == 0 ? 8 : (b0 + slot - 1 < NB ? b0 + slot - 1 : NB - 1); const int src = mrow * 6144 + rem;
          float s = A.in[I_BMOD][rem];
#pragma unroll
          for (int ks = 0; ks < 8; ++ks) s += MP[(size_t)ks * (2 * 9 * 6144) + src];
          mod[idx] = s; } }
    __syncthreads();
    const int rfirst = rbeg + F.wave;
    f32x4 vn[3][4];
#pragma unroll
    for (int p = 0; p < 3; ++p) { const int rp = rfirst + 8 * p < rend ? rfirst + 8 * p : rbeg; const float* src = SRCROW(rp);
#pragma unroll
        for (int j = 0; j < 4; ++j) vn[p][j] = *(const f32x4*)(src + 256 * j + 4 * F.lane); }
    for (int r = rfirst; r < rend; r += 8) {
        f32x4 v[4];
        { const int rp = r + 24 < rend ? r + 24 : rbeg; const float* src = SRCROW(rp);
#pragma unroll
          for (int j = 0; j < 4; ++j) { v[j] = vn[0][j]; vn[0][j] = vn[1][j]; vn[1][j] = vn[2][j]; vn[2][j] = *(const f32x4*)(src + 256 * j + 4 * F.lane); } }
        _Float16* xr = WSP(_Float16, WS_XRES) + (size_t)r * 1024;
#pragma unroll
        for (int j = 0; j < 4; ++j) *(f16x4*)(xr + 256 * j + 4 * F.lane) = f4h(v[j]);
        const int slot = (r % LB) < NCX ? 0 : 1 + r / LB - b0;
        emit_row(F, A, r, v, wdt, mod + slot * 2048, mod + slot * 2048 + 1024); }
}
__device__ __forceinline__ void ln_row(f32x4 (&v)[4], const LAS float* lnw, int lane) {
    float s = 0.f;
#pragma unroll
    for (int j = 0; j < 4; ++j) s += (v[j][0] + v[j][1]) + (v[j][2] + v[j][3]);
    const float mean = wave_sum(s) * (1.f / 1024.f); float s2 = 0.f;
#pragma unroll
    for (int j = 0; j < 4; ++j) { v[j] = v[j] - mean; s2 += (v[j][0] * v[j][0] + v[j][1] * v[j][1]) + (v[j][2] * v[j][2] + v[j][3] * v[j][3]); }
    const float rstd = 1.f / sqrtf(wave_sum(s2) * (1.f / 1024.f) + LN_EPS);
#pragma unroll
    for (int j = 0; j < 4; ++j) v[j] = v[j] * rstd * *(const LAS f32x4*)(lnw + 256 * j + 4 * lane) + *(const LAS f32x4*)(lnw + 1024 + 256 * j + 4 * lane);
}
__device__ __forceinline__ void p_ln1(Frame& F, ArgsR A, int L) {
    constexpr int LDA = 1032;
    LAS bf16* Ahi = (LAS bf16*)(F.lds + RING_OFF);
    LAS bf16* Alo = Ahi + 16 * LDA;
    LAS float* red = (LAS float*)(Alo + 16 * LDA);
    LAS float* lnw = red + 2048;
    LAS float* mod = lnw + 2048;
    const bool xonly = (L == 1); const int nrows = xonly ? NB * NX : R;
#define ROWOF1(qq) (xonly ? ((qq) / NX) * LB + NCX + (qq) % NX : (qq))
    const int rpb = (nrows + F.G - 1) / F.G, rbeg = blockIdx.x * rpb, rend = rbeg + rpb < nrows ? rbeg + rpb : nrows, b0 = ROWOF1(rbeg < nrows ? rbeg : 0) / LB;
    const int lane = F.lane, w = F.wave, q = lane >> 4, c16 = lane & 15;
    __syncthreads();
    for (int idx = F.tid; idx < 2048; idx += NWAVES * 64) lnw[idx] = idx < 1024 ? A.in[I_LN1W][L * 1024 + idx] : A.in[I_LN1B][L * 1024 + idx - 1024];
    stage_mod<3>(F, A, L, b0, 2, mod);
    bf16x8 bh[4], bl[4];
#pragma unroll
    for (int ks = 0; ks < 4; ++ks)
#pragma unroll
        for (int i = 0; i < 8; ++i) { const float wv = A.in[I_WROUTER][(size_t)L * 16384 + (size_t)(128 * w + 32 * ks + 8 * q + i) * 16 + c16]; const unsigned hi = f2bf(wv); bh[ks][i] = (short)hi; bl[ks][i] = (short)f2bf(wv - bf2f(hi)); }
    __syncthreads();
    const bf16* YP = WSP(bf16, WS_YPRE); const _Float16* XR = WSP(_Float16, WS_XRES);
    f16x4 vn[2][4]; v2u yn[2][4];
#pragma unroll
    for (int p = 0; p < 2; ++p) { const int rp = rbeg + 2 * w + p < rend ? rbeg + 2 * w + p : rbeg;
#pragma unroll
        for (int j = 0; j < 4; ++j) { vn[p][j] = *(const f16x4*)(XR + (size_t)ROWOF1(rp) * 1024 + 256 * j + 4 * lane); yn[p][j] = *(const v2u*)(YP + (size_t)ROWOF1(rp) * 1024 + 256 * j + 4 * lane); } }
    for (int g0 = rbeg; g0 < rend; g0 += 16) {
#pragma unroll
        for (int p = 0; p < 2; ++p) { const int rq = g0 + 2 * w + p, r = ROWOF1(rq < nrows ? rq : 0);
            f32x4 v[4]; v2u yb[4];
            { const int rp = rq + 16 < rend ? rq + 16 : rbeg;
#pragma unroll
              for (int j = 0; j < 4; ++j) { v[j] = h4f(vn[p][j]); yb[j] = yn[p][j]; vn[p][j] = *(const f16x4*)(XR + (size_t)ROWOF1(rp) * 1024 + 256 * j + 4 * lane); yn[p][j] = *(const v2u*)(YP + (size_t)ROWOF1(rp) * 1024 + 256 * j + 4 * lane); } }
            if (rq < rend) {
                const int slot = (r % LB) < NCX ? 0 : 1 + r / LB - b0; const LAS float* mg1 = mod + slot * 3072; const LAS float* msh = mg1 + 1024; const LAS float* msc = mg1 + 2048;
#pragma unroll
                for (int j = 0; j < 4; ++j) { const f32x4 g1 = *(const LAS f32x4*)(mg1 + 256 * j + 4 * lane);
                    v[j] = v[j] * ALPHA + g1 * (f32x4){bf2f(yb[j].x & 0xffffu), bf2f(yb[j].x >> 16), bf2f(yb[j].y & 0xffffu), bf2f(yb[j].y >> 16)}; }
                ln_row(v, lnw, lane);
                _Float16* xr = WSP(_Float16, WS_XRES2) + (size_t)r * 1024; bf16* ha = WSP(bf16, WS_HA) + (size_t)r * 1024;
#pragma unroll
                for (int j = 0; j < 4; ++j) { const int k = 256 * j + 4 * lane; *(f16x4*)(xr + k) = f4h(v[j]);
                    const f32x4 sh = *(const LAS f32x4*)(msh + k), sc = *(const LAS f32x4*)(msc + k); const f32x4 h = v[j] * (sc + 1.0f) + sh;
                    v2u o; o.x = pk2(h[0], h[1]); o.y = pk2(h[2], h[3]); *(v2u*)(ha + k) = o;
                    v2u lo; lo.x = pk2(h[0] - bf2f(o.x & 0xffffu), h[1] - bf2f(o.x >> 16)); lo.y = pk2(h[2] - bf2f(o.y & 0xffffu), h[3] - bf2f(o.y >> 16));
                    *(LAS v2u*)(Ahi + (2 * w + p) * LDA + k) = o; *(LAS v2u*)(Alo + (2 * w + p) * LDA + k) = lo; } } }
        __syncthreads();
        { f32x4 acc = {0.f, 0.f, 0.f, 0.f};
#pragma unroll
          for (int ks = 0; ks < 4; ++ks) { const bf16x8 ah = lds_frag(Ahi, LDA, 0, 128 * w + 32 * ks, lane), al = lds_frag(Alo, LDA, 0, 128 * w + 32 * ks, lane);
              acc = mfma16(ah, bh[ks], acc); acc = mfma16(ah, bl[ks], acc); acc = mfma16(al, bh[ks], acc); }
#pragma unroll
          for (int j = 0; j < 4; ++j) red[(w * 16 + 4 * q + j) * 16 + c16] = acc[j]; }
        __syncthreads();
        if (F.tid < 256) { const int i = F.tid >> 4, e = F.tid & 15, rq = g0 + i, r = ROWOF1(rq < nrows ? rq : 0); float lg = 0.f;
#pragma unroll
            for (int ww = 0; ww < 8; ++ww) lg += red[(ww * 16 + i) * 16 + e];
            float mx = lg; mx = fmaxf(mx, __shfl_xor(mx, 1)); mx = fmaxf(mx, __shfl_xor(mx, 2)); mx = fmaxf(mx, __shfl_xor(mx, 4)); mx = fmaxf(mx, __shfl_xor(mx, 8));
            const float ex = expf(lg - mx); float sum = ex; sum += __shfl_xor(sum, 1); sum += __shfl_xor(sum, 2); sum += __shfl_xor(sum, 4); sum += __shfl_xor(sum, 8);
            if (rq < rend) WSP(float, WS_AFF)[(size_t)r * 16 + e] = ex / sum; }
    }
#undef ROWOF1
}
__device__ __forceinline__ void p_ln2(Frame& F, ArgsR A, int L) {
    const bool last = (L == 1);
    LAS float* wdt = (LAS float*)(F.lds + RING_OFF); LAS float* lnw = wdt + 8192; LAS float* modg = lnw + 2048; LAS float* modn = modg + 3 * 1024;
    const int nrows = last ? NB * NX : R;
#define ROWOF(qq) (last ? ((qq) / NX) * LB + NCX + (qq) % NX : (qq))
    const int rpb = (nrows + F.G - 1) / F.G, qbeg = blockIdx.x * rpb, qend = qbeg + rpb < nrows ? qbeg + rpb : nrows, b0 = ROWOF(qbeg < nrows ? qbeg : 0) / LB;
    __syncthreads();
    if (!last) { stage_wdt(F, A, L + 1, wdt); stage_mod<2>(F, A, L + 1, b0, 0, modn); }
    stage_mod<1>(F, A, L, b0, 5, modg);
    for (int idx = F.tid; idx < 2048; idx += NWAVES * 64) lnw[idx] = idx < 1024 ? A.in[I_LN2W][L * 1024 + idx] : A.in[I_LN2B][L * 1024 + idx - 1024];
    __syncthreads();
    const bf16* YS = WSP(bf16, WS_YPRE); const _Float16* XR = WSP(_Float16, WS_XRES2); const int* INV = WSP(int, WS_INV);
    const int qfirst = qbeg + F.wave;
    f16x4 vn[3][4]; int invn[3];
#pragma unroll
    for (int p = 0; p < 3; ++p) { const int qp = qfirst + 8 * p < qend ? qfirst + 8 * p : qbeg; const int rp = ROWOF(qp); invn[p] = INV[(size_t)rp * 16 + (F.lane & 15)];
#pragma unroll
        for (int j = 0; j < 4; ++j) vn[p][j] = *(const f16x4*)(XR + (size_t)rp * 1024 + 256 * j + 4 * F.lane); }
    for (int qq = qfirst; qq < qend; qq += 8) { const int r = ROWOF(qq), b = r / LB, s = r % LB;
        f32x4 moe[4];
#pragma unroll
        for (int j = 0; j < 4; ++j) moe[j] = (f32x4){0.f, 0.f, 0.f, 0.f};
        const int myinv = invn[0];
        unsigned long long msk = __ballot(myinv >= 0 && F.lane < 16);
        while (msk) { int e0 = __builtin_ctzll(msk); msk &= msk - 1; int e1 = -1; if (msk) { e1 = __builtin_ctzll(msk); msk &= msk - 1; }
            const int i0 = __builtin_amdgcn_readlane(myinv, e0); const int i1 = e1 >= 0 ? __builtin_amdgcn_readlane(myinv, e1) : i0;
            v2u p0[4], p1[4];
#pragma unroll
            for (int j = 0; j < 4; ++j) { p0[j] = *(const v2u*)(YS + (size_t)i0 * 1024 + 256 * j + 4 * F.lane); p1[j] = *(const v2u*)(YS + (size_t)i1 * 1024 + 256 * j + 4 * F.lane); }
            const float w1 = e1 >= 0 ? 1.f : 0.f;
#pragma unroll
            for (int j = 0; j < 4; ++j) { moe[j][0] += bf2f(p0[j].x & 0xffffu) + w1 * bf2f(p1[j].x & 0xffffu); moe[j][1] += bf2f(p0[j].x >> 16) + w1 * bf2f(p1[j].x >> 16);
                moe[j][2] += bf2f(p0[j].y & 0xffffu) + w1 * bf2f(p1[j].y & 0xffffu); moe[j][3] += bf2f(p0[j].y >> 16) + w1 * bf2f(p1[j].y >> 16); } }
        __builtin_amdgcn_sched_barrier(0);
        f32x4 v[4];
        { const int qp = qq + 24 < qend ? qq + 24 : qbeg; const int rn = ROWOF(qp); invn[0] = invn[1]; invn[1] = invn[2]; invn[2] = INV[(size_t)rn * 16 + (F.lane & 15)];
#pragma unroll
          for (int j = 0; j < 4; ++j) { v[j] = h4f(vn[0][j]); vn[0][j] = vn[1][j]; vn[1][j] = vn[2][j]; vn[2][j] = *(const f16x4*)(XR + (size_t)rn * 1024 + 256 * j + 4 * F.lane); } }
        const int slot = s < NCX ? 0 : 1 + b - b0;
#pragma unroll
        for (int j = 0; j < 4; ++j) { const f32x4 g2 = *(const LAS f32x4*)(modg + slot * 1024 + 256 * j + 4 * F.lane); v[j] = v[j] * ALPHA + g2 * moe[j]; }
        ln_row(v, lnw, F.lane);
        if (last) { float* o = A.out + (size_t)(b * NX + s - NCX) * 1024;
#pragma unroll
            for (int j = 0; j < 4; ++j) *(f32x4*)(o + 256 * j + 4 * F.lane) = v[j]; }
        else { _Float16* xr = WSP(_Float16, WS_XRES) + (size_t)r * 1024;
#pragma unroll
            for (int j = 0; j < 4; ++j) *(f16x4*)(xr + 256 * j + 4 * F.lane) = f4h(v[j]);
            emit_row(F, A, r, v, wdt, modn + slot * 2048, modn + slot * 2048 + 1024); } }
#undef ROWOF
}
__device__ __forceinline__ void p_qkpost(Frame& F, ArgsR A, int L) {
    const bf16* PROJ = WSP(bf16, WS_PROJ); const float* ROPE = WSP(float, WS_ROPE);
    const int gw = F.vcu * NWAVES + F.wave, NGW = F.G * NWAVES, m = F.lane & 7;
    bf16* KC = WSP(bf16, WS_KC); bf16* VC = WSP(bf16, WS_VC);
    const float* nwp = A.in[I_KNORM] + L * 64 + 8 * m; const f32x4 n0 = *(const f32x4*)nwp, n1 = *(const f32x4*)(nwp + 4);
    for (int it0 = gw * 8; it0 < R * 4; it0 += NGW * 8 * 3) {
        v4u raws[3]; f32x4 rc[3][4];
#pragma unroll
        for (int p = 0; p < 3; ++p) { const int it = it0 + p * NGW * 8, item = (it < R * 4 ? it : gw * 8) + (F.lane >> 3), r = item >> 2, sl = item & 3, s = r % LB;
            raws[p] = *(const v4u*)(PROJ + (size_t)r * NPROJ + KCOL + sl * 64 + 8 * m);
            const int t = s >= NCX ? s - NCX : 0, pos = (m >> 2) ? (t & 63) : (t >> 6); const float* rp = ROPE + (size_t)(pos * 16 + 8 * (m & 1)) * 2;
#pragma unroll
            for (int q = 0; q < 4; ++q) rc[p][q] = *(const f32x4*)(rp + 4 * q); }
#pragma unroll
        for (int p = 0; p < 3; ++p) { const int it = it0 + p * NGW * 8; if (it < R * 4) { const int item = it + (F.lane >> 3), r = item >> 2, sl = item & 3, s = r % LB; const bool lat = s >= NCX;
            const v4u raw = raws[p]; float e[8]; unpack8(raw, e);
            float ss = 0.f;
#pragma unroll
            for (int i = 0; i < 8; ++i) ss += e[i] * e[i];
            ss += __shfl_xor(ss, 1); ss += __shfl_xor(ss, 2); ss += __shfl_xor(ss, 4);
            const float rs = 1.f / sqrtf(ss * (1.f / 64.f) + LN_EPS);
            e[0] *= rs * n0[0]; e[1] *= rs * n0[1]; e[2] *= rs * n0[2]; e[3] *= rs * n0[3]; e[4] *= rs * n1[0]; e[5] *= rs * n1[1]; e[6] *= rs * n1[2]; e[7] *= rs * n1[3];
            const f32x4 c0 = rc[p][0], c1 = rc[p][1], c2 = rc[p][2], c3 = rc[p][3];
            const float cs[8] = {c0[0], c0[2], c1[0], c1[2], c2[0], c2[2], c3[0], c3[2]}, sn[8] = {c0[1], c0[3], c1[1], c1[3], c2[1], c2[3], c3[1], c3[3]};
            const float sgn = (m & 2) ? 1.f : -1.f; float o[8];
#pragma unroll
            for (int i = 0; i < 8; ++i) { const float pe = __shfl_xor(e[i], 2); o[i] = lat ? e[i] * cs[i] + sgn * pe * sn[i] : e[i]; }
            const v4u outv = (v4u){pk2(o[0], o[1]), pk2(o[2], o[3]), pk2(o[4], o[5]), pk2(o[6], o[7])};
            const int bb = r / LB, tl = s >> 6, rr = s & 63;
            if (sl < 2) *(v4u*)(KC + ((size_t)(bb * (LB / 64) + tl) * 2 + sl) * 4096 + (m * 64 + rr) * 8) = outv;
            else *(v4u*)(VC + ((size_t)(bb * (LB / 64) + tl) * 2 + (sl - 2)) * 4096 + ((((rr >> 4) + 4 * (m >> 2)) * 64) + (rr & 15) * 4 + (m & 3)) * 8) = raw; } }
    }
}
template <int MODE> __device__ __forceinline__ void ssd_unit(Frame& F, ArgsR A, int L, int b, int c) {
    constexpr int LD = 72;
    LAS bf16* XT = (LAS bf16*)(F.lds + RING_OFF);
    LAS bf16* Brow = XT + 4 * 64 * LD;
    LAS bf16* CB = Brow + 2 * 64 * LD;
    LAS bf16* Msl = CB + 2 * 64 * LD;
    LAS float* dtv = (LAS float*)(Msl + 8 * 16 * LD);
    LAS float* csv = dtv + 512;
    LAS float* ssq = csv + 512;
    LAS bf16* YO = (LAS bf16*)(ssq + 128);
    const int tid = F.tid, lane = F.lane, w = F.wave, q = lane >> 4, c16 = lane & 15;
    const bf16* PROJ = WSP(bf16, WS_PROJ);
    const int r0 = b * LB + 64 * c, seg_lo = (c < 4) ? b * LB : b * LB + NCX, seg_hi = (c < 4) ? b * LB + NCX : (b + 1) * LB;
    __syncthreads();
    { const int cg = tid & 63, ro = tid >> 6, ch0 = 8 * cg;
      if (MODE == 3 || cg < 48) {
        v4u raw[11];
#pragma unroll
        for (int i = 0; i < 11; ++i) { const int rr = r0 + 8 * ro - 1 + i, rc = rr < seg_lo ? seg_lo : (rr >= seg_hi ? seg_hi - 1 : rr);
            v4u p = *(const v4u*)(PROJ + (size_t)rc * NPROJ + XBCCOL + ch0); if (rr < seg_lo || rr >= seg_hi) p = (v4u){0u, 0u, 0u, 0u}; raw[i] = p; }
        float wt[4][8], bs[8];
        { const float* cw = A.in[I_SCONVW] + (size_t)L * 4 * 512 + ch0;
#pragma unroll
          for (int j = 0; j < 4; ++j) { const f32x4 a0 = *(const f32x4*)(cw + j * 512), a1 = *(const f32x4*)(cw + j * 512 + 4); wt[j][0] = a0[0]; wt[j][1] = a0[1]; wt[j][2] = a0[2]; wt[j][3] = a0[3]; wt[j][4] = a1[0]; wt[j][5] = a1[1]; wt[j][6] = a1[2]; wt[j][7] = a1[3]; }
          const f32x4 b0 = *(const f32x4*)(A.in[I_SCONVB] + L * 512 + ch0), b1 = *(const f32x4*)(A.in[I_SCONVB] + L * 512 + ch0 + 4); bs[0] = b0[0]; bs[1] = b0[1]; bs[2] = b0[2]; bs[3] = b0[3]; bs[4] = b1[0]; bs[5] = b1[1]; bs[6] = b1[2]; bs[7] = b1[3]; }
        v4u rp[8];
        { float w0[8], w1[8], w2[8], w3[8]; unpack8(raw[0], w0); unpack8(raw[1], w1); unpack8(raw[2], w2);
#pragma unroll
          for (int l = 0; l < 8; ++l) { unpack8(raw[l + 3], w3); float y[8];
#pragma unroll
              for (int cc = 0; cc < 8; ++cc) { y[cc] = silu_ff(wt[0][cc] * w0[cc] + wt[1][cc] * w1[cc] + wt[2][cc] * w2[cc] + wt[3][cc] * w3[cc] + bs[cc]); w0[cc] = w1[cc]; w1[cc] = w2[cc]; w2[cc] = w3[cc]; }
              rp[l] = (v4u){pk2(y[0], y[1]), pk2(y[2], y[3]), pk2(y[4], y[5]), pk2(y[6], y[7])}; } }
#define ROWPK(l) (rp[l])
#define CPAIR(cc, i) (((cc) & 1) ? ((rp[2 * (i)][(cc) >> 1] >> 16) | (rp[2 * (i) + 1][(cc) >> 1] & 0xffff0000u)) : ((rp[2 * (i)][(cc) >> 1] & 0xffffu) | (rp[2 * (i) + 1][(cc) >> 1] << 16)))
#define COLPK(cc) ((v4u){CPAIR(cc, 0), CPAIR(cc, 1), CPAIR(cc, 2), CPAIR(cc, 3)})
        if (ch0 < 256) { const int h = ch0 >> 6, p0 = ch0 & 63;
#pragma unroll
            for (int cc = 0; cc < 8; ++cc) *(LAS v4u*)(XT + (h * 64 + p0 + cc) * LD + 8 * ro) = COLPK(cc);
        } else if (ch0 < 384) { const int g = (ch0 - 256) >> 6, n0 = ch0 & 63;
#pragma unroll
            for (int l = 0; l < 8; ++l) *(LAS v4u*)(Brow + (g * 64 + 8 * ro + l) * LD + n0) = ROWPK(l);
            if (MODE == 1) {
#pragma unroll
                for (int cc = 0; cc < 8; ++cc) *(LAS v4u*)(CB + (g * 64 + n0 + cc) * LD + 8 * ro) = COLPK(cc); }
        } else { const int g = (ch0 - 384) >> 6, n0 = ch0 & 63;
#pragma unroll
            for (int l = 0; l < 8; ++l) *(LAS v4u*)(CB + (g * 64 + 8 * ro + l) * LD + n0) = ROWPK(l); }
#undef ROWPK
#undef COLPK
#undef CPAIR
      } }
    { const int dh = tid >> 6, l = tid & 63;
      const float dt = softplus_f(WSP(float, WS_DT)[(size_t)(r0 + l) * 8 + dh] + A.in[I_SDTB][L * 8 + dh]); const float a = -__expf(A.in[I_SALOG][L * 8 + dh]);
      dtv[dh * 64 + l] = dt; csv[dh * 64 + l] = dt * a; }
    __syncthreads();
    { const int dh = tid >> 6, l = tid & 63; float s = 0.f;
      if (dh < 4) { for (int j = 0; j <= l; ++j) s += csv[dh * 64 + j]; } else { for (int j = l; j < 64; ++j) s += csv[dh * 64 + j]; }
      __syncthreads(); csv[dh * 64 + l] = s; }
    __syncthreads();
    if (MODE == 1) {
        const int d = w >> 2, h = w & 3, g = h >> 1, dh = w;
        const float cs_end = d == 0 ? csv[dh * 64 + 63] : csv[dh * 64];
        const size_t chain = (size_t)((b * 2 + d) * 4 + h) * NCH + c;
        float* S = WSP(float, WS_S) + chain * 4096;
        float wg[2][8];
#pragma unroll
        for (int ks = 0; ks < 2; ++ks)
#pragma unroll
            for (int i = 0; i < 8; ++i) { const int k = 32 * ks + 8 * q + i; wg[ks][i] = __expf(cs_end - csv[dh * 64 + k]) * dtv[dh * 64 + k]; }
#pragma unroll
        for (int pt = 0; pt < 4; ++pt) { f32x4 acc[4];
#pragma unroll
            for (int nt = 0; nt < 4; ++nt) acc[nt] = (f32x4){0.f, 0.f, 0.f, 0.f};
#pragma unroll
            for (int ks = 0; ks < 2; ++ks) { const bf16x8 a0 = lds_frag(XT + h * 64 * LD, LD, 16 * pt, 32 * ks, lane); bf16x8 a;
#pragma unroll
                for (int i = 0; i < 8; ++i) a[i] = (short)f2bf(bf2f((unsigned short)a0[i]) * wg[ks][i]);
#pragma unroll
                for (int nt = 0; nt < 4; ++nt) acc[nt] = mfma16(a, lds_frag(CB + g * 64 * LD, LD, 16 * nt, 32 * ks, lane), acc[nt]); }
#pragma unroll
            for (int nt = 0; nt < 4; ++nt)
#pragma unroll
                for (int j = 0; j < 4; ++j) S[(16 * pt + 4 * q + j) * 64 + 16 * nt + c16] = acc[nt][j]; }
        if (lane == 0) WSP(float, WS_TOT)[chain] = __expf(cs_end);
    } else {
        {
          const int h = w & 3, rh = w >> 2, g2 = h >> 1; const LAS bf16* Cg2 = CB + g2 * 64 * LD;
          f32x4 yo[2][4];
#pragma unroll
          for (int r2 = 0; r2 < 2; ++r2)
#pragma unroll
              for (int pt = 0; pt < 4; ++pt) yo[r2][pt] = (f32x4){0.f, 0.f, 0.f, 0.f};
#pragma unroll
          for (int d = 0; d < 2; ++d) { const int dh = d * 4 + h; const bf16* Hin = WSP(bf16, WS_HIN) + ((size_t)((b * 2 + d) * 4 + h) * NCH + c) * 4096;
              bf16x8 hq[4][2];
#pragma unroll
              for (int pt = 0; pt < 4; ++pt)
#pragma unroll
                  for (int ks = 0; ks < 2; ++ks) hq[pt][ks] = *(const bf16x8*)(Hin + (16 * pt + c16) * 64 + 32 * ks + 8 * q);
#pragma unroll
              for (int r2 = 0; r2 < 2; ++r2) { const int rt = 2 * rh + r2; const bf16x8 a0 = lds_frag(Cg2, LD, 16 * rt, 0, lane), a1 = lds_frag(Cg2, LD, 16 * rt, 32, lane);
                  float ec[4];
#pragma unroll
                  for (int j = 0; j < 4; ++j) ec[j] = exp_f(csv[dh * 64 + 16 * rt + 4 * q + j]);
#pragma unroll
                  for (int pt = 0; pt < 4; ++pt) { f32x4 off = {0.f, 0.f, 0.f, 0.f}; off = mfma16(a0, hq[pt][0], off); off = mfma16(a1, hq[pt][1], off);
#pragma unroll
                      for (int j = 0; j < 4; ++j) yo[r2][pt][j] += off[j] * ec[j]; } } }
#pragma unroll
          for (int r2 = 0; r2 < 2; ++r2)
#pragma unroll
              for (int pt = 0; pt < 4; ++pt)
#pragma unroll
                  for (int j = 0; j < 4; ++j) YO[(h * 64 + 16 * (2 * rh + r2) + 4 * q + j) * LD + 16 * pt + c16] = (bf16)f2bf(yo[r2][pt][j]);
        }
        __syncthreads();
        const int rt = w & 3, g = w >> 2;
        const LAS bf16* Cg = CB + g * 64 * LD; const LAS bf16* Bg = Brow + g * 64 * LD; LAS bf16* Mw = Msl + w * 16 * LD;
        f32x4 G[4];
#pragma unroll
        for (int st = 0; st < 4; ++st) { G[st] = (f32x4){0.f, 0.f, 0.f, 0.f};
#pragma unroll
            for (int ks = 0; ks < 2; ++ks) G[st] = mfma16(lds_frag(Bg, LD, 16 * st, 32 * ks, lane), lds_frag(Cg, LD, 16 * rt, 32 * ks, lane), G[st]); }
        f32x4 y[2][4];
#pragma unroll
        for (int hh = 0; hh < 2; ++hh)
#pragma unroll
            for (int pt = 0; pt < 4; ++pt) y[hh][pt] = (f32x4){0.f, 0.f, 0.f, 0.f};
#pragma unroll
        for (int hh = 0; hh < 2; ++hh) { const int h = 2 * g + hh; const LAS bf16* XTh = XT + h * 64 * LD;
#pragma unroll
            for (int d = 0; d < 2; ++d) { const int dh = d * 4 + h;
                float csl[4];
#pragma unroll
                for (int j = 0; j < 4; ++j) csl[j] = csv[dh * 64 + 16 * rt + 4 * q + j];
                { const int l = 16 * rt + c16; const float csm = csv[dh * 64 + l];
#pragma unroll
                  for (int st = 0; st < 4; ++st) { const f32x4 css = *(const LAS f32x4*)(csv + dh * 64 + 16 * st + 4 * q), dts = *(const LAS f32x4*)(dtv + dh * 64 + 16 * st + 4 * q); float val[4];
#pragma unroll
                      for (int j = 0; j < 4; ++j) { const int s = 16 * st + 4 * q + j; const bool valid = d == 0 ? (s <= l) : (s >= l);
                          val[j] = valid ? G[st][j] * exp_f(fminf(csm - css[j], 0.f)) * dts[j] : 0.f; }
                      *(LAS v2u*)(Mw + c16 * LD + 16 * st + 4 * q) = (v2u){pk2(val[0], val[1]), pk2(val[2], val[3])}; } }
                LDS_WAIT();
#pragma unroll
                for (int ks = 0; ks < 2; ++ks) { const bf16x8 a = lds_frag(Mw, LD, 0, 32 * ks, lane);
#pragma unroll
                    for (int pt = 0; pt < 4; ++pt) y[hh][pt] = mfma16(a, lds_frag(XTh, LD, 16 * pt, 32 * ks, lane), y[hh][pt]); }
                LDS_WAIT();
            }
            const float Dv = A.in[I_SD][L * 4 + h];
#pragma unroll
            for (int pt = 0; pt < 4; ++pt)
#pragma unroll
                for (int j = 0; j < 4; ++j) y[hh][pt][j] += Dv * bf2f(XTh[(16 * pt + c16) * LD + 16 * rt + 4 * q + j]) + bf2f(YO[(h * 64 + 16 * rt + 4 * q + j) * LD + 16 * pt + c16]);
        }
        float ss[4] = {0.f, 0.f, 0.f, 0.f};
#pragma unroll
        for (int hh = 0; hh < 2; ++hh)
#pragma unroll
            for (int pt = 0; pt < 4; ++pt)
#pragma unroll
                for (int j = 0; j < 4; ++j) { const int r = r0 + 16 * rt + 4 * q + j; const float z = bf2f(PROJ[(size_t)r * NPROJ + ZCOL + (2 * g + hh) * 64 + 16 * pt + c16]);
                    const float v = y[hh][pt][j] * silu_ff(z); y[hh][pt][j] = v; ss[j] += v * v; }
#pragma unroll
        for (int j = 0; j < 4; ++j) { float s = ss[j]; s += __shfl_xor(s, 1); s += __shfl_xor(s, 2); s += __shfl_xor(s, 4); s += __shfl_xor(s, 8); if (c16 == 0) ssq[g * 64 + 16 * rt + 4 * q + j] = s; }
        __syncthreads();
        bf16* MG = WSP(bf16, WS_MERGED);
#pragma unroll
        for (int j = 0; j < 4; ++j) { const int l = 16 * rt + 4 * q + j; const float rs = 1.f / sqrtf((ssq[l] + ssq[64 + l]) * (1.f / 256.f) + LN_EPS);
#pragma unroll
            for (int hh = 0; hh < 2; ++hh)
#pragma unroll
                for (int pt = 0; pt < 4; ++pt) { const int chn = (2 * g + hh) * 64 + 16 * pt + c16; MG[(size_t)(r0 + l) * 1024 + 512 + chn] = (bf16)f2bf(y[hh][pt][j] * rs * A.in[I_SNORM][L * 256 + chn]); } }
    }
}
template <int MODE> __device__ __forceinline__ void rg_unit(Frame& F, ArgsR A, int L, int b, int c) {
    constexpr int LDU = 264, LDQ = 68;
    LAS bf16* U = (LAS bf16*)(F.lds + RING_OFF);
    LAS unsigned* QT = (LAS unsigned*)(F.lds + RING_OFF + 33792);
    const int tid = F.tid, lane = F.lane, w = F.wave, q = lane >> 4, c16 = lane & 15;
    const bf16* PROJ = WSP(bf16, WS_PROJ);
    const int r0 = b * LB + 64 * c, seg_lo = (c < 4) ? b * LB : b * LB + NCX, seg_hi = (c < 4) ? b * LB + NCX : (b + 1) * LB;
    __syncthreads();
    { const int cg = tid & 31, rq = tid >> 5, ch0 = 8 * cg;
      v4u raw[7];
#pragma unroll
      for (int i = 0; i < 7; ++i) { const int rr = r0 + 4 * rq - 1 + i, rc = rr < seg_lo ? seg_lo : (rr >= seg_hi ? seg_hi - 1 : rr);
          v4u p = *(const v4u*)(PROJ + (size_t)rc * NPROJ + UCOL + ch0); if (rr < seg_lo || rr >= seg_hi) p = (v4u){0u, 0u, 0u, 0u}; raw[i] = p; }
      float wt[4][8], bs[8];
      { const float* cw = A.in[I_RCONVW] + (size_t)L * 4 * 256 + ch0;
#pragma unroll
        for (int j = 0; j < 4; ++j) { const f32x4 a0 = *(const f32x4*)(cw + j * 256), a1 = *(const f32x4*)(cw + j * 256 + 4); wt[j][0] = a0[0]; wt[j][1] = a0[1]; wt[j][2] = a0[2]; wt[j][3] = a0[3]; wt[j][4] = a1[0]; wt[j][5] = a1[1]; wt[j][6] = a1[2]; wt[j][7] = a1[3]; }
        const f32x4 b0 = *(const f32x4*)(A.in[I_RCONVB] + L * 256 + ch0), b1 = *(const f32x4*)(A.in[I_RCONVB] + L * 256 + ch0 + 4); bs[0] = b0[0]; bs[1] = b0[1]; bs[2] = b0[2]; bs[3] = b0[3]; bs[4] = b1[0]; bs[5] = b1[1]; bs[6] = b1[2]; bs[7] = b1[3]; }
      float w0[8], w1[8], w2[8], w3[8]; unpack8(raw[0], w0); unpack8(raw[1], w1); unpack8(raw[2], w2);
#pragma unroll
      for (int l = 0; l < 4; ++l) { unpack8(raw[l + 3], w3); float yv[8];
#pragma unroll
          for (int cc = 0; cc < 8; ++cc) { yv[cc] = wt[0][cc] * w0[cc] + wt[1][cc] * w1[cc] + wt[2][cc] * w2[cc] + wt[3][cc] * w3[cc] + bs[cc]; w0[cc] = w1[cc]; w1[cc] = w2[cc]; w2[cc] = w3[cc]; }
          *(LAS v4u*)(U + (4 * rq + l) * LDU + ch0) = (v4u){pk2(yv[0], yv[1]), pk2(yv[2], yv[3]), pk2(yv[4], yv[5]), pk2(yv[6], yv[7])}; }
    }
    __syncthreads();
    LAS bf16* P16 = (LAS bf16*)(F.lds + RING_OFF + 33792 + 69632);
#pragma unroll 1
    for (int d = 0; d < 2; ++d) {
        { const int blk = w & 3, eh = w >> 2;
          const bf16* WA = WSP(bf16, WS_RGW) + (size_t)(((L * 2 + 0) * 2 + d) * 4 + blk) * 4096; const bf16* WX = WSP(bf16, WS_RGW) + (size_t)(((L * 2 + 1) * 2 + d) * 4 + blk) * 4096;
          bf16x8 wa0[2], wa1[2], wx0[2], wx1[2]; float ba[2], bx[2], sp[2];
#pragma unroll
          for (int n2 = 0; n2 < 2; ++n2) { const int e = 32 * eh + 16 * n2 + c16, ch = blk * 64 + e;
              wa0[n2] = *(const bf16x8*)(WA + e * 64 + 8 * q); wa1[n2] = *(const bf16x8*)(WA + e * 64 + 32 + 8 * q); wx0[n2] = *(const bf16x8*)(WX + e * 64 + 8 * q); wx1[n2] = *(const bf16x8*)(WX + e * 64 + 32 + 8 * q);
              ba[n2] = A.in[I_RBA][(L * 2 + d) * 256 + ch]; bx[n2] = A.in[I_RBX][(L * 2 + d) * 256 + ch]; sp[n2] = A.in[I_RLAM][(L * 2 + d) * 256 + ch]; }
          sp[0] = softplus_f(-sp[0]); sp[1] = softplus_f(-sp[1]);
#pragma unroll
          for (int rt = 0; rt < 4; ++rt) {
              const bf16x8 a0 = lds_frag(U, LDU, 16 * rt, blk * 64, lane), a1 = lds_frag(U, LDU, 16 * rt, blk * 64 + 32, lane);
#pragma unroll
              for (int n2 = 0; n2 < 2; ++n2) { const int ch = blk * 64 + 32 * eh + 16 * n2 + c16;
                  f32x4 pa = {0.f, 0.f, 0.f, 0.f}, px = {0.f, 0.f, 0.f, 0.f};
                  pa = mfma16(a0, wa0[n2], pa); pa = mfma16(a1, wa1[n2], pa); px = mfma16(a0, wx0[n2], px); px = mfma16(a1, wx1[n2], px);
                  v4u pk;
#pragma unroll
                  for (int j = 0; j < 4; ++j) { const int l = 16 * rt + 4 * q + j; const float la = -8.0f * sigmoid_f(pa[j] + ba[n2]) * sp[n2];
                      const float inp = __builtin_amdgcn_sqrtf(fmaxf(1.0f - exp_f(2.0f * la), 0.f)) * sigmoid_f(px[j] + bx[n2]) * bf2f(U[l * LDU + ch]);
                      pk[j] = pk2(la, inp); }
                  if (d == 1) pk = (v4u){pk[3], pk[2], pk[1], pk[0]};
                  *(LAS v4u*)(QT + ch * LDQ + (d == 0 ? 16 * rt + 4 * q : 60 - 16 * rt - 4 * q)) = pk; } } }
        __syncthreads();
        if (tid < 256) { const int ch = tid; const size_t o = (size_t)((b * NCH + c) * 2 + d) * 256 + ch;
            float h = MODE == 1 ? 0.f : WSP(float, WS_RGC)[o], ls = 0.f;
#pragma unroll 1
            for (int g = 0; g < 4; ++g) { v4u qv[4];
#pragma unroll
                for (int i = 0; i < 4; ++i) qv[i] = *(const LAS v4u*)(QT + ch * LDQ + 16 * g + 4 * i);
#pragma unroll
                for (int kk = 0; kk < 16; ++kk) { const unsigned e = qv[kk >> 2][kk & 3]; const float la = bf2f(e & 0xffffu); h = exp_f(la) * h + __uint_as_float(e & 0xffff0000u); ls += la;
                    if (MODE == 1) { const int k = 16 * g + kk, l = d == 0 ? k : 63 - k;
                        WSP(unsigned, WS_RGL)[((size_t)(b * 2 + d) * LB + 64 * c + l) * 256 + ch] = pk2(h, exp_f(ls)); }
                    if (MODE == 3) { const int k = 16 * g + kk; if (d == 0) P16[k * 256 + ch] = (bf16)f2bf(h); else P16[(63 - k) * 256 + ch] = (bf16)f2bf(h + bf2f(P16[(63 - k) * 256 + ch])); } } }
            if (MODE == 1) { float* RS = WSP(float, WS_RGS); *(f32x2_t*)(RS + 2 * o) = (f32x2_t){__expf(ls), h}; } }
        __syncthreads();
    }
    if (MODE == 3) {
        bf16* MG = WSP(bf16, WS_MERGED);
        const f32x4 nwr = *(const f32x4*)(A.in[I_RONORM] + L * 256 + 4 * lane); const f32x4 nwa0 = *(const f32x4*)(A.in[I_AONORM] + L * 512 + 8 * lane), nwa1 = *(const f32x4*)(A.in[I_AONORM] + L * 512 + 8 * lane + 4);
#pragma unroll 1
        for (int r4 = 0; r4 < 8; r4 += 4) {
        v2u gp[4]; v4u op[4];
#pragma unroll
        for (int rr = 0; rr < 4; ++rr) { const size_t r = (size_t)(r0 + 8 * w + r4 + rr); gp[rr] = *(const v2u*)(PROJ + r * NPROJ + GCOL + 4 * lane); op[rr] = *(const v4u*)(WSP(bf16, WS_OB) + r * 512 + 8 * lane); }
#pragma unroll
        for (int rr = 0; rr < 4; ++rr) { const int l = 8 * w + r4 + rr; const size_t r = (size_t)(r0 + l);
            { const v2u hp = *(const LAS v2u*)(P16 + l * 256 + 4 * lane); const f32x4 hv = {bf2f(hp.x & 0xffffu), bf2f(hp.x >> 16), bf2f(hp.y & 0xffffu), bf2f(hp.y >> 16)};
              float v[4]; v[0] = hv[0] * gelu_tanh_f(bf2f(gp[rr].x & 0xffffu)); v[1] = hv[1] * gelu_tanh_f(bf2f(gp[rr].x >> 16)); v[2] = hv[2] * gelu_tanh_f(bf2f(gp[rr].y & 0xffffu)); v[3] = hv[3] * gelu_tanh_f(bf2f(gp[rr].y >> 16));
              const float rs = 1.f / sqrtf(wave_sum((v[0] * v[0] + v[1] * v[1]) + (v[2] * v[2] + v[3] * v[3])) * (1.f / 256.f) + LN_EPS);
              v2u o; o.x = pk2(v[0] * rs * nwr[0], v[1] * rs * nwr[1]); o.y = pk2(v[2] * rs * nwr[2], v[3] * rs * nwr[3]); *(v2u*)(MG + r * 1024 + 768 + 4 * lane) = o; }
            { float v[8]; unpack8(op[rr], v); float s = 0.f;
#pragma unroll
              for (int i = 0; i < 8; ++i) s += v[i] * v[i];
              const float rs = 1.f / sqrtf(wave_sum(s) * (1.f / 512.f) + LN_EPS);
              v4u o; o.x = pk2(v[0] * rs * nwa0[0], v[1] * rs * nwa0[1]); o.y = pk2(v[2] * rs * nwa0[2], v[3] * rs * nwa0[3]); o.z = pk2(v[4] * rs * nwa1[0], v[5] * rs * nwa1[1]); o.w = pk2(v[6] * rs * nwa1[2], v[7] * rs * nwa1[3]);
              *(v4u*)(MG + r * 1024 + 8 * lane) = o; } }
        }
    }
}
__device__ __forceinline__ void p_carry(Frame& F, ArgsR A) {
    typedef float f32x2 __attribute__((ext_vector_type(2)));
    const int gt = blockIdx.x * (NWAVES * 64) + F.tid, NT = F.G * NWAVES * 64;
    for (int idx = gt; idx < 64 * 2048; idx += NT) { const int chain = idx >> 11, e2 = idx & 2047, d = (chain >> 2) & 1;
        const f32x2* S = (const f32x2*)(WSP(float, WS_S) + (size_t)chain * NCH * 4096) + e2; unsigned* H = WSP(unsigned, WS_HIN) + (size_t)chain * NCH * 2048 + e2; const float* T = WSP(float, WS_TOT) + chain * NCH;
        f32x2 st = {0.f, 0.f};
        for (int k0 = 0; k0 < NCH; k0 += 4) { f32x2 s[4]; float tt[4]; int cc[4];
#pragma unroll
            for (int i = 0; i < 4; ++i) { const int k = k0 + i; cc[i] = d == 0 ? k : (k < 4 ? 3 - k : 71 - k); s[i] = S[(size_t)cc[i] * 2048]; tt[i] = T[cc[i]]; }
#pragma unroll
            for (int i = 0; i < 4; ++i) { H[(size_t)cc[i] * 2048] = pk2(st[0], st[1]); st = st * tt[i] + s[i]; } } }
    for (int idx = gt; idx < 4096; idx += NT) { const int b = idx >> 9, d = (idx >> 8) & 1, ch = idx & 255; float st = 0.f;
        for (int k0 = 0; k0 < NCH; k0 += 4) { f32x2 av[4]; size_t oo[4];
#pragma unroll
            for (int i = 0; i < 4; ++i) { const int k = k0 + i, c = d == 0 ? k : (k < 4 ? 3 - k : 71 - k); oo[i] = (size_t)((b * NCH + c) * 2 + d) * 256 + ch; av[i] = *(const f32x2*)(WSP(float, WS_RGS) + 2 * oo[i]); }
#pragma unroll
            for (int i = 0; i < 4; ++i) { WSP(float, WS_RGC)[oo[i]] = st; st = av[i][0] * st + av[i][1]; } } }
}
__device__ __forceinline__ unsigned block_sum_u(Frame& F, unsigned v, LAS unsigned* red) {
#pragma unroll
    for (int o = 1; o < 64; o <<= 1) v += __shfl_xor(v, o);
    __syncthreads();
    if (F.lane == 0) red[F.wave] = v;
    __syncthreads();
    unsigned s = 0;
#pragma unroll
    for (int i = 0; i < 8; ++i) s += red[i];
    return s;
}
__device__ __forceinline__ unsigned block_excl_scan_u(Frame& F, unsigned v, LAS unsigned* red) {
    unsigned inc = v;
#pragma unroll
    for (int o = 1; o < 64; o <<= 1) { const unsigned t = __shfl_up(inc, o); if (F.lane >= o) inc += t; }
    __syncthreads();
    if (F.lane == 63) red[F.wave] = inc;
    __syncthreads();
    unsigned base = 0;
#pragma unroll
    for (int i = 0; i < 8; ++i) base += (i < F.wave) ? red[i] : 0u;
    return base + inc - v;
}
__device__ __forceinline__ void topk_unit(Frame& F, ArgsR A, int set, int b, int e) {
    LAS unsigned* red = (LAS unsigned*)(F.lds + RING_OFF);
    const int n = set == 0 ? NX : NCX, cap = set == 0 ? 512 : 32, row0 = b * LB + (set == 0 ? NCX : 0);
    const float* AFF = WSP(float, WS_AFF);
    unsigned key[8];
#pragma unroll
    for (int j = 0; j < 8; ++j) { const int t = 8 * F.tid + j, tc = t < n ? t : n - 1; const unsigned kv = __float_as_uint(AFF[(size_t)(row0 + tc) * 16 + e]); key[j] = t < n ? kv : 0u; }
    unsigned prefix = 0u;
    for (int it = 0; it < 15; ++it) { const int sh = 28 - 2 * it; const unsigned c1 = prefix | (1u << sh), c2 = prefix | (2u << sh), c3 = prefix | (3u << sh); unsigned pk = 0;
#pragma unroll
        for (int j = 0; j < 8; ++j) pk += (key[j] >= c1 ? 1u : 0u) + (key[j] >= c2 ? 1u << 10 : 0u) + (key[j] >= c3 ? 1u << 20 : 0u);
#pragma unroll
        for (int o = 1; o < 64; o <<= 1) pk += __shfl_xor(pk, o);
        LAS unsigned* rb = red + 16 + 8 * (it & 1);
        if (F.lane == 0) rb[F.wave] = pk;
        __syncthreads();
        unsigned n1 = 0, n2 = 0, n3 = 0;
#pragma unroll
        for (int i = 0; i < 8; ++i) { const unsigned v = rb[i]; n1 += v & 1023u; n2 += (v >> 10) & 1023u; n3 += v >> 20; }
        prefix = n3 >= (unsigned)cap ? c3 : (n2 >= (unsigned)cap ? c2 : (n1 >= (unsigned)cap ? c1 : prefix)); }
    const unsigned T = prefix; unsigned ngt = 0, neq = 0;
#pragma unroll
    for (int j = 0; j < 8; ++j) { ngt += key[j] > T ? 1u : 0u; neq += key[j] == T ? 1u : 0u; }
    const unsigned tot_gt = block_sum_u(F, ngt, red); const unsigned need = (unsigned)cap - tot_gt;
    unsigned tie = block_excl_scan_u(F, neq, red);
    unsigned selmask = 0, nsel = 0;
#pragma unroll
    for (int j = 0; j < 8; ++j) { bool sel = key[j] > T; if (key[j] == T) { sel = tie < need; ++tie; } if (sel) { selmask |= 1u << j; ++nsel; } }
    unsigned slot = block_excl_scan_u(F, nsel, red);
    int* INV = WSP(int, WS_INV); int* SRC = WSP(int, WS_SRC); float* GATE = WSP(float, WS_GATE);
#pragma unroll
    for (int j = 0; j < 8; ++j) { const int t = 8 * F.tid + j; if (t < n) { const int r = row0 + t;
        if ((selmask >> j) & 1u) { const int rg = e * EROWS + (set == 0 ? b * 512 : 4096 + b * 32) + (int)slot; ++slot; SRC[rg] = r; GATE[rg] = __uint_as_float(key[j]); INV[(size_t)r * 16 + e] = rg; }
        else INV[(size_t)r * 16 + e] = -1; } }
}
__device__ __forceinline__ void p_topk(Frame& F, ArgsR A, int L) {
    const int nu = L == 0 ? 256 : 128;
    for (int u = blockIdx.x; u < nu; u += F.G) { __syncthreads(); topk_unit(F, A, u >> 7, (u & 127) >> 4, u & 15); }
}
__device__ __forceinline__ int queue_next(Frame& F, gu32* ctr) { __syncthreads(); if (F.tid == 0) F.MISC[0] = __hip_atomic_fetch_add(ctr, 1u, RLX_AGENT); __syncthreads(); return (int)F.MISC[0]; }
__device__ __forceinline__ void p_x1(Frame& F, ArgsR A, int L) {
    gu32* ctr = (gu32*)(A.ws + WS_CTL) + CW_QUEUE + 64 * (2 * L);
    for (;;) { const int u = queue_next(F, ctr); if (u >= 2 * NB * NCH) break;
        if (u < NB * NCH) rg_unit<1>(F, A, L, u / NCH, u % NCH); else ssd_unit<1>(F, A, L, (u - NB * NCH) / NCH, (u - NB * NCH) % NCH); }
}
__device__ __forceinline__ void p_x3(Frame& F0, ArgsR A, int L) {
    const int par = F0.vcu & 1;
#pragma unroll 1
    for (int step = 0; step < 2; ++step) { Frame F; make_frame(F, F0.lds);
      if ((step ^ par) == 0) {
    gu32* ctr = (gu32*)(A.ws + WS_CTL) + CW_QUEUE + 64 * (2 * L + 1);
    for (;;) { const int u = queue_next(F, ctr); if (u >= NB * NCH) break; if (L == 1 && u % NCH < NCX / 64) continue; ssd_unit<3>(F, A, L, u / NCH, u % NCH); }
      } else {
    const int gw = F.vcu * NWAVES + F.wave, NGW = F.G * NWAVES, lane = F.lane;
    const bf16* PROJ = WSP(bf16, WS_PROJ); bf16* MG = WSP(bf16, WS_MERGED); const unsigned* RGL = WSP(unsigned, WS_RGL); const float* RGC = WSP(float, WS_RGC); const bf16* OB = WSP(bf16, WS_OB);
    const f32x4 nwr = *(const f32x4*)(A.in[I_RONORM] + L * 256 + 4 * lane); const f32x4 nwa0 = *(const f32x4*)(A.in[I_AONORM] + L * 512 + 8 * lane), nwa1 = *(const f32x4*)(A.in[I_AONORM] + L * 512 + 8 * lane + 4);
    const int nrows3 = L == 1 ? NB * NX : R;
    for (int q0 = 2 * gw; q0 < nrows3; q0 += 2 * NGW) { const int r0 = L == 1 ? (q0 / NX) * LB + NCX + q0 % NX : q0;
        v4u sp[2][2]; f32x4 cr[2][2]; v2u gp[2]; v4u op[2];
#pragma unroll
        for (int p = 0; p < 2; ++p) { const int r = r0 + p, b = r / LB, s = r % LB, c = s >> 6;
#pragma unroll
            for (int d = 0; d < 2; ++d) { sp[p][d] = *(const v4u*)(RGL + ((size_t)(b * 2 + d) * LB + s) * 256 + 4 * lane); cr[p][d] = *(const f32x4*)(RGC + (size_t)((b * NCH + c) * 2 + d) * 256 + 4 * lane); }
            gp[p] = *(const v2u*)(PROJ + (size_t)r * NPROJ + GCOL + 4 * lane); op[p] = *(const v4u*)(OB + (size_t)r * 512 + 8 * lane); }
#pragma unroll
        for (int p = 0; p < 2; ++p) { const size_t r = (size_t)(r0 + p);
            { float hv[4];
#pragma unroll
              for (int i = 0; i < 4; ++i) hv[i] = (bf2f(sp[p][0][i] & 0xffffu) + __uint_as_float(sp[p][0][i] & 0xffff0000u) * cr[p][0][i]) + (bf2f(sp[p][1][i] & 0xffffu) + __uint_as_float(sp[p][1][i] & 0xffff0000u) * cr[p][1][i]);
              float v[4]; v[0] = hv[0] * gelu_tanh_f(bf2f(gp[p].x & 0xffffu)); v[1] = hv[1] * gelu_tanh_f(bf2f(gp[p].x >> 16)); v[2] = hv[2] * gelu_tanh_f(bf2f(gp[p].y & 0xffffu)); v[3] = hv[3] * gelu_tanh_f(bf2f(gp[p].y >> 16));
              const float rs = 1.f / sqrtf(wave_sum((v[0] * v[0] + v[1] * v[1]) + (v[2] * v[2] + v[3] * v[3])) * (1.f / 256.f) + LN_EPS);
              v2u o; o.x = pk2(v[0] * rs * nwr[0], v[1] * rs * nwr[1]); o.y = pk2(v[2] * rs * nwr[2], v[3] * rs * nwr[3]); *(v2u*)(MG + r * 1024 + 768 + 4 * lane) = o; }
            { float v[8]; unpack8(op[p], v); float s = 0.f;
#pragma unroll
              for (int i = 0; i < 8; ++i) s += v[i] * v[i];
              const float rs = 1.f / sqrtf(wave_sum(s) * (1.f / 512.f) + LN_EPS);
              v4u o; o.x = pk2(v[0] * rs * nwa0[0], v[1] * rs * nwa0[1]); o.y = pk2(v[2] * rs * nwa0[2], v[3] * rs * nwa0[3]); o.z = pk2(v[4] * rs * nwa1[0], v[5] * rs * nwa1[1]); o.w = pk2(v[6] * rs * nwa1[2], v[7] * rs * nwa1[3]);
              *(v4u*)(MG + r * 1024 + 8 * lane) = o; } } }
      }
      __syncthreads(); }
}
__device__ __forceinline__ void p_attn(Frame& F, ArgsR A, int L, unsigned char* lds_generic) {
    attn_body::bf16* P = (attn_body::bf16*)WSP(bf16, WS_PROJ);
    const int nun = L == 0 ? 1024 + 64 : 1024;
    const int slot = (F.vcu >> 3) & 3;
    for (int a = F.vcu, i = 0; a < nun; a += F.G, ++i) { int b, h, q0, nt;
        if (L == 0 && i == slot) { conv_rounds(F, A, 0, 14, 49152); __syncthreads(); }
        if (a < 1024) { b = a >> 7; h = (a & 127) >> 4; q0 = NCX + 256 * (a & 15); nt = 68; } else { b = (a - 1024) >> 3; h = (a - 1024) & 7; q0 = 0; nt = 4; }
        attn_body::attn_unit<8>(b, h, q0, nt, P, (const attn_body::bf16*)WSP(bf16, WS_KC), (const attn_body::bf16*)WSP(bf16, WS_VC), (attn_body::bf16*)WSP(bf16, WS_OB), A.in[I_QNORM] + L * 64, WSP(float, WS_ROPE), (char*)lds_generic + RING_OFF); }
}
__device__ __forceinline__ void make_frame(Frame& F, LAS unsigned char* lds) {
    F.lds = lds; F.MISC = (volatile LAS unsigned*)(lds + MISC_OFF);
    int tid = threadIdx.x; asm volatile("" : "+v"(tid));
    F.tid = tid; F.lane = F.tid & 63; F.wave = __builtin_amdgcn_readfirstlane(F.tid >> 6);
    int g = gridDim.x, bx = blockIdx.x; asm volatile("" : "+s"(g), "+s"(bx));
    F.G = g; F.vcu = (F.G % 8 == 0) ? (bx % 8) * (F.G / 8) + bx / 8 : bx;
}
__device__ __forceinline__ const __attribute__((address_space(4))) Args* kargs_ptr() { auto p = __builtin_amdgcn_kernarg_segment_ptr(); asm volatile("" : "+s"(p)); return (const __attribute__((address_space(4))) Args*)p; }
#define KARGS (*kargs_ptr())
PHASE_FN void ph_pro0(LAS unsigned char* lds) { Frame F; make_frame(F, lds); p_pro0(F, KARGS); }
PHASE_FN void ph_pro2(LAS unsigned char* lds) { Frame F; make_frame(F, lds); p_pro2(F, KARGS); }
PHASE_FN void ph_inproj(LAS unsigned char* lds, int L) { Frame F; make_frame(F, lds); ArgsR A = KARGS;
    pg8::Gemm g{WSP(bf16, WS_HA), WSP(bf16, WS_WIN) + (size_t)L * 2048 * 1024, R, NPROJ, 1024}; pg8::StaticOrder S; S.init(R, NPROJ, F.G, (int)blockIdx.x);
    pg8::EpiStoreBf16 E{WSP(bf16, WS_PROJ), NPROJ, nullptr};
    pg8::gemm_phase<pg8::EpiStoreBf16, pg8::StaticOrder, true, true>(F.lds + RING_OFF, g, S, E);
    if (blockIdx.x >= 128) conv_rounds(F, A, L, 9, 49152); }
PHASE_FN void ph_qkpost(LAS unsigned char* lds, int L) { Frame F; make_frame(F, lds); p_qkpost(F, KARGS, L); }
PHASE_FN void ph_x1(LAS unsigned char* lds, int L) { Frame F; make_frame(F, lds); p_x1(F, KARGS, L); }
PHASE_FN void ph_attn(LAS unsigned char* lds, unsigned char* lds_generic, int L) { Frame F; make_frame(F, lds); p_attn(F, KARGS, L, lds_generic); }
PHASE_FN void ph_carry(LAS unsigned char* lds, int L) { Frame F; make_frame(F, lds); p_carry(F, KARGS); if (L == 1) { __syncthreads(); conv_rounds(F, KARGS, 1, 1 << 20, 49152); } }
PHASE_FN void ph_x3(LAS unsigned char* lds, int L) { Frame F; make_frame(F, lds); p_x3(F, KARGS, L); }
PHASE_FN void ph_outproj(LAS unsigned char* lds, int L) { Frame F; make_frame(F, lds); ArgsR A = KARGS;
    pg8::Gemm g{WSP(bf16, WS_MERGED), WSP(bf16, WS_WOUT) + (size_t)L * 1024 * 1024, R, 1024, 1024}; pg8::RowOrder S{L == 1, F.G, F.vcu};
    pg8::EpiStoreBf16 E{WSP(bf16, WS_YPRE), 1024, nullptr};
    pg8::gemm_phase<pg8::EpiStoreBf16, pg8::RowOrder, true, true>(F.lds + RING_OFF, g, S, E);
    if (L == 0 && F.vcu >= 32) conv_rounds(F, A, 0, 6, 49152); }
PHASE_FN void ph_ln1(LAS unsigned char* lds, int L) { Frame F; make_frame(F, lds); if (L == 0) conv_rounds(F, KARGS, 0, 1 << 20, 49152); p_ln1(F, KARGS, L); }
PHASE_FN void ph_topk(LAS unsigned char* lds, int L) { Frame F; make_frame(F, lds); p_topk(F, KARGS, L); }
PHASE_FN void ph_gemm1(LAS unsigned char* lds, int L) { Frame F; make_frame(F, lds); ArgsR A = KARGS;
    pg8::Gemm g{WSP(bf16, WS_HA), WSP(bf16, WS_WGU), RGROWS, 4096, 1024, WSP(int, WS_SRC)}; pg8::MoeOrder S{L == 0 ? 17 : 16, 16, F.G, F.vcu};
    pg8::EpiSwiGlu E{WSP(bf16, WS_HID), FF};
    pg8::gemm_phase<pg8::EpiSwiGlu, pg8::MoeOrder, true, true, true>(F.lds + RING_OFF, g, S, E); }
PHASE_FN void ph_gemm2(LAS unsigned char* lds, int L) { Frame F; make_frame(F, lds); ArgsR A = KARGS;
    pg8::Gemm g{WSP(bf16, WS_HID), WSP(bf16, WS_WD), RGROWS, 1024, FF}; pg8::MoeOrder S{L == 0 ? 17 : 16, 4, F.G, F.vcu};
    pg8::EpiStoreBf16 E{WSP(bf16, WS_YPRE), 1024, WSP(float, WS_GATE)};
    pg8::gemm_phase<pg8::EpiStoreBf16, pg8::MoeOrder, true, true>(F.lds + RING_OFF, g, S, E);
    if (L == 0 && F.vcu >= 64) { const int qmax = 32768 / (8 * (F.G > 64 ? F.G - 64 : 1)); conv_rounds(F, A, 1, qmax < 20 ? qmax : 20, 32768); } }
PHASE_FN void ph_ln2(LAS unsigned char* lds, int L) { Frame F; make_frame(F, lds); p_ln2(F, KARGS, L); }

__global__ void __launch_bounds__(NWAVES * 64, 2) mk_fwd(Args A) {
    extern __shared__ __attribute__((aligned(16))) unsigned char lds[];
    LAS unsigned char* L3 = (LAS unsigned char*)lds;
    volatile LAS unsigned* MISC = (volatile LAS unsigned*)(L3 + MISC_OFF);
    gu32* ctl = (gu32*)(A.ws + WS_CTL);
    for (int u = threadIdx.x; u < (LDS_BYTES - LDSCTL_OFF) / 4; u += NWAVES * 64) ((LAS unsigned*)(L3 + LDSCTL_OFF))[u] = 0u;
    __syncthreads();
    const int lo = A.ph_lo, hi = A.ph_hi;
    XcdBarrier bar; bar.bar = (unsigned*)(ctl + CW_BAR); bar.x = 0; bar.st = nullptr;
    if (hi - lo > 1) bar = xcd_barrier_post((unsigned*)(ctl + CW_BAR), MISC + 8);
#ifndef PHMASK
#define PHMASK 0xfffff
#endif
#define EN(bit) (((PHMASK) >> (bit)) & 1)
#ifndef DUPMASK
#define DUPMASK 0
#endif
#define DUP(bit, call) do { if (((DUPMASK) >> (bit)) & 1) { __syncthreads(); call; } } while (0)
#define IN(k) (lo <= (k) && (k) < hi)
#define SEAM(k) do { if (IN(k) && IN((k) + 1)) xcd_barrier(bar); else __syncthreads(); } while (0)
    if (EN(0) && IN(PH_PRO0)) { ph_pro0(L3); DUP(0, ph_pro0(L3)); } SEAM(PH_PRO0);
    if (EN(2) && IN(PH_PRO2)) { ph_pro2(L3); DUP(2, ph_pro2(L3)); } SEAM(PH_PRO2);
#pragma unroll 1
    for (int L = 0; L < 2; ++L) {
        const int pb = PH_L0 + PH_PER_LAYER * L;
        if (EN(3) && IN(pb + PL_INPROJ)) { ph_inproj(L3, L); DUP(3, ph_inproj(L3, L)); } SEAM(pb + PL_INPROJ);
        if (EN(4) && IN(pb + PL_QKPOST)) ph_qkpost(L3, L); SEAM(pb + PL_QKPOST);
        if (IN(pb + PL_MIX1)) { if (EN(15)) { ph_attn(L3, lds, L); DUP(15, ph_attn(L3, lds, L)); } __syncthreads(); if (EN(5)) ph_x1(L3, L); } SEAM(pb + PL_MIX1);
        if (EN(6) && IN(pb + PL_CARRY)) { ph_carry(L3, L); DUP(6, ph_carry(L3, L)); } SEAM(pb + PL_CARRY);
        if (EN(7) && IN(pb + PL_MIX3)) ph_x3(L3, L); SEAM(pb + PL_MIX3);
        if (EN(8) && IN(pb + PL_OUTPROJ)) { ph_outproj(L3, L); DUP(8, ph_outproj(L3, L)); } SEAM(pb + PL_OUTPROJ);
        if (EN(9) && IN(pb + PL_LN1)) { ph_ln1(L3, L); DUP(9, ph_ln1(L3, L)); } SEAM(pb + PL_LN1);
        if (EN(10) && IN(pb + PL_TOPK)) { ph_topk(L3, L); DUP(10, ph_topk(L3, L)); } SEAM(pb + PL_TOPK);
        if (EN(12) && IN(pb + PL_GEMM1)) { ph_gemm1(L3, L); DUP(12, ph_gemm1(L3, L)); } SEAM(pb + PL_GEMM1);
        if (EN(13) && IN(pb + PL_GEMM2)) { ph_gemm2(L3, L); DUP(13, ph_gemm2(L3, L)); } SEAM(pb + PL_GEMM2);
        if (EN(14) && IN(pb + PL_LN2)) { ph_ln2(L3, L); if (L == 1) DUP(14, ph_ln2(L3, L)); } SEAM(pb + PL_LN2);
    }
#undef IN
#undef SEAM
}

extern "C" void kernel_launch(void* const* d_in, const int* in_sizes, int n_in, void* d_out, int out_size, void* d_ws, size_t ws_size, hipStream_t stream) {
    static int grid = 0;
    if (grid == 0) {
        if (n_in != 33 || out_size != NB * NX * DMODEL || ws_size < WS_END) { fprintf(stderr, "kernel_launch: unexpected problem (n_in %d, out %d, ws %zu)\n", n_in, out_size, ws_size); grid = -1; return; }
        int dev = 0, cus = 0, per_cu = 0;
        if (hipGetDevice(&dev) != hipSuccess || hipDeviceGetAttribute(&cus, hipDeviceAttributeMultiprocessorCount, dev) != hipSuccess) { grid = -1; return; }
        if (hipFuncSetAttribute((const void*)mk_fwd, hipFuncAttributeMaxDynamicSharedMemorySize, LDS_BYTES) != hipSuccess) { fprintf(stderr, "kernel_launch: hipFuncSetAttribute failed\n"); grid = -1; return; }
        if (hipOccupancyMaxActiveBlocksPerMultiprocessor(&per_cu, (const void*)mk_fwd, NWAVES * 64, LDS_BYTES) != hipSuccess || per_cu < 1) fprintf(stderr, "kernel_launch: occupancy query reports %d\n", per_cu);
        (void)hipGetLastError();
        grid = cus;
    }
    if (grid < 0) return;
    if (hipMemsetAsync((char*)d_ws + WS_CTL, 0, CTL_ZERO_BYTES, stream) != hipSuccess) return;
    Args a{};
    for (int i = 0; i < 33; ++i) a.in[i] = (const float*)d_in[i];
    a.out = (float*)d_out; a.ws = (unsigned char*)d_ws;
#if MK_PER_PHASE
    for (int p = 0; p < N_PHASES; ++p) { a.ph_lo = p; a.ph_hi = p + 1; hipLaunchKernelGGL(mk_fwd, dim3(grid), dim3(NWAVES * 64), LDS_BYTES, stream, a); }
#else
    a.ph_lo = 0; a.ph_hi = N_PHASES; hipLaunchKernelGGL(mk_fwd, dim3(grid), dim3(NWAVES * 64), LDS_BYTES, stream, a);
#endif
}
```

```cpp
#include <hip/hip_runtime.h>
#include <hip/hip_bf16.h>
#include <cstdio>
#include <cstdint>
#include <cmath>
namespace pg8 {
#define PG8_LAS __attribute__((address_space(3)))
typedef unsigned short bf16_t;
typedef short bf16x8 __attribute__((ext_vector_type(8)));
typedef float f32x4 __attribute__((ext_vector_type(4)));
typedef unsigned u32x4 __attribute__((ext_vector_type(4)));
constexpr int BM = 256, BK = 64, HALF = 128, HTB = HALF * BK * 2  , STAGE_BYTES = 8 * HTB, NXCD = 8, WGM = 8;

__host__ __device__ __forceinline__ int lds_byte(int r, int c) { const int st = (r >> 4) * 2 + (c >> 5), rr = r & 15, cc = c & 31, ob = rr * 64 + cc * 2; return st * 1024 + (ob ^ (((ob >> 9) & 1) << 5)); }
__host__ __device__ __forceinline__ void stage_rc(int b, int& R, int& C) { const int st = b / 1024, sb = b % 1024, swz = sb ^ (((sb >> 9) & 1) << 5); R = (st >> 1) * 16 + swz / 64; C = (st & 1) * 32 + (swz % 64) / 2; }
__host__ __device__ __forceinline__ int perm32(int rho) { const int n = rho >> 4, i = rho & 15; return 8 * (i >> 2) + 4 * n + (i & 3); }

struct Unit { int pm, pn, pa, pb; };
struct Gemm { const bf16_t* A; const bf16_t* Bt; int M, N, K; const int* rowsrc = nullptr; };

struct StaticOrder {
    int nM, nN, nwg, G, c;
    __host__ __device__ void init(int M, int N, int G_, int c_) { nM = M / BM; nN = N / BM; nwg = nM * nN; G = G_; c = c_; }
    __host__ __device__ bool next(int i, Unit& u) const {
        const long L = (long)i * G + c; if (L >= nwg) return false;
        int wgid = (int)L; { const int q = nwg / NXCD, r = nwg % NXCD, xcd = wgid % NXCD, off = wgid / NXCD; wgid = (xcd < r ? xcd * (q + 1) : r * (q + 1) + (xcd - r) * q) + off; }
        const int nig = WGM * nN, gid = wgid / nig, fm = gid * WGM, gsz = (nM - fm) < WGM ? (nM - fm) : WGM;
        u.pm = fm + ((wgid % nig) % gsz); u.pn = (wgid % nig) / gsz; u.pa = u.pm; u.pb = u.pn; return true;
    }
    __device__ __forceinline__ void a_ready(const Unit&) const {}
    __device__ __forceinline__ void done(const Unit&) const {}
};

__device__ __forceinline__ unsigned cvt_pk_bf16(float lo, float hi) { unsigned r; asm volatile("v_cvt_pk_bf16_f32 %0, %1, %2" : "=v"(r) : "v"(lo), "v"(hi)); return r; }
__device__ __forceinline__ float silu_f(float x) { return x * __builtin_amdgcn_rcpf(1.f + __builtin_amdgcn_exp2f(x * -1.4426950408889634f)); }
struct EpiStoreBf16 {
    static constexpr bool PERM = true, AFTER_DRAIN = false;
    bf16_t* O; int ldc; const float* rowscale;
    __device__ __forceinline__ void operator()(const f32x4 (&acc)[2][2][4][2], const Unit& u, int wr, int wc, int fr, int fq) const {
        const int row0 = u.pm * BM + wr * 64 + fr; const int col0 = u.pn * BM + wc * 32 + 8 * fq;
#pragma unroll
        for (int ai = 0; ai < 2; ++ai)
#pragma unroll
            for (int m = 0; m < 4; ++m) { const int row = row0 + ai * HALF + m * 16; bf16_t* rowp = O + (size_t)row * ldc + col0;
                const float sc = rowscale ? rowscale[row] : 1.f;
#pragma unroll
                for (int bj = 0; bj < 2; ++bj) { const f32x4 v0 = acc[ai][bj][m][0] * sc, v1 = acc[ai][bj][m][1] * sc;
                    u32x4 w; w.x = cvt_pk_bf16(v0[0], v0[1]); w.y = cvt_pk_bf16(v0[2], v0[3]); w.z = cvt_pk_bf16(v1[0], v1[1]); w.w = cvt_pk_bf16(v1[2], v1[3]);
                    *(u32x4*)(rowp + bj * HALF) = w; } }
    }
};
struct EpiSwiGlu {
    static constexpr bool PERM = false, AFTER_DRAIN = false;
    bf16_t* O; int ldc;
    __device__ __forceinline__ void operator()(const f32x4 (&acc)[2][2][4][2], const Unit& u, int wr, int wc, int fr, int fq) const {
#pragma unroll
        for (int ai = 0; ai < 2; ++ai)
#pragma unroll
            for (int m = 0; m < 4; ++m) { const int row = u.pm * BM + ai * HALF + wr * 64 + m * 16 + fr; const int col = u.pn * 128 + wc * 32 + 8 * fq;
                const f32x4 g0 = acc[ai][0][m][0], u0 = acc[ai][0][m][1], g1 = acc[ai][1][m][0], u1 = acc[ai][1][m][1];
                u32x4 w; w.x = cvt_pk_bf16(silu_f(g0[0]) * u0[0], silu_f(g0[1]) * u0[1]); w.y = cvt_pk_bf16(silu_f(g0[2]) * u0[2], silu_f(g0[3]) * u0[3]);
                w.z = cvt_pk_bf16(silu_f(g1[0]) * u1[0], silu_f(g1[1]) * u1[1]); w.w = cvt_pk_bf16(silu_f(g1[2]) * u1[2], silu_f(g1[3]) * u1[3]);
                *(u32x4*)(O + (size_t)row * ldc + col) = w; }
    }
};
struct EpiResid {
    static constexpr bool PERM = false, AFTER_DRAIN = false;
    const float* xres; float* out; const float* g1base; float alpha;
    __device__ __forceinline__ void operator()(const f32x4 (&acc)[2][2][4][2], const Unit& u, int wr, int wc, int fr, int fq) const {
        const int mrow = (u.pm % 17 == 0) ? 8 : (u.pm / 17); const float* g1 = g1base + (size_t)mrow * 6144;
        const int col0 = u.pn * BM + wc * 32 + 4 * fq;
        f32x4 gv[2][2];
#pragma unroll
        for (int bj = 0; bj < 2; ++bj)
#pragma unroll
            for (int n = 0; n < 2; ++n) gv[bj][n] = *(const f32x4*)(g1 + col0 + bj * HALF + n * 16);
#pragma unroll
        for (int ai = 0; ai < 2; ++ai)
#pragma unroll
            for (int m = 0; m < 4; ++m) { const size_t off = (size_t)(u.pm * BM + ai * HALF + wr * 64 + m * 16 + fr) * 1024 + col0;
#pragma unroll
                for (int bj = 0; bj < 2; ++bj)
#pragma unroll
                    for (int n = 0; n < 2; ++n) { const f32x4 xr = *(const f32x4*)(xres + off + bj * HALF + n * 16);
                        *(f32x4*)(out + off + bj * HALF + n * 16) = acc[ai][bj][m][n] * gv[bj][n] + xr * alpha; } }
    }
};
struct RowOrder {
    bool xonly; int G, c;
    __device__ __forceinline__ bool next(int i, Unit& u) const {
        const long L = (long)i * G + c; const int ntiles = xonly ? 128 : 136; if (L >= (long)ntiles * 4) return false;
        const int U = (int)L, xt = U >> 2; u.pm = xonly ? (xt >> 4) * 17 + 1 + (xt & 15) : xt; u.pn = U & 3; u.pa = u.pm; u.pb = u.pn; return true;
    }
    __device__ __forceinline__ void a_ready(const Unit&) const {}
    __device__ __forceinline__ void done(const Unit&) const {}
};
struct MoeOrder {
    int MT, NTB, G, c;
    __device__ __forceinline__ bool next(int i, Unit& u) const {
        const long L = (long)i * G + c; if (L >= (long)16 * MT * NTB) return false;
        const int U = (int)L, per = MT * NTB, e = U / per, rem = U % per; int mt = rem / NTB, nt = rem % NTB;
        if (MT == 16 && NTB == 16) { const int x = rem >> 5, sl = rem & 31; mt = 4 * (x >> 1) + (sl >> 3); nt = 8 * (x & 1) + (sl & 7); }
        u.pa = e * 17 + mt; u.pb = e * NTB + nt; u.pm = u.pa; u.pn = nt; return true;
    }
    __device__ __forceinline__ void a_ready(const Unit&) const {}
    __device__ __forceinline__ void done(const Unit&) const {}
};
template <class Epi, class Sched, bool ALIGN_EPI = false, bool SP2 = false, bool GATHER = false>
__device__ __forceinline__ void gemm_phase(PG8_LAS unsigned char* lds, const Gemm g, const Sched& S, const Epi& E) {
    int tid_ = threadIdx.x; asm volatile("" : "+v"(tid_));
    const int tid = tid_, wid = __builtin_amdgcn_readfirstlane(tid >> 6), lane = tid & 63, wr = wid >> 2, wc = wid & 3, fr = lane & 15, fq = lane >> 4;
    const int K = g.K, nt = K / BK;
    static_assert(!GATHER || SP2, "the gathered A path is written for the SP2 loop only");
    unsigned voffA[2], voffB[2], ccol[2] = {0u, 0u}; int rrow[2] = {0, 0};
#pragma unroll
    for (int i = 0; i < 2; ++i) { int R, C; stage_rc(tid * 16 + i * 8192, R, C); const int Rb = Epi::PERM ? ((R & ~31) + perm32(R & 31)) : R;
        voffA[i] = (unsigned)(R * K + C) * 2u; voffB[i] = (unsigned)(Rb * K + C) * 2u; ccol[i] = (unsigned)C * 2u; rrow[i] = R; }
    const size_t kstep = (size_t)(BK * 2);
    const size_t hstep = (size_t)HALF * K * 2;
    const size_t tstep = 2 * hstep;
    const unsigned ldsw = (unsigned)wid * 1024u;
    const int aoff = lds_byte(wr * 64 + fr, fq * 8), boff = lds_byte(wc * 32 + fr, fq * 8);
#define PG8_SA(b, h) (((b) * 2 + (h)) * HTB)
#define PG8_SB(b, h) ((4 + (b) * 2 + (h)) * HTB)
    const char* gA = (const char*)g.A; PG8_LAS unsigned* idxl = (PG8_LAS unsigned*)(lds + STAGE_BYTES);
#define PG8_IDX(buf, hi) (idxl[((buf) * 4 + (hi)) * 512 + wid * 64 + lane])
#define PG8_STA(bufoff, gbase, gptr, w0, w1) do { if constexpr (GATHER) { const unsigned vo_[2] = {(w0) * (unsigned)(K * 2) + ccol[0], (w1) * (unsigned)(K * 2) + ccol[1]}; PG8_STAGE(bufoff, gptr, vo_); } else { PG8_STAGE(bufoff, gbase, voffA); } } while (0)
#define PG8_WAIT_VX() do { if constexpr (GATHER) asm volatile("s_waitcnt vmcnt(12)" ::: "memory"); else asm volatile("s_waitcnt vmcnt(8)" ::: "memory"); } while (0)
#define PG8_STAGE(bufoff, gbase, voff) do { _Pragma("unroll") for (int _i = 0; _i < 2; ++_i) \
        __builtin_amdgcn_global_load_lds((const unsigned*)((const char*)(gbase) + (voff)[_i]), (PG8_LAS unsigned*)(lds + (bufoff) + ldsw + _i * 8192), 16, 0, 0); } while (0)
#define PG8_LDA(dst, b, h) do { _Pragma("unroll") for (int m = 0; m < 4; ++m) _Pragma("unroll") for (int k = 0; k < 2; ++k) dst[m][k] = *(const PG8_LAS bf16x8*)(lds + PG8_SA(b, h) + aoff + m * 2048 + k * 1024); } while (0)
#define PG8_LDB(dst, b, h) do { _Pragma("unroll") for (int n = 0; n < 2; ++n) _Pragma("unroll") for (int k = 0; k < 2; ++k) dst[n][k] = *(const PG8_LAS bf16x8*)(lds + PG8_SB(b, h) + boff + n * 2048 + k * 1024); } while (0)
#define PG8_MMA(ai, bj, At, Bt) do { __builtin_amdgcn_s_setprio(1); _Pragma("unroll") for (int m = 0; m < 4; ++m) _Pragma("unroll") for (int n = 0; n < 2; ++n) _Pragma("unroll") for (int k = 0; k < 2; ++k) \
        acc[ai][bj][m][n] = __builtin_amdgcn_mfma_f32_16x16x32_bf16(Bt[n][k], At[m][k], acc[ai][bj][m][n], 0, 0, 0); __builtin_amdgcn_s_setprio(0); } while (0)
#define PG8_WAIT_V(n) asm volatile("s_waitcnt vmcnt(" #n ")" ::: "memory")
#define PG8_WAIT_L(n) asm volatile("s_waitcnt lgkmcnt(" #n ")" ::: "memory")
#define PG8_BAR __builtin_amdgcn_s_barrier()
#define PG8_SCHED __builtin_amdgcn_sched_barrier(0)
    Unit cur, nxt; int ui = 0;
    if (!S.next(0, cur)) return;
    f32x4 acc[2][2][4][2];
#pragma unroll
    for (int a = 0; a < 2; ++a)
#pragma unroll
        for (int b = 0; b < 2; ++b)
#pragma unroll
            for (int m = 0; m < 4; ++m)
#pragma unroll
                for (int n = 0; n < 2; ++n) acc[a][b][m][n] = (f32x4){0.f, 0.f, 0.f, 0.f};
    bf16x8 At[4][2], B0[2][2], B1[2][2];
    const char* cA = (const char*)g.A + (size_t)cur.pa * tstep; const char* cB = (const char*)g.Bt + (size_t)cur.pb * tstep;
    unsigned w00 = 0u, w01 = 0u, w10 = 0u, w11 = 0u;
    if constexpr (GATHER) { const int* rs = g.rowsrc + (size_t)cur.pa * 256; w00 = (unsigned)rs[rrow[0]]; w01 = (unsigned)rs[rrow[1]]; w10 = (unsigned)rs[128 + rrow[0]]; w11 = (unsigned)rs[128 + rrow[1]];
        PG8_IDX(0, 0) = w00; PG8_IDX(0, 1) = w01; PG8_IDX(0, 2) = w10; PG8_IDX(0, 3) = w11; }
    S.a_ready(cur);
    if constexpr (SP2) {
        PG8_STAGE(PG8_SB(0, 0), cB, voffB); PG8_STAGE(PG8_SB(0, 1), cB + hstep, voffB); PG8_STA(PG8_SA(0, 0), cA, gA, w00, w01); PG8_STA(PG8_SA(0, 1), cA + hstep, gA, w10, w11);
        if (wr == 1) PG8_BAR;
        PG8_WAIT_V(2); PG8_BAR;
        PG8_STAGE(PG8_SB(1, 0), cB + kstep, voffB); PG8_STA(PG8_SA(1, 0), cA + kstep, gA + kstep, w00, w01); PG8_STAGE(PG8_SB(1, 1), cB + hstep + kstep, voffB);
        PG8_WAIT_V(6); PG8_BAR;
    } else {
        PG8_STAGE(PG8_SB(0, 0), cB, voffB); PG8_STAGE(PG8_SA(0, 0), cA, voffA); PG8_STAGE(PG8_SB(0, 1), cB + hstep, voffB); PG8_STAGE(PG8_SA(0, 1), cA + hstep, voffA);
        if (wr == 1) PG8_BAR;
        PG8_WAIT_V(4); PG8_BAR;
        PG8_STAGE(PG8_SB(1, 0), cB + kstep, voffB); PG8_STAGE(PG8_SA(1, 0), cA + kstep, voffA); PG8_STAGE(PG8_SB(1, 1), cB + hstep + kstep, voffB);
        PG8_WAIT_V(6); PG8_BAR;
    }
    for (;;) {
        const bool has_next = S.next(ui + 1, nxt);
        const char* nA = has_next ? (const char*)g.A + (size_t)nxt.pa * tstep : cA; const char* nB = has_next ? (const char*)g.Bt + (size_t)nxt.pb * tstep : cB;
        for (int t = 0; t < nt; t += 2) {
            const bool last = (t == nt - 2);
            const char* a1 = cA + (size_t)(t + 1) * kstep;
            const char* a2 = last ? nA : cA + (size_t)(t + 2) * kstep; const char* b2 = last ? nB : cB + (size_t)(t + 2) * kstep;
            const char* a3 = a2 + kstep; const char* b3 = b2 + kstep;
            if (last && has_next) S.a_ready(nxt);
            const int cbuf = ui & 1, xbuf = (last && has_next) ? (cbuf ^ 1) : cbuf;
            const char* ga1 = gA + (size_t)(t + 1) * kstep; const char* ga2 = last ? gA : gA + (size_t)(t + 2) * kstep; const char* ga3 = ga2 + kstep;
            unsigned c10 = 0u, c11 = 0u, x00 = 0u, x01 = 0u, x10 = 0u, x11 = 0u;
            if constexpr (GATHER) {
                { const int* rs = g.rowsrc + (size_t)(has_next ? nxt.pa : cur.pa) * 256;
                    __builtin_amdgcn_global_load_lds((const unsigned*)(rs + rrow[0]), &PG8_IDX(cbuf ^ 1, 0) - lane, 4, 0, 0); __builtin_amdgcn_global_load_lds((const unsigned*)(rs + rrow[1]), &PG8_IDX(cbuf ^ 1, 1) - lane, 4, 0, 0);
                    __builtin_amdgcn_global_load_lds((const unsigned*)(rs + 128 + rrow[0]), &PG8_IDX(cbuf ^ 1, 2) - lane, 4, 0, 0); __builtin_amdgcn_global_load_lds((const unsigned*)(rs + 128 + rrow[1]), &PG8_IDX(cbuf ^ 1, 3) - lane, 4, 0, 0); }
                c10 = PG8_IDX(cbuf, 2); c11 = PG8_IDX(cbuf, 3); x00 = PG8_IDX(xbuf, 0); x01 = PG8_IDX(xbuf, 1); x10 = PG8_IDX(xbuf, 2); x11 = PG8_IDX(xbuf, 3);
            }
            if constexpr (SP2) {
            PG8_LDB(B0, 0, 0); PG8_LDB(B1, 0, 1); PG8_SCHED; PG8_LDA(At, 0, 0); PG8_STA(PG8_SA(1, 1), a1 + hstep, ga1, c10, c11);
            PG8_WAIT_VX(); PG8_WAIT_L(0); PG8_BAR; PG8_MMA(0, 0, At, B0); PG8_MMA(0, 1, At, B1); PG8_BAR; PG8_SCHED;
            PG8_LDA(At, 0, 1); PG8_STAGE(PG8_SB(0, 0), b2, voffB); PG8_STAGE(PG8_SB(0, 1), b2 + hstep, voffB); PG8_STA(PG8_SA(0, 0), a2, ga2, x00, x01);
            PG8_WAIT_VX(); PG8_WAIT_L(0); PG8_BAR; PG8_MMA(1, 0, At, B0); PG8_MMA(1, 1, At, B1); PG8_BAR; PG8_SCHED;
            PG8_LDB(B0, 1, 0); PG8_LDB(B1, 1, 1); PG8_SCHED; PG8_LDA(At, 1, 0); PG8_STA(PG8_SA(0, 1), a2 + hstep, ga2, x10, x11);
            PG8_WAIT_V(8); PG8_WAIT_L(0); PG8_BAR; PG8_MMA(0, 0, At, B0); PG8_MMA(0, 1, At, B1); PG8_BAR; PG8_SCHED;
            PG8_LDA(At, 1, 1); PG8_STAGE(PG8_SB(1, 0), b3, voffB); PG8_STAGE(PG8_SB(1, 1), b3 + hstep, voffB); PG8_STA(PG8_SA(1, 0), a3, ga3, x00, x01);
            PG8_WAIT_V(8); PG8_WAIT_L(0); PG8_BAR; PG8_MMA(1, 0, At, B0); PG8_MMA(1, 1, At, B1); PG8_BAR; PG8_SCHED;
            } else {
            PG8_LDB(B0, 0, 0); PG8_SCHED; PG8_LDA(At, 0, 0); PG8_STAGE(PG8_SA(1, 1), a1 + hstep, voffA);
            PG8_WAIT_L(8); PG8_BAR; PG8_WAIT_L(0); PG8_MMA(0, 0, At, B0); PG8_BAR; PG8_SCHED;
            PG8_LDB(B1, 0, 1); PG8_STAGE(PG8_SB(0, 0), b2, voffB);
            PG8_BAR; PG8_WAIT_L(0); PG8_MMA(0, 1, At, B1); PG8_BAR;
            PG8_LDA(At, 0, 1); PG8_STAGE(PG8_SA(0, 0), a2, voffA);
            PG8_BAR; PG8_WAIT_L(0); PG8_MMA(1, 0, At, B0); PG8_BAR; PG8_SCHED;
            PG8_STAGE(PG8_SB(0, 1), b2 + hstep, voffB);
            PG8_WAIT_V(6); PG8_BAR; PG8_MMA(1, 1, At, B1); PG8_BAR;
            PG8_LDB(B0, 1, 0); PG8_SCHED; PG8_LDA(At, 1, 0); PG8_STAGE(PG8_SA(0, 1), a2 + hstep, voffA);
            PG8_WAIT_L(8); PG8_BAR; PG8_WAIT_L(0); PG8_MMA(0, 0, At, B0); PG8_BAR; PG8_SCHED;
            PG8_LDB(B1, 1, 1); PG8_STAGE(PG8_SB(1, 0), b3, voffB);
            PG8_BAR; PG8_WAIT_L(0); PG8_MMA(0, 1, At, B1); PG8_BAR;
            PG8_LDA(At, 1, 1); PG8_STAGE(PG8_SA(1, 0), a3, voffA);
            PG8_BAR; PG8_WAIT_L(0); PG8_MMA(1, 0, At, B0); PG8_BAR; PG8_SCHED;
            PG8_STAGE(PG8_SB(1, 1), b3 + hstep, voffB);
            PG8_WAIT_V(6); PG8_BAR; PG8_MMA(1, 1, At, B1); PG8_BAR;
            }
        }
        if constexpr (ALIGN_EPI) { if (wr == 0) PG8_BAR; }
        if constexpr (!Epi::AFTER_DRAIN) { E(acc, cur, wr, wc, fr, fq); S.done(cur); }
        if (!has_next) break;
#pragma unroll
        for (int a = 0; a < 2; ++a)
#pragma unroll
            for (int b = 0; b < 2; ++b)
#pragma unroll
                for (int m = 0; m < 4; ++m)
#pragma unroll
                    for (int n = 0; n < 2; ++n) acc[a][b][m][n] = (f32x4){0.f, 0.f, 0.f, 0.f};
        cur = nxt; cA = nA; cB = nB; ++ui;
        if constexpr (ALIGN_EPI) { if (wr == 1) PG8_BAR; }
    }
    PG8_WAIT_V(0);
    if constexpr (!ALIGN_EPI) { if (wr == 0) PG8_BAR; }
    PG8_BAR;
    if constexpr (Epi::AFTER_DRAIN) { E.fused(acc, cur, wr, wc, fr, fq, lds, wid, lane); S.done(cur); }
#undef PG8_SA
#undef PG8_SB
#undef PG8_STAGE
#undef PG8_STA
#undef PG8_IDX
#undef PG8_WAIT_VX
#undef PG8_LDA
#undef PG8_LDB
#undef PG8_MMA
#undef PG8_WAIT_V
#undef PG8_WAIT_L
#undef PG8_BAR
#undef PG8_SCHED
}
}
namespace attn_body {
using bf16=__hip_bfloat16;
using bf16x8=__attribute__((ext_vector_type(8)))short;
using s16x4=__attribute__((ext_vector_type(4)))short;
using f32x16=__attribute__((ext_vector_type(16)))float;
using u32x4=__attribute__((ext_vector_type(4)))unsigned;
constexpr int D=64,DM=2048,DMK=128,LBROWS=4352;
constexpr int NW=8,QBLK=32,QB=QBLK*NW,KVBLK=64;
__device__ __forceinline__ int crow(int r,int hi){return (r&3)+8*(r>>2)+4*hi;}
#define SBAR() __builtin_amdgcn_sched_barrier(0)
__device__ __forceinline__ void cmask(f32x16&p0,f32x16&p1,int jb,int qrel,int hi){
  const float NEG=-INFINITY; int kb=64*jb+4*hi;
  #pragma unroll
  for(int r=0;r<16;++r){int kv=kb+(r&3)+8*(r>>2); if(kv>qrel)p0[r]=NEG; if(kv+32>qrel)p1[r]=NEG;}
}

constexpr int NSLOT=3, SLOTB=8192;
constexpr int LDS_K=0, LDS_V=NSLOT*SLOTB, LDS_WS=2*NSLOT*SLOTB, LDS_OST=LDS_WS+NW*64*4, LDS_BYTES=LDS_OST+NW*4096;
constexpr float C2=0.125f*1.4426950408889634f;
__device__ __forceinline__ void glds16(const void*gsrc,unsigned lds_dst){unsigned keep;
  asm volatile("s_mov_b32 %0, m0\n\ts_mov_b32 m0, %2\n\ts_nop 0\n\tglobal_load_lds_dwordx4 %1, off\n\ts_mov_b32 m0, %0":"=&s"(keep):"v"(gsrc),"s"(lds_dst):"memory");}
__device__ __forceinline__ float max3f(float a,float b,float c){float r;asm("v_max3_f32 %0, %1, %2, %3":"=v"(r):"v"(a),"v"(b),"v"(c));return r;}
__device__ __forceinline__ float max2f(float a,float b){float r;asm("v_max_f32_e32 %0, %1, %2":"=v"(r):"v"(a),"v"(b));return r;}
__device__ __forceinline__ float fadd_s(float a,float b){float r;asm("v_add_f32_e32 %0, %1, %2":"=v"(r):"v"(a),"v"(b));return r;}
__device__ __forceinline__ float fsub_s(float a,float b){float r;asm("v_sub_f32_e32 %0, %1, %2":"=v"(r):"v"(a),"v"(b));return r;}
typedef float f32x2_t __attribute__((ext_vector_type(2))); typedef __bf16 bf16x2_t __attribute__((ext_vector_type(2)));
__device__ __forceinline__ unsigned cvtpk_s(float lo,float hi){f32x2_t v={lo,hi};bf16x2_t b=__builtin_convertvector(v,bf16x2_t);return __builtin_bit_cast(unsigned,b);}
#define WAIT_BAR(N) asm volatile("s_waitcnt vmcnt(" #N ") lgkmcnt(0)\n\ts_barrier":::"memory")

__device__ __forceinline__ void qkt(f32x16&p0,f32x16&p1,const char*Kslot,const bf16x8*qr,const f32x16&negm,int r32,int hi){
  const char*kb=Kslot+hi*1024+r32*16;
  #pragma unroll
  for(int d0=0;d0<4;++d0){
    const bf16x8 b0=*reinterpret_cast<const bf16x8*>(kb+d0*2048);
    const bf16x8 b1=*reinterpret_cast<const bf16x8*>(kb+d0*2048+512);
    if(d0==0){p0=__builtin_amdgcn_mfma_f32_32x32x16_bf16(b0,qr[0],negm,0,0,0);p1=__builtin_amdgcn_mfma_f32_32x32x16_bf16(b1,qr[0],negm,0,0,0);}
    else{p0=__builtin_amdgcn_mfma_f32_32x32x16_bf16(b0,qr[d0],p0,0,0,0);p1=__builtin_amdgcn_mfma_f32_32x32x16_bf16(b1,qr[d0],p1,0,0,0);}}
}
typedef __attribute__((address_space(3))) const char* lds_cptr;
typedef short v4i16_t __attribute__((ext_vector_type(4)));
__device__ __forceinline__ void kload8(bf16x8*kf,lds_cptr kp){
  kf[0]=*(const __attribute__((address_space(3))) bf16x8*)(kp);      kf[1]=*(const __attribute__((address_space(3))) bf16x8*)(kp+512);
  kf[2]=*(const __attribute__((address_space(3))) bf16x8*)(kp+2048); kf[3]=*(const __attribute__((address_space(3))) bf16x8*)(kp+2560);
  kf[4]=*(const __attribute__((address_space(3))) bf16x8*)(kp+4096); kf[5]=*(const __attribute__((address_space(3))) bf16x8*)(kp+4608);
  kf[6]=*(const __attribute__((address_space(3))) bf16x8*)(kp+6144); kf[7]=*(const __attribute__((address_space(3))) bf16x8*)(kp+6656);
}
__device__ __forceinline__ void kload2(bf16x8*kf,lds_cptr kp,int j){ kf[2*j]=*(const __attribute__((address_space(3))) bf16x8*)(kp+j*2048); kf[2*j+1]=*(const __attribute__((address_space(3))) bf16x8*)(kp+j*2048+512); }
__device__ __forceinline__ s16x4 vtr(lds_cptr p){ return __builtin_bit_cast(s16x4,__builtin_amdgcn_ds_read_tr16_b64_v4i16((__attribute__((address_space(3))) v4i16_t*)p)); }
__device__ __forceinline__ float rowmax(const f32x16&p0,const f32x16&p1){
  float a=max3f(p0[0],p0[1],p1[0]),b=max3f(p0[2],p0[3],p1[1]);a=max3f(a,p1[2],p1[3]);
  #pragma unroll
  for(int r=4;r<16;r+=4){a=max3f(a,p0[r],p0[r+1]);b=max3f(b,p0[r+2],p0[r+3]);a=max3f(a,p1[r],p1[r+1]);b=max3f(b,p1[r+2],p1[r+3]);}
  const float m=max2f(a,b);
  auto rr=__builtin_amdgcn_permlane32_swap(__float_as_uint(m),__float_as_uint(m),false,false);
  return max2f(__uint_as_float(rr[0]),__uint_as_float(rr[1]));
}
__device__ __forceinline__ void pv(f32x16*o,int vb,bf16x8 pa0,bf16x8 pa1,bf16x8 pa2,bf16x8 pa3){
  #pragma unroll
  for(int d0=0;d0<2;++d0){s16x4 lo[4],hi[4];
    #pragma unroll
    for(int ks=0;ks<4;++ks){
      asm volatile("ds_read_b64_tr_b16 %0,%1 offset:%c2":"=&v"(lo[ks]):"v"(vb),"i"(d0*4096+ks*1024):"memory");
      asm volatile("ds_read_b64_tr_b16 %0,%1 offset:%c2":"=&v"(hi[ks]):"v"(vb),"i"(d0*4096+ks*1024+512):"memory");}
    asm volatile("s_waitcnt lgkmcnt(0)":::"memory");SBAR();
    #define PK(k) (bf16x8){lo[k][0],lo[k][1],lo[k][2],lo[k][3],hi[k][0],hi[k][1],hi[k][2],hi[k][3]}
    o[d0]=__builtin_amdgcn_mfma_f32_32x32x16_bf16(pa0,PK(0),o[d0],0,0,0);
    o[d0]=__builtin_amdgcn_mfma_f32_32x32x16_bf16(pa1,PK(1),o[d0],0,0,0);
    o[d0]=__builtin_amdgcn_mfma_f32_32x32x16_bf16(pa2,PK(2),o[d0],0,0,0);
    o[d0]=__builtin_amdgcn_mfma_f32_32x32x16_bf16(pa3,PK(3),o[d0],0,0,0);
    #undef PK
  }
}

#ifndef ATTN_STORE16
#define ATTN_STORE16(p,v) (*(u32x4*)(p)=(v))
#endif
template<int THRL> __device__ __forceinline__ void attn_unit(int b,int h,int q0,int NT,const bf16*P,const bf16*KC,const bf16*VC,bf16*OB,const float*qnw,const float*rope,char*shm){
  int tid_=threadIdx.x; asm volatile("":"+v"(tid_)); const int tid=tid_,lane=tid&63,r32=lane&31,hi=lane>>5; const int wid=__builtin_amdgcn_readfirstlane(tid>>6);
  const long rowbase=(long)b*LBROWS;
  const bf16*Qw=P+(rowbase+q0+wid*QBLK)*DM+h*D;
  const bf16*Kh=KC+((long)b*(LBROWS/64)*2+(h>>2))*4096,*Vh=VC+((long)b*(LBROWS/64)*2+(h>>2))*4096;
  const unsigned lds0=(unsigned)(uintptr_t)shm;
  float*wsf=(float*)(shm+LDS_WS)+wid*64;
  const bf16*ksrc=Kh+(wid*64+lane)*8;
  const bf16*vsrc=Vh+(wid*64+lane)*8;
  const unsigned kdst=lds0+LDS_K+wid*1024, vdst=lds0+LDS_V+wid*1024;
  #define DMA_K(t,slot) glds16(ksrc+(long)(t)*8192,(unsigned)__builtin_amdgcn_readfirstlane(kdst+(slot)))
  #define DMA_V(t,slot) glds16(vsrc+(long)(t)*8192,(unsigned)__builtin_amdgcn_readfirstlane(vdst+(slot)))
  const int vb0=(int)(lds0+LDS_V)+((lane>>4)&1)*32+(lane&3)*8+(4*hi+((lane&15)>>2))*64;
  const char*Kbase=shm+LDS_K; bf16x8 kf[8];
  const lds_cptr shm3=(lds_cptr)shm; const lds_cptr kp0=shm3+LDS_K+hi*1024+r32*16; const lds_cptr vp0=shm3+LDS_V+((lane>>4)&1)*32+(lane&3)*8+(4*hi+((lane&15)>>2))*64;
  DMA_K(0,0);DMA_V(0,0);DMA_K(1,SLOTB);
  bf16x8 qr[4];
  #pragma unroll
  for(int d0=0;d0<4;++d0)qr[d0]=*reinterpret_cast<const bf16x8*>(&Qw[(long)r32*DM+d0*16+hi*8]);
  {
    float e[4][8]; float ss=0.f;
    #pragma unroll
    for(int d0=0;d0<4;++d0){
      #pragma unroll
      for(int j=0;j<8;++j){ e[d0][j]=__uint_as_float((unsigned)(unsigned short)qr[d0][j]<<16); ss+=e[d0][j]*e[d0][j]; } }
    ss+=__shfl_xor(ss,32);
    const float rs=1.f/sqrtf(ss*(1.f/64.f)+1e-6f);
    #pragma unroll
    for(int d0=0;d0<4;++d0){ const float*wp=qnw+16*d0+8*hi;
      #pragma unroll
      for(int j=0;j<8;++j) e[d0][j]*=rs*wp[j]; }
    if(q0>=256){ const int t=q0-256+wid*QBLK+r32; const float*rr=rope+((t>>6)*16+8*hi)*2,*rc=rope+((t&63)*16+8*hi)*2;
      #pragma unroll
      for(int j=0;j<8;++j){ const float cr=rr[2*j],sr=rr[2*j+1],cc=rc[2*j],sc=rc[2*j+1];
        const float a0=e[0][j],a1=e[1][j],a2=e[2][j],a3=e[3][j];
        e[0][j]=a0*cr-a1*sr; e[1][j]=a1*cr+a0*sr; e[2][j]=a2*cc-a3*sc; e[3][j]=a3*cc+a2*sc; } }
    #pragma unroll
    for(int d0=0;d0<4;++d0){ u32x4 w; w[0]=cvtpk_s(e[d0][0]*C2,e[d0][1]*C2); w[1]=cvtpk_s(e[d0][2]*C2,e[d0][3]*C2); w[2]=cvtpk_s(e[d0][4]*C2,e[d0][5]*C2); w[3]=cvtpk_s(e[d0][6]*C2,e[d0][7]*C2); qr[d0]=__builtin_bit_cast(bf16x8,w); }
  }
  float mhat=0.f,l_reg=0.f;f32x16 o[2];o[0]=f32x16{};o[1]=f32x16{};f32x16 negm=f32x16{};asm volatile("":"+v"(negm));
  const int qrel=wid*QBLK+r32;
  #define CMASK(P0,P1,t) do{}while(0)
  bool resc=false;
  #define START(P0,P1) do{ const float rm=rowmax(P0,P1); resc=false; \
    { const float dl=rm; mhat=fadd_s(mhat,dl); \
      _Pragma("unroll") for(int r=0;r<16;++r){P0[r]=fsub_s(P0[r],dl);P1[r]=fsub_s(P1[r],dl);} \
      _Pragma("unroll") for(int r=0;r<16;++r)negm[r]=-mhat; asm volatile("":"+v"(negm)); } \
    _Pragma("unroll") for(int r=0;r<16;++r)P0[r]=__builtin_amdgcn_exp2f(P0[r]); }while(0)
  #define RESC() do{ if(resc){ asm volatile("s_waitcnt lgkmcnt(0)":::"memory"); \
      _Pragma("unroll") for(int d_=0;d_<2;++d_) _Pragma("unroll") for(int r=0;r<16;++r)o[d_][r]*=wsf[crow(r,hi)]; } }while(0)
  f32x16 pA0,pA1,pB0,pB1;
  int sl_prev=0,sl_cur=0,sl_next=SLOTB;
  #define ROT() do{sl_prev=sl_cur;sl_cur=sl_next;sl_next=(sl_next==(NSLOT-1)*SLOTB)?0:sl_next+SLOTB;}while(0)
  DMA_K(2,2*SLOTB);
  WAIT_BAR(3);
  qkt(pA0,pA1,Kbase,qr,negm,r32,hi);asm volatile("s_nop 15\n\ts_nop 7":"+v"(pA0),"+v"(pA1));CMASK(pA0,pA1,0);
  START(pA0,pA1);
  _Pragma("unroll") for(int r=0;r<16;++r)pA1[r]=__builtin_amdgcn_exp2f(pA1[r]);
  WAIT_BAR(0);
  DMA_K(3,0);DMA_V(1,SLOTB);
  ROT();
  kload8(kf,kp0+sl_cur);
  WAIT_BAR(2);
  s16x4 vlo[8],vhi[8]; u32x4 pw0,pw1,pw2,pw3;
  #define PKW(P,B) cvtpk_s(P[B],P[B+1])
  #define PAF(k) __builtin_bit_cast(bf16x8,pw##k)
  #define VFR(i) (bf16x8){vlo[i][0],vlo[i][1],vlo[i][2],vlo[i][3],vhi[i][0],vhi[i][1],vhi[i][2],vhi[i][3]}
  #define PIN(x) asm volatile("":"+v"(x))
  #define MX3(a,b,c) __builtin_fmaxf(__builtin_fmaxf((a),(b)),(c))
  #define GAPA(MF,A0,A1,A2,A3,W0,W1,PW) do{ MF; sacc+=A0; sacc+=A1; sacc+=A2; sacc+=A3; PIN(sacc); W0; W1; PIN(PW); SBAR(); }while(0)
  #define EX(v) __builtin_amdgcn_exp2f(v)
  #define GAPB(MF,X,B) do{ MF; X[B]=EX(X[B]); X[B+1]=EX(X[B+1]); X[B+2]=EX(X[B+2]); X[B+3]=EX(X[B+3]); PIN(X); SBAR(); }while(0)
  #define VRD(i) do{ vlo[i]=vtr(vp_+(((i)>>2)*4096+((i)&3)*1024)); vhi[i]=vtr(vp_+(((i)>>2)*4096+((i)&3)*1024+512)); }while(0)
  #define KRD(G,j) do{ if(G){ kload2(kf,kp0+sl_next,j); SBAR(); } }while(0)
  #define STEP(C0,C1,P0,P1,t,GK,GV,GL) do{ SBAR(); \
    const lds_cptr vp_=vp0+sl_prev; \
    VRD(0); SBAR(); float sacc=(P0[0]+P0[1]); \
    GAPA(C0=__builtin_amdgcn_mfma_f32_32x32x16_bf16(kf[0],qr[0],negm,0,0,0), P0[2],P0[3],P0[4],P0[5],     pw0[0]=PKW(P0,0), pw0[1]=PKW(P0,2), pw0); \
    VRD(4); SBAR(); GAPA(C1=__builtin_amdgcn_mfma_f32_32x32x16_bf16(kf[1],qr[0],negm,0,0,0), P0[6],P0[7],P0[8],P0[9],     pw0[2]=PKW(P0,4), pw0[3]=PKW(P0,6), pw0); \
    VRD(1); SBAR(); GAPA(C0=__builtin_amdgcn_mfma_f32_32x32x16_bf16(kf[2],qr[1],C0,0,0,0),   P0[10],P0[11],P0[12],P0[13], pw1[0]=PKW(P0,8), pw1[1]=PKW(P0,10), pw1); \
    VRD(5); SBAR(); GAPA(C1=__builtin_amdgcn_mfma_f32_32x32x16_bf16(kf[3],qr[1],C1,0,0,0),   P0[14],P0[15],P1[0],P1[1],   pw1[2]=PKW(P0,12),pw1[3]=PKW(P0,14), pw1); \
    VRD(2); SBAR(); GAPA(C0=__builtin_amdgcn_mfma_f32_32x32x16_bf16(kf[4],qr[2],C0,0,0,0),   P1[2],P1[3],P1[4],P1[5],     pw2[0]=PKW(P1,0), pw2[1]=PKW(P1,2), pw2); \
    VRD(6); SBAR(); GAPA(C1=__builtin_amdgcn_mfma_f32_32x32x16_bf16(kf[5],qr[2],C1,0,0,0),   P1[6],P1[7],P1[8],P1[9],     pw2[2]=PKW(P1,4), pw2[3]=PKW(P1,6), pw2); \
    VRD(3); SBAR(); GAPA(C0=__builtin_amdgcn_mfma_f32_32x32x16_bf16(kf[6],qr[3],C0,0,0,0),   P1[10],P1[11],P1[12],P1[13], pw3[0]=PKW(P1,8), pw3[1]=PKW(P1,10), pw3); \
    VRD(7); SBAR(); GAPA(C1=__builtin_amdgcn_mfma_f32_32x32x16_bf16(kf[7],qr[3],C1,0,0,0),   P1[14],P1[15],0.f,0.f,       pw3[2]=PKW(P1,12),pw3[3]=PKW(P1,14), pw3); \
    l_reg+=sacc; \
    if(GK){DMA_K((t)+3,sl_cur);} if(GV){DMA_V((t)+1,sl_next);} \
    CMASK(C0,C1,t); \
    { float a=MX3(C0[0],C0[1],C1[0]),b=MX3(C0[2],C0[3],C1[1]); a=MX3(a,C1[2],C1[3]); \
      _Pragma("unroll") for(int r=4;r<16;r+=4){a=MX3(a,C0[r],C0[r+1]);b=MX3(b,C0[r+2],C0[r+3]);a=MX3(a,C1[r],C1[r+1]);b=MX3(b,C1[r+2],C1[r+3]);} \
      float rm=__builtin_fmaxf(a,b); { auto rr=__builtin_amdgcn_permlane32_swap(__float_as_uint(rm),__float_as_uint(rm),false,false); rm=__builtin_fmaxf(__uint_as_float(rr[0]),__uint_as_float(rr[1])); } \
      resc=false; \
      if(__builtin_expect(__any(rm>(float)THRL),0)){ const float dl=__builtin_fmaxf(rm,0.f); mhat+=dl; \
        _Pragma("unroll") for(int r=0;r<16;++r){C0[r]-=dl;C1[r]-=dl;} \
        _Pragma("unroll") for(int r=0;r<16;++r)negm[r]=-mhat; asm volatile("":"+v"(negm)); \
        const float f=__builtin_amdgcn_exp2f(-dl); l_reg*=f; if(hi==0)wsf[r32]=f; resc=true; } } \
    SBAR(); \
    GAPB(o[0]=__builtin_amdgcn_mfma_f32_32x32x16_bf16(PAF(0),VFR(0),o[0],0,0,0), C0,0); \
    GAPB(o[1]=__builtin_amdgcn_mfma_f32_32x32x16_bf16(PAF(0),VFR(4),o[1],0,0,0), C0,4); \
    KRD(GL,0); GAPB(o[0]=__builtin_amdgcn_mfma_f32_32x32x16_bf16(PAF(1),VFR(1),o[0],0,0,0), C0,8); \
    KRD(GL,1); GAPB(o[1]=__builtin_amdgcn_mfma_f32_32x32x16_bf16(PAF(1),VFR(5),o[1],0,0,0), C0,12); \
    KRD(GL,2); GAPB(o[0]=__builtin_amdgcn_mfma_f32_32x32x16_bf16(PAF(2),VFR(2),o[0],0,0,0), C1,0); \
    KRD(GL,3); GAPB(o[1]=__builtin_amdgcn_mfma_f32_32x32x16_bf16(PAF(2),VFR(6),o[1],0,0,0), C1,4); \
    GAPB(o[0]=__builtin_amdgcn_mfma_f32_32x32x16_bf16(PAF(3),VFR(3),o[0],0,0,0), C1,8); \
    GAPB(o[1]=__builtin_amdgcn_mfma_f32_32x32x16_bf16(PAF(3),VFR(7),o[1],0,0,0), C1,12); \
    }while(0)
  int t=1;
  #undef CMASK
  #define CMASK(P0,P1,t) do{}while(0)
  for(;t+5<NT;t+=2){
    STEP(pB0,pB1,pA0,pA1,t,true,true,true);     WAIT_BAR(2); RESC(); ROT();
    STEP(pA0,pA1,pB0,pB1,t+1,true,true,true);   WAIT_BAR(2); RESC(); ROT();
  }
  #undef CMASK
  #define CMASK(P0,P1,t) do{}while(0)
  #define ENDW(tt) do{ if((tt)+3<NT){WAIT_BAR(2);} else if((tt)+2<NT){WAIT_BAR(1);} else {WAIT_BAR(0);} }while(0)
  for(;t+1<NT;t+=2){
    STEP(pB0,pB1,pA0,pA1,t,(t+3<NT),(t+1<NT),(t+1<NT));       ENDW(t);   RESC(); ROT();
    STEP(pA0,pA1,pB0,pB1,t+1,(t+4<NT),(t+2<NT),(t+2<NT));     ENDW(t+1); RESC(); ROT();
  }
  STEP(pB0,pB1,pA0,pA1,NT-1,false,false,false); RESC();
  { float sacc=pB0[0]+pB0[1]; _Pragma("unroll") for(int r=2;r<16;++r)sacc+=pB0[r]; _Pragma("unroll") for(int r=0;r<16;++r)sacc+=pB1[r]; l_reg+=sacc;
    pw0=(u32x4){PKW(pB0,0),PKW(pB0,2),PKW(pB0,4),PKW(pB0,6)};pw1=(u32x4){PKW(pB0,8),PKW(pB0,10),PKW(pB0,12),PKW(pB0,14)};pw2=(u32x4){PKW(pB1,0),PKW(pB1,2),PKW(pB1,4),PKW(pB1,6)};pw3=(u32x4){PKW(pB1,8),PKW(pB1,10),PKW(pB1,12),PKW(pB1,14)};
    SBAR(); pv(o,vb0+sl_cur,PAF(0),PAF(1),PAF(2),PAF(3)); }
  #undef PKW
  #undef PAF
  #undef VFR
  #undef PIN
  #undef MX3
  #undef GAPA
  #undef GAPB
  #undef EX
  #undef VRD
  #undef KRD
  #undef STEP
  #undef ENDW
  {auto rr=__builtin_amdgcn_permlane32_swap(__float_as_uint(l_reg),__float_as_uint(l_reg),false,false);l_reg=__uint_as_float(rr[0])+__uint_as_float(rr[1]);}
  if(hi==0)wsf[32+r32]=l_reg;asm volatile("s_waitcnt lgkmcnt(0)":::"memory");
  float rli[16];
  #pragma unroll
  for(int r=0;r<16;++r)rli[r]=__builtin_amdgcn_rcpf(wsf[32+crow(r,hi)]);
  bf16*Ow=OB+(rowbase+q0+wid*QBLK)*512+h*D;
  { bf16*stg=(bf16*)(shm+LDS_OST)+wid*2048;
    #pragma unroll
    for(int r=0;r<16;++r){const int orow=crow(r,hi);
      #pragma unroll
      for(int d0=0;d0<2;++d0)stg[orow*64+d0*32+r32]=__float2bfloat16(o[d0][r]*rli[r]);}
    asm volatile("s_waitcnt lgkmcnt(0)":::"memory");
    #pragma unroll
    for(int i=0;i<4;++i){const int row=i*8+(lane>>3),ch=lane&7; const u32x4 v=*(const u32x4*)(stg+row*64+ch*8); ATTN_STORE16(Ow+(long)row*512+ch*8,v);} }
  asm volatile("s_waitcnt lgkmcnt(0)\n\ts_barrier":::"memory");
  #undef DMA_K
  #undef DMA_V
  #undef CMASK
  #undef START
  #undef RESC
  #undef ROT
}
constexpr int ATTN_LDS_BYTES=LDS_BYTES;
#undef SBAR
#undef WAIT_BAR
}
constexpr int NWAVES = 8;
#ifndef MK_PER_PHASE
#define MK_PER_PHASE 0
#endif
constexpr int NB = 8, NX = 4096, NCX = 256, LB = NX + NCX, R = NB * LB, DMODEL = 1024, NPROJ = 2048, NIN = 2056;
constexpr int QCOL = 0, KCOL = 512, VCOL = 640, XBCCOL = 768, ZCOL = 1280, UCOL = 1536, GCOL = 1792;
constexpr int NE = 16, FF = 2048, EROWS = 4352, RGROWS = NE * EROWS;
constexpr int NCH = 68;
constexpr float LN_EPS = 1e-6f, ALPHA = 1.41421356237309515f;
constexpr size_t MiB = 1u << 20;
constexpr size_t WS_CTL = 0, CTL_ZERO_BYTES = 128 * 1024;
constexpr size_t WS_MODP = 1 * MiB, WS_MOD = 5 * MiB, WS_ROPE = 6 * MiB, WS_DT = 7 * MiB, WS_AFF = 9 * MiB, WS_INV = 12 * MiB, WS_SRC = 15 * MiB, WS_GATE = 16 * MiB, WS_TOT = 17 * MiB,
                 WS_RGS = 18 * MiB, WS_RGC = 21 * MiB, WS_RGW = 23 * MiB, WS_WIN = 24 * MiB, WS_WOUT = 32 * MiB, WS_WGU = 36 * MiB, WS_WD = 164 * MiB, WS_XRES = 228 * MiB, WS_XRES2 = 296 * MiB  ,
                 WS_YPRE = 364 * MiB  , WS_HA = 500 * MiB, WS_PROJ = 568 * MiB, WS_MERGED = 704 * MiB,
                 WS_S = 772 * MiB, WS_HIN = 840 * MiB  , WS_KC = 876 * MiB, WS_VC = 886 * MiB  , WS_OB = 896 * MiB  , WS_HID = 568 * MiB  , WS_RGL = 932 * MiB  , WS_END = 1000 * MiB;
constexpr int CW_TMO = 0, CW_BAR = 4096, CW_QUEUE = 8192;
constexpr int RING_OFF = 0, LDSCTL_OFF = 147456  , MISC_OFF = LDSCTL_OFF + 320, LDS_BYTES = 151552;
constexpr int PH_PRO0 = 0, PH_PRO2 = 1, PH_L0 = 2, PH_PER_LAYER = 11, N_PHASES = PH_L0 + 2 * PH_PER_LAYER;
constexpr int PL_INPROJ = 0, PL_QKPOST = 1, PL_MIX1 = 2, PL_CARRY = 3, PL_MIX3 = 4, PL_OUTPROJ = 5, PL_LN1 = 6, PL_TOPK = 7, PL_GEMM1 = 8, PL_GEMM2 = 9, PL_LN2 = 10;

#define GAS __attribute__((address_space(1)))
#define LAS __attribute__((address_space(3)))
typedef unsigned short bf16;
typedef unsigned v4u __attribute__((ext_vector_type(4)));
typedef unsigned v2u __attribute__((ext_vector_type(2)));
typedef _Float16 f16x4 __attribute__((ext_vector_type(4)));
typedef float f32x2_t __attribute__((ext_vector_type(2)));
typedef float f32x4 __attribute__((ext_vector_type(4)));
__device__ __forceinline__ f32x4 h4f(f16x4 h) { return __builtin_convertvector(h, f32x4); }
__device__ __forceinline__ f16x4 f4h(f32x4 v) { return __builtin_convertvector(v, f16x4); }
typedef short bf16x8 __attribute__((ext_vector_type(8)));
typedef GAS unsigned gu32;
#define RLX_AGENT __ATOMIC_RELAXED, __HIP_MEMORY_SCOPE_AGENT
#define LDS_WAIT() asm volatile("s_waitcnt lgkmcnt(0)" ::: "memory")
__device__ __forceinline__ float bf2f(unsigned u) { return __uint_as_float(u << 16); }
__device__ __forceinline__ unsigned pk2(float lo, float hi) { unsigned r; asm("v_cvt_pk_bf16_f32 %0, %1, %2" : "=v"(r) : "v"(lo), "v"(hi)); return r; }
__device__ __forceinline__ unsigned f2bf(float f) { return pk2(f, f) & 0xffffu; }
__device__ __forceinline__ float rcp_f(float x) { return __builtin_amdgcn_rcpf(x); }
__device__ __forceinline__ float exp_f(float x) { return __builtin_amdgcn_exp2f(x * 1.4426950408889634f); }
__device__ __forceinline__ float sigmoid_f(float x) { return rcp_f(1.f + exp_f(-x)); }
__device__ __forceinline__ float silu_ff(float x) { return x * rcp_f(1.f + exp_f(-x)); }
__device__ __forceinline__ float softplus_f(float x) { return x > 20.f ? x : log1pf(__expf(x)); }
__device__ __forceinline__ float gelu_tanh_f(float x) { const float u = 0.7978845608028654f * (x + 0.044715f * x * x * x); return x * rcp_f(1.f + exp_f(-2.f * u)); }
template <int CTRL> __device__ __forceinline__ int dpp_i(int v) { return __builtin_amdgcn_update_dpp(0, v, CTRL, 0xf, 0xf, true); }
__device__ __forceinline__ float wave_sum(float v) {
    v += __builtin_bit_cast(float, dpp_i<0xB1>(__builtin_bit_cast(int, v))); v += __builtin_bit_cast(float, dpp_i<0x4E>(__builtin_bit_cast(int, v)));
    v += __builtin_bit_cast(float, dpp_i<0x141>(__builtin_bit_cast(int, v))); v += __builtin_bit_cast(float, dpp_i<0x140>(__builtin_bit_cast(int, v)));
    v += __shfl_xor(v, 16); v += __shfl_xor(v, 32);
    return v;
}
template <int CTRL> __device__ __forceinline__ float dpp_f(float v) { return __builtin_bit_cast(float, dpp_i<CTRL>(__builtin_bit_cast(int, v))); }
__device__ __forceinline__ void unpack8(const v4u p, float (&f)[8]) { f[0] = bf2f(p.x & 0xffffu); f[1] = bf2f(p.x >> 16); f[2] = bf2f(p.y & 0xffffu); f[3] = bf2f(p.y >> 16); f[4] = bf2f(p.z & 0xffffu); f[5] = bf2f(p.z >> 16); f[6] = bf2f(p.w & 0xffffu); f[7] = bf2f(p.w >> 16); }
__device__ __forceinline__ float reduce8(const float (&v)[8], int lane) {
    float a[4], b[2], c;
    { const bool hi = lane & 32;
#pragma unroll
      for (int i = 0; i < 4; ++i) { const float send = hi ? v[i] : v[i + 4], keep = hi ? v[i + 4] : v[i]; a[i] = keep + __shfl_xor(send, 32); } }
    { const bool hi = lane & 16;
#pragma unroll
      for (int i = 0; i < 2; ++i) { const float send = hi ? a[i] : a[i + 2], keep = hi ? a[i + 2] : a[i]; b[i] = keep + __shfl_xor(send, 16); } }
    { const bool hi = lane & 8; const float send = hi ? b[0] : b[1], keep = hi ? b[1] : b[0]; c = keep + __shfl_xor(send, 8); }
    c += __shfl_xor(c, 4); c += __shfl_xor(c, 2); c += __shfl_xor(c, 1);
    return c;
}
__device__ __forceinline__ float reduce16(const float (&v)[16], int lane) {
    float a[8], b[4], c[2], d;
    { const bool hi = lane & 32;
#pragma unroll
      for (int i = 0; i < 8; ++i) { const float send = hi ? v[i] : v[i + 8], keep = hi ? v[i + 8] : v[i]; a[i] = keep + __shfl_xor(send, 32); } }
    { const bool hi = lane & 16;
#pragma unroll
      for (int i = 0; i < 4; ++i) { const float send = hi ? a[i] : a[i + 4], keep = hi ? a[i + 4] : a[i]; b[i] = keep + __shfl_xor(send, 16); } }
    { const bool hi = lane & 8;
#pragma unroll
      for (int i = 0; i < 2; ++i) { const float send = hi ? b[i] : b[i + 2], keep = hi ? b[i + 2] : b[i]; c[i] = keep + __shfl_xor(send, 8); } }
    { const bool hi = lane & 4; const float send = hi ? c[0] : c[1], keep = hi ? c[1] : c[0]; d = keep + __shfl_xor(send, 4); }
    d += __shfl_xor(d, 2); d += __shfl_xor(d, 1);
    return d;
}
__device__ __forceinline__ f32x4 mfma16(bf16x8 a, bf16x8 b, f32x4 c) { return __builtin_amdgcn_mfma_f32_16x16x32_bf16(a, b, c, 0, 0, 0); }
__device__ __forceinline__ bf16x8 lds_frag(const LAS bf16* T, int ld, int row0, int k0, int lane) { return *(const LAS bf16x8*)(T + (row0 + (lane & 15)) * ld + k0 + 8 * (lane >> 4)); }

#define XB_TMO      128
#define XB_XCNT(j)  (256  + 64 * (j))
#define XB_XSUB(j)  (1280 + 64 * (j))
#define XB_XGEN(j)  (2304 + 64 * (j))
#define XB_TOP      3328
#define XB_TOPGEN   3392
#define XCD_BAR_WORDS 3456
#define XB_SPIN_CAP (1u << 18)

__device__ __forceinline__ unsigned xb_ld(unsigned* p)              { return __hip_atomic_load(p, __ATOMIC_RELAXED, __HIP_MEMORY_SCOPE_AGENT); }
__device__ __forceinline__ unsigned xb_add(unsigned* p, unsigned v) { return __hip_atomic_fetch_add(p, v, __ATOMIC_RELAXED, __HIP_MEMORY_SCOPE_AGENT); }
__device__ __forceinline__ unsigned xb_xcc_id() { return (unsigned)__builtin_amdgcn_s_getreg((3 << 11) | 20) & 0xFu; }
#define XB_SPIN(cond, bar) do { unsigned _sp = 0; while (cond) { __builtin_amdgcn_s_sleep(1); \
    if ((++_sp & 255u) == 0u) { if (xb_ld(&(bar)[XB_TMO])) break; if (_sp > XB_SPIN_CAP) { atomicAdd(&(bar)[XB_TMO], 1u); break; } } } } while (0)

struct XcdBarrier {
    unsigned* bar; unsigned x;
    volatile LAS unsigned* st;
};

__device__ __forceinline__ XcdBarrier xcd_barrier_post(unsigned* bar, volatile LAS unsigned* st) {
    XcdBarrier b; b.bar = bar; b.x = xb_xcc_id(); b.st = st;
    if (threadIdx.x == 0) (void)xb_add(&bar[XB_XCNT(b.x)], 1u);
    return b;
}
__device__ __forceinline__ void xcd_barrier_complete(unsigned* bar, unsigned x, unsigned& nloc, unsigned& nx) {
    const unsigned G = gridDim.x * gridDim.y * gridDim.z;
    unsigned sum, cnt, mine, sp = 0u;
    for (;;) {
        sum = 0u; cnt = 0u; mine = 0u;
#pragma unroll
        for (unsigned j = 0; j < 16; ++j) { const unsigned c = xb_ld(&bar[XB_XCNT(j)]); sum += c; cnt += (c > 0u) ? 1u : 0u; mine = (j == x) ? c : mine; }
        if (sum == G) break;
        __builtin_amdgcn_s_sleep(1);
        if ((++sp & 255u) == 0u) { if (xb_ld(&bar[XB_TMO])) break; if (sp > XB_SPIN_CAP) { atomicAdd(&bar[XB_TMO], 1u); break; } }
    }
    nloc = mine > 0u ? mine : 1u; nx = cnt > 0u ? cnt : 1u;
}

__device__ __forceinline__ void xcd_barrier(const XcdBarrier& b) {
    asm volatile("s_waitcnt vmcnt(0)" ::: "memory");
    __syncthreads();
    if (threadIdx.x == 0) {
        unsigned* bar = b.bar;
        __builtin_amdgcn_s_waitcnt(0);
        unsigned nloc = b.st[0], nx = b.st[1];
        if (nloc == 0u) { xcd_barrier_complete(bar, b.x, nloc, nx); b.st[0] = nloc; b.st[1] = nx; }
        const unsigned old = xb_add(&bar[XB_XSUB(b.x)], 1u);
        const unsigned gen = old / nloc;
        if (old + 1u == (gen + 1u) * nloc) {
            __builtin_amdgcn_fence(__ATOMIC_RELEASE, "agent");
            asm volatile("s_waitcnt vmcnt(0)" ::: "memory");
            const unsigned og = xb_add(&bar[XB_TOP], 1u);
            const unsigned tg = og / nx;
            if (og + 1u == (tg + 1u) * nx) xb_add(&bar[XB_TOPGEN], 1u);
            else XB_SPIN(xb_ld(&bar[XB_TOPGEN]) == tg, bar);
            __builtin_amdgcn_fence(__ATOMIC_ACQUIRE, "agent");
            xb_add(&bar[XB_XGEN(b.x)], 1u);
            asm volatile("s_waitcnt vmcnt(0)" ::: "memory");
        } else {
            XB_SPIN(xb_ld(&bar[XB_XGEN(b.x)]) == gen, bar);
            __builtin_amdgcn_fence(__ATOMIC_ACQUIRE, "agent");
            asm volatile("s_waitcnt vmcnt(0)" ::: "memory");
        }
    }
    __syncthreads();
}

struct Frame { LAS unsigned char* lds; volatile LAS unsigned* MISC; int tid, lane, wave, vcu, G; };
struct Args { const float* in[33]; float* out; unsigned char* ws; int ph_lo, ph_hi; };
typedef const __attribute__((address_space(4))) Args& ArgsR;
#define PHASE_FN __device__ __forceinline__
__device__ __forceinline__ void make_frame(Frame& F, LAS unsigned char* lds);
enum { I_X = 0, I_C, I_CTX, I_CCTX, I_WMOD, I_BMOD, I_WIN, I_QNORM, I_KNORM, I_AONORM, I_SCONVW, I_SCONVB, I_SDTB, I_SALOG, I_SD, I_SNORM, I_RCONVW, I_RCONVB, I_RWA, I_RBA, I_RWX, I_RBX, I_RLAM, I_RONORM,
       I_WOUT, I_LN1W, I_LN1B, I_WROUTER, I_WGATE, I_WUP, I_WDOWN, I_LN2W, I_LN2B };
#define WSP(T, off) ((T*)(A.ws + (off)))

template <int MODE> __device__ __forceinline__ void transpose_item(const float* W, int K, int Nsrc, int kb, int ncol0, bf16* WT, int drow0, LAS float* scr, int lane) {
    const int k0 = 64 * kb;
    { f32x4 v[8]; const int kr = lane >> 3, nq = 4 * (lane & 7);
#pragma unroll
      for (int i = 0; i < 8; ++i) v[i] = __builtin_nontemporal_load((const f32x4*)(W + (size_t)(k0 + 8 * i + kr) * Nsrc + ncol0 + nq));
#pragma unroll
      for (int i = 0; i < 8; ++i) { LAS float* d = scr + (8 * i + kr) * 33 + nq; d[0] = v[i][0]; d[1] = v[i][1]; d[2] = v[i][2]; d[3] = v[i][3]; } }
    LDS_WAIT(); asm volatile("" ::: "memory");
    const int c = lane & 7;
#pragma unroll
    for (int j = 0; j < 4; ++j) { const int n = (lane >> 3) + 8 * j; const LAS float* s = scr + (8 * c) * 33 + n;
        const int row = MODE == 0 ? drow0 + n : drow0 + 128 * ((n >> 2) & 1) + 4 * (n >> 3) + (n & 3);
        v4u o; o.x = pk2(s[0 * 33], s[1 * 33]); o.y = pk2(s[2 * 33], s[3 * 33]); o.z = pk2(s[4 * 33], s[5 * 33]); o.w = pk2(s[6 * 33], s[7 * 33]);
        *(v4u*)(WT + (size_t)row * K + k0 + 8 * c) = o; }
    LDS_WAIT(); asm volatile("" ::: "memory");
}
__device__ __forceinline__ void convert_item(Frame& F, ArgsR A, int l, int it, LAS float* scr) {
    bf16* WGU = WSP(bf16, WS_WGU); bf16* WD = WSP(bf16, WS_WD);
    if (it < 32768) { const int up = it >> 14, id = it & 16383, e = id >> 10, rem = id & 1023, kb = rem >> 6, nb = rem & 63;
        const float* W = A.in[up ? I_WUP : I_WGATE] + (size_t)(l * 16 + e) * 1024 * 2048;
        transpose_item<1>(W, 1024, 2048, kb, 32 * nb, WGU + (size_t)e * 4096 * 1024, 256 * (nb >> 2) + 32 * (nb & 3) + 16 * up, scr, F.lane);
    } else { const int id = it - 32768, e = id >> 10, rem = id & 1023, kb = rem >> 5, nb = rem & 31;
        const float* W = A.in[I_WDOWN] + (size_t)(l * 16 + e) * 2048 * 1024;
        transpose_item<0>(W, 2048, 1024, kb, 32 * nb, WD + (size_t)e * 1024 * 2048, 32 * nb, scr, F.lane); }
}
__device__ __forceinline__ void conv_rounds(Frame& F, ArgsR A, int l, int quota, int limit) {
    gu32* cctr = (gu32*)(A.ws + WS_CTL) + 12288 + 64 * l; LAS float* scr = (LAS float*)(F.lds + RING_OFF + F.wave * 16384);
    for (int r = 0; r < quota; ++r) { __syncthreads(); if (F.tid == 0) F.MISC[1] = __hip_atomic_fetch_add(cctr, 8u, RLX_AGENT); __syncthreads();
        const int base = (int)F.MISC[1]; if (base >= limit) break; convert_item(F, A, l, base + F.wave, scr); }
}
__device__ __forceinline__ void p_pro0(Frame& F, ArgsR A) {
    LAS float* scr = (LAS float*)(F.lds + RING_OFF + F.wave * 16384);
    const int gw = F.vcu * NWAVES + F.wave, NGW = F.G * NWAVES;
    { const int gt = (gw - (NGW >= 1216 ? 1200 : 0)) * 64 + F.lane; if (gt >= 0 && gt < 1024) { const int pos = gt >> 4, i = gt & 15; const float inv = powf(10000.0f, -(float)i / 16.0f); const float ang = (float)pos * inv;
        float* T = WSP(float, WS_ROPE); T[2 * gt] = cosf(ang); T[2 * gt + 1] = sinf(ang); } }
    for (int it = NGW - 1 - gw; it < 384; it += NGW) { const int l = it / 192, rem = it % 192, cb = rem >> 3, ks = rem & 7, col = cb * 256 + 4 * F.lane;
#pragma unroll
        for (int h = 0; h < 2; ++h) { const int kk = F.lane + 64 * h, k = ks * 128 + kk;
#pragma unroll
            for (int r = 0; r < 9; ++r) scr[kk * 12 + r] = silu_ff(r < 8 ? A.in[I_C][r * 1024 + k] : A.in[I_CCTX][k]); }
        LDS_WAIT(); asm volatile("" ::: "memory");
        f32x4 acc[9];
#pragma unroll
        for (int r = 0; r < 9; ++r) acc[r] = (f32x4){0.f, 0.f, 0.f, 0.f};
        const float* Wm = A.in[I_WMOD] + (size_t)l * 1024 * 6144 + col + (size_t)(ks * 128) * 6144;
        for (int k0 = 0; k0 < 128; k0 += 8) { f32x4 w4[8];
#pragma unroll
            for (int u = 0; u < 8; ++u) w4[u] = __builtin_nontemporal_load((const f32x4*)(Wm + (size_t)(k0 + u) * 6144));
#pragma unroll
            for (int u = 0; u < 8; ++u) { const f32x4 s0 = *(const LAS f32x4*)(scr + (k0 + u) * 12), s1 = *(const LAS f32x4*)(scr + (k0 + u) * 12 + 4); const float s8 = scr[(k0 + u) * 12 + 8];
                acc[0] += w4[u] * s0[0]; acc[1] += w4[u] * s0[1]; acc[2] += w4[u] * s0[2]; acc[3] += w4[u] * s0[3]; acc[4] += w4[u] * s1[0]; acc[5] += w4[u] * s1[1]; acc[6] += w4[u] * s1[2]; acc[7] += w4[u] * s1[3]; acc[8] += w4[u] * s8; } }
        float* MP = WSP(float, WS_MODP) + (size_t)((ks * 2 + l) * 9) * 6144 + col;
#pragma unroll
        for (int r = 0; r < 9; ++r) *(f32x4*)(MP + (size_t)r * 6144) = acc[r];
        LDS_WAIT(); asm volatile("" ::: "memory"); }
    for (int it = gw; it < 2 * (1024 + 512 + 32); it += NGW) { const int l = it / 1568; int id = it % 1568;
        if (id < 1024) { const int kb = id >> 6, nb = id & 63; transpose_item<0>(A.in[I_WIN] + (size_t)l * 1024 * NIN, 1024, NIN, kb, 32 * nb + (32 * nb >= 1536 ? 8 : 0), WSP(bf16, WS_WIN) + (size_t)l * 2048 * 1024, 32 * nb, scr, F.lane); continue; }
        id -= 1024;
        if (id < 512) { const int kb = id >> 5, nb = id & 31; transpose_item<0>(A.in[I_WOUT] + (size_t)l * 1024 * 1024, 1024, 1024, kb, 32 * nb, WSP(bf16, WS_WOUT) + (size_t)l * 1024 * 1024, 32 * nb, scr, F.lane); continue; }
        id -= 512;
        { const int ty = id >> 4, d = (id >> 3) & 1, blk = (id >> 1) & 3, nb = id & 1;
          transpose_item<0>(A.in[ty ? I_RWX : I_RWA] + (size_t)((l * 2 + d) * 4 + blk) * 4096, 64, 64, 0, 32 * nb, WSP(bf16, WS_RGW) + (size_t)(((l * 2 + ty) * 2 + d) * 4 + blk) * 4096, 32 * nb, scr, F.lane); }
    }
}
__device__ __forceinline__ void stage_wdt(Frame& F, ArgsR A, int L, LAS float* wdt) {
    for (int idx = F.tid; idx < 8192; idx += NWAVES * 64) wdt[(idx & 7) * 1024 + (idx >> 3)] = A.in[I_WIN][((size_t)L * 1024 + (idx >> 3)) * NIN + 1536 + (idx & 7)];
}
template <int NV> __device__ __forceinline__ void stage_mod(Frame& F, ArgsR A, int L, int b0, int sec0, LAS float* dst) {
    const float* M = WSP(float, WS_MOD) + (size_t)L * 9 * 6144;
    for (int idx = F.tid; idx < 3 * NV * 1024; idx += NWAVES * 64) { const int slot = idx / (NV * 1024), rem = idx % (NV * 1024); const int mrow = slot == 0 ? 8 : (b0 + slot - 1 < NB ? b0 + slot - 1 : NB - 1);
        dst[idx] = M[(size_t)mrow * 6144 + sec0 * 1024 + rem]; }
}
__device__ __forceinline__ void emit_row(Frame& F, ArgsR A, int r, const f32x4 (&v)[4], const LAS float* wdt, const LAS float* msh, const LAS float* msc) {
    bf16* ha = WSP(bf16, WS_HA) + (size_t)r * 1024;
    float dd[8];
#pragma unroll
    for (int i = 0; i < 8; ++i) dd[i] = 0.f;
#pragma unroll
    for (int j = 0; j < 4; ++j) { const int k = 256 * j + 4 * F.lane;
        const f32x4 sh = *(const LAS f32x4*)(msh + k), sc = *(const LAS f32x4*)(msc + k); const f32x4 h = v[j] * (sc + 1.0f) + sh;
        v2u o; o.x = pk2(h[0], h[1]); o.y = pk2(h[2], h[3]); *(v2u*)(ha + k) = o;
#pragma unroll
        for (int i = 0; i < 8; ++i) { const f32x4 wv = *(const LAS f32x4*)(wdt + i * 1024 + k); dd[i] += (wv[0] * h[0] + wv[1] * h[1]) + (wv[2] * h[2] + wv[3] * h[3]); }
        __builtin_amdgcn_sched_barrier(0); }
    const float dsum = reduce8(dd, F.lane);
    if ((F.lane & 7) == 0) WSP(float, WS_DT)[(size_t)r * 8 + ((F.lane >> 5) & 1) * 4 + ((F.lane >> 4) & 1) * 2 + ((F.lane >> 3) & 1)] = dsum;
}
#define SRCROW(rr) (((rr) % LB) < NCX ? A.in[I_CTX] + (size_t)(((rr) / LB) * NCX + (rr) % LB) * 1024 : A.in[I_X] + (size_t)(((rr) / LB) * NX + (rr) % LB - NCX) * 1024)
__device__ __forceinline__ void p_pro2(Frame& F, ArgsR A, const XcdBarrier& bar) {
    LAS float* wdt = (LAS float*)(F.lds + RING_OFF); LAS float* mod = wdt + 8192;
    const int rpb = (R + F.G - 1) / F.G, rbeg = blockIdx.x * rpb, rend = rbeg + rpb < R ? rbeg + rpb : R, b0 = rbeg / LB;
    __syncthreads(); stage_wdt(F, A, 0, wdt);
    xcd_barrier(bar);
    {
      const float* MP = WSP(float, WS_MODP); float* MOD = WSP(float, WS_MOD);
      for (int idx = blockIdx.x * (NWAVES * 64) + F.tid; idx < 2 * 9 * 6144; idx += F.G * NWAVES * 64) { const int l = idx / (9 * 6144), col = idx % 6144; float s = A.in[I_BMOD][l * 6144 + col];
#pragma unroll
          for (int ks = 0; ks < 8; ++ks) s += MP[(size_t)ks * (2 * 9 * 6144) + idx];
          MOD[idx] = s; }
      for (int idx = F.tid; idx < 3 * 2048; idx += NWAVES * 64) { const int slot = idx / 2048, rem = idx % 2048; const int mrow = slot == 0 ? 8 : (b0 + slot - 1 < NB ? b0 + slot - 1 : NB - 1); const int src = mrow * 6144 + rem;
          float s = A.in[I_BMOD][rem];
#pragma unroll
          for (int ks = 0; ks < 8; ++ks) s += MP[(size_t)ks * (2 * 9 * 6144) + src];
          mod[idx] = s; } }
    __syncthreads();
    const int rfirst = rbeg + F.wave;
    f32x4 vn[3][4];
#pragma unroll
    for (int p = 0; p < 3; ++p) { const int rp = rfirst + 8 * p < rend ? rfirst + 8 * p : rbeg; const float* src = SRCROW(rp);
#pragma unroll
        for (int j = 0; j < 4; ++j) vn[p][j] = __builtin_nontemporal_load((const f32x4*)(src + 256 * j + 4 * F.lane)); }
    for (int r = rfirst; r < rend; r += 8) {
        f32x4 v[4];
        { const int rp = r + 24 < rend ? r + 24 : rbeg; const float* src = SRCROW(rp);
#pragma unroll
          for (int j = 0; j < 4; ++j) { v[j] = vn[0][j]; vn[0][j] = vn[1][j]; vn[1][j] = vn[2][j]; vn[2][j] = __builtin_nontemporal_load((const f32x4*)(src + 256 * j + 4 * F.lane)); } }
        _Float16* xr = WSP(_Float16, WS_XRES) + (size_t)r * 1024;
#pragma unroll
        for (int j = 0; j < 4; ++j) *(f16x4*)(xr + 256 * j + 4 * F.lane) = f4h(v[j]);
        const int slot = (r % LB) < NCX ? 0 : 1 + r / LB - b0;
        emit_row(F, A, r, v, wdt, mod + slot * 2048, mod + slot * 2048 + 1024); }
}
__device__ __forceinline__ void ln_row(f32x4 (&v)[4], const LAS float* lnw, int lane) {
    float s = 0.f;
#pragma unroll
    for (int j = 0; j < 4; ++j) s += (v[j][0] + v[j][1]) + (v[j][2] + v[j][3]);
    const float mean = wave_sum(s) * (1.f / 1024.f); float s2 = 0.f;
#pragma unroll
    for (int j = 0; j < 4; ++j) { v[j] = v[j] - mean; s2 += (v[j][0] * v[j][0] + v[j][1] * v[j][1]) + (v[j][2] * v[j][2] + v[j][3] * v[j][3]); }
    const float rstd = __builtin_amdgcn_rsqf(wave_sum(s2) * (1.f / 1024.f) + LN_EPS);
#pragma unroll
    for (int j = 0; j < 4; ++j) v[j] = v[j] * rstd * *(const LAS f32x4*)(lnw + 256 * j + 4 * lane) + *(const LAS f32x4*)(lnw + 1024 + 256 * j + 4 * lane);
}
__device__ __forceinline__ void p_ln1(Frame& F, ArgsR A, int L, const XcdBarrier& bar) {
    constexpr int LDA = 1032;
    LAS bf16* Ahi = (LAS bf16*)(F.lds + RING_OFF);
    LAS bf16* Alo = Ahi + 16 * LDA;
    LAS float* red = (LAS float*)(Alo + 16 * LDA);
    LAS float* lnw = red + 2048;
    LAS float* mod = lnw + 2048;
    const bool xonly = (L == 1); const int nrows = xonly ? NB * NX : R;
#define ROWOF1(qq) (xonly ? ((qq) / NX) * LB + NCX + (qq) % NX : (qq))
    const int rpb = (nrows + F.G - 1) / F.G, rbeg = blockIdx.x * rpb, rend = rbeg + rpb < nrows ? rbeg + rpb : nrows, b0 = ROWOF1(rbeg < nrows ? rbeg : 0) / LB;
    const int lane = F.lane, w = F.wave, q = lane >> 4, c16 = lane & 15;
    __syncthreads();
    for (int idx = F.tid; idx < 2048; idx += NWAVES * 64) lnw[idx] = idx < 1024 ? A.in[I_LN1W][L * 1024 + idx] : A.in[I_LN1B][L * 1024 + idx - 1024];
    stage_mod<3>(F, A, L, b0, 2, mod);
    bf16x8 bh[4], bl[4];
#pragma unroll
    for (int ks = 0; ks < 4; ++ks)
#pragma unroll
        for (int i = 0; i < 8; ++i) { const float wv = A.in[I_WROUTER][(size_t)L * 16384 + (size_t)(128 * w + 32 * ks + 8 * q + i) * 16 + c16]; const unsigned hi = f2bf(wv); bh[ks][i] = (short)hi; bl[ks][i] = (short)f2bf(wv - bf2f(hi)); }
    __syncthreads();
    xcd_barrier(bar);
    const bf16* YP = WSP(bf16, WS_YPRE); const _Float16* XR = WSP(_Float16, WS_XRES);
    f16x4 vn[2][4]; v2u yn[2][4];
#pragma unroll
    for (int p = 0; p < 2; ++p) { const int rp = rbeg + 2 * w + p < rend ? rbeg + 2 * w + p : rbeg;
#pragma unroll
        for (int j = 0; j < 4; ++j) { vn[p][j] = __builtin_nontemporal_load((const f16x4*)(XR + (size_t)ROWOF1(rp) * 1024 + 256 * j + 4 * lane)); yn[p][j] = __builtin_nontemporal_load((const v2u*)(YP + (size_t)ROWOF1(rp) * 1024 + 256 * j + 4 * lane)); } }
    for (int g0 = rbeg; g0 < rend; g0 += 16) {
#pragma unroll
        for (int p = 0; p < 2; ++p) { const int rq = g0 + 2 * w + p, r = ROWOF1(rq < nrows ? rq : 0);
            f32x4 v[4]; v2u yb[4];
            { const int rp = rq + 16 < rend ? rq + 16 : rbeg;
#pragma unroll
              for (int j = 0; j < 4; ++j) { v[j] = h4f(vn[p][j]); yb[j] = yn[p][j]; vn[p][j] = __builtin_nontemporal_load((const f16x4*)(XR + (size_t)ROWOF1(rp) * 1024 + 256 * j + 4 * lane)); yn[p][j] = __builtin_nontemporal_load((const v2u*)(YP + (size_t)ROWOF1(rp) * 1024 + 256 * j + 4 * lane)); } }
            if (rq < rend) {
                const int slot = (r % LB) < NCX ? 0 : 1 + r / LB - b0; const LAS float* mg1 = mod + slot * 3072; const LAS float* msh = mg1 + 1024; const LAS float* msc = mg1 + 2048;
#pragma unroll
                for (int j = 0; j < 4; ++j) { const f32x4 g1 = *(const LAS f32x4*)(mg1 + 256 * j + 4 * lane);
                    v[j] = v[j] * ALPHA + g1 * (f32x4){bf2f(yb[j].x & 0xffffu), bf2f(yb[j].x >> 16), bf2f(yb[j].y & 0xffffu), bf2f(yb[j].y >> 16)}; }
                ln_row(v, lnw, lane);
                _Float16* xr = WSP(_Float16, WS_XRES2) + (size_t)r * 1024; bf16* ha = WSP(bf16, WS_HA) + (size_t)r * 1024;
#pragma unroll
                for (int j = 0; j < 4; ++j) { const int k = 256 * j + 4 * lane; *(f16x4*)(xr + k) = f4h(v[j]);
                    const f32x4 sh = *(const LAS f32x4*)(msh + k), sc = *(const LAS f32x4*)(msc + k); const f32x4 h = v[j] * (sc + 1.0f) + sh;
                    v2u o; o.x = pk2(h[0], h[1]); o.y = pk2(h[2], h[3]); *(v2u*)(ha + k) = o;
                    v2u lo; lo.x = pk2(h[0] - bf2f(o.x & 0xffffu), h[1] - bf2f(o.x >> 16)); lo.y = pk2(h[2] - bf2f(o.y & 0xffffu), h[3] - bf2f(o.y >> 16));
                    *(LAS v2u*)(Ahi + (2 * w + p) * LDA + k) = o; *(LAS v2u*)(Alo + (2 * w + p) * LDA + k) = lo; } } }
        __syncthreads();
        { f32x4 acc = {0.f, 0.f, 0.f, 0.f};
#pragma unroll
          for (int ks = 0; ks < 4; ++ks) { const bf16x8 ah = lds_frag(Ahi, LDA, 0, 128 * w + 32 * ks, lane), al = lds_frag(Alo, LDA, 0, 128 * w + 32 * ks, lane);
              acc = mfma16(ah, bh[ks], acc); acc = mfma16(ah, bl[ks], acc); acc = mfma16(al, bh[ks], acc); }
#pragma unroll
          for (int j = 0; j < 4; ++j) red[(w * 16 + 4 * q + j) * 16 + c16] = acc[j]; }
        __syncthreads();
        if (F.tid < 256) { const int i = F.tid >> 4, e = F.tid & 15, rq = g0 + i, r = ROWOF1(rq < nrows ? rq : 0); float lg = 0.f;
#pragma unroll
            for (int ww = 0; ww < 8; ++ww) lg += red[(ww * 16 + i) * 16 + e];
            float mx = lg; mx = fmaxf(mx, dpp_f<0xB1>(mx)); mx = fmaxf(mx, dpp_f<0x4E>(mx)); mx = fmaxf(mx, dpp_f<0x141>(mx)); mx = fmaxf(mx, dpp_f<0x140>(mx));
            const float ex = __expf(lg - mx); float sum = ex; sum += dpp_f<0xB1>(sum); sum += dpp_f<0x4E>(sum); sum += dpp_f<0x141>(sum); sum += dpp_f<0x140>(sum);
            if (rq < rend) WSP(float, WS_AFF)[(size_t)r * 16 + e] = ex / sum; }
    }
#undef ROWOF1
}
__device__ __forceinline__ void p_ln2(Frame& F, ArgsR A, int L, const XcdBarrier& bar) {
    const bool last = (L == 1);
    LAS float* wdt = (LAS float*)(F.lds + RING_OFF); LAS float* lnw = wdt + 8192; LAS float* modg = lnw + 2048; LAS float* modn = modg + 3 * 1024;
    const int nrows = last ? NB * NX : R;
#define ROWOF(qq) (last ? ((qq) / NX) * LB + NCX + (qq) % NX : (qq))
    const int rpb = (nrows + F.G - 1) / F.G, qbeg = blockIdx.x * rpb, qend = qbeg + rpb < nrows ? qbeg + rpb : nrows, b0 = ROWOF(qbeg < nrows ? qbeg : 0) / LB;
    __syncthreads();
    if (!last) { stage_wdt(F, A, L + 1, wdt); stage_mod<2>(F, A, L + 1, b0, 0, modn); }
    stage_mod<1>(F, A, L, b0, 5, modg);
    for (int idx = F.tid; idx < 2048; idx += NWAVES * 64) lnw[idx] = idx < 1024 ? A.in[I_LN2W][L * 1024 + idx] : A.in[I_LN2B][L * 1024 + idx - 1024];
    __syncthreads();
    xcd_barrier(bar);
    const bf16* YS = WSP(bf16, WS_YPRE); const _Float16* XR = WSP(_Float16, WS_XRES2); const int* INV = WSP(int, WS_INV);
    const int qfirst = qbeg + F.wave;
    f16x4 vn[3][4]; int invn[3];
#pragma unroll
    for (int p = 0; p < 3; ++p) { const int qp = qfirst + 8 * p < qend ? qfirst + 8 * p : qbeg; const int rp = ROWOF(qp); invn[p] = INV[(size_t)rp * 16 + (F.lane & 15)];
#pragma unroll
        for (int j = 0; j < 4; ++j) vn[p][j] = __builtin_nontemporal_load((const f16x4*)(XR + (size_t)rp * 1024 + 256 * j + 4 * F.lane)); }
    for (int qq = qfirst; qq < qend; qq += 8) { const int r = ROWOF(qq), b = r / LB, s = r % LB;
        f32x4 moe[4];
#pragma unroll
        for (int j = 0; j < 4; ++j) moe[j] = (f32x4){0.f, 0.f, 0.f, 0.f};
        const int myinv = invn[0];
        unsigned long long msk = __ballot(myinv >= 0 && F.lane < 16);
        while (msk) { int e0 = __builtin_ctzll(msk); msk &= msk - 1; int e1 = -1; if (msk) { e1 = __builtin_ctzll(msk); msk &= msk - 1; }
            const int i0 = __builtin_amdgcn_readlane(myinv, e0); const int i1 = e1 >= 0 ? __builtin_amdgcn_readlane(myinv, e1) : i0;
            v2u p0[4], p1[4];
#pragma unroll
            for (int j = 0; j < 4; ++j) { p0[j] = __builtin_nontemporal_load((const v2u*)(YS + (size_t)i0 * 1024 + 256 * j + 4 * F.lane)); p1[j] = __builtin_nontemporal_load((const v2u*)(YS + (size_t)i1 * 1024 + 256 * j + 4 * F.lane)); }
            const float w1 = e1 >= 0 ? 1.f : 0.f;
#pragma unroll
            for (int j = 0; j < 4; ++j) { moe[j][0] += bf2f(p0[j].x & 0xffffu) + w1 * bf2f(p1[j].x & 0xffffu); moe[j][1] += bf2f(p0[j].x >> 16) + w1 * bf2f(p1[j].x >> 16);
                moe[j][2] += bf2f(p0[j].y & 0xffffu) + w1 * bf2f(p1[j].y & 0xffffu); moe[j][3] += bf2f(p0[j].y >> 16) + w1 * bf2f(p1[j].y >> 16); } }
        __builtin_amdgcn_sched_barrier(0);
        f32x4 v[4];
        { const int qp = qq + 24 < qend ? qq + 24 : qbeg; const int rn = ROWOF(qp); invn[0] = invn[1]; invn[1] = invn[2]; invn[2] = INV[(size_t)rn * 16 + (F.lane & 15)];
#pragma unroll
          for (int j = 0; j < 4; ++j) { v[j] = h4f(vn[0][j]); vn[0][j] = vn[1][j]; vn[1][j] = vn[2][j]; vn[2][j] = __builtin_nontemporal_load((const f16x4*)(XR + (size_t)rn * 1024 + 256 * j + 4 * F.lane)); } }
        const int slot = s < NCX ? 0 : 1 + b - b0;
#pragma unroll
        for (int j = 0; j < 4; ++j) { const f32x4 g2 = *(const LAS f32x4*)(modg + slot * 1024 + 256 * j + 4 * F.lane); v[j] = v[j] * ALPHA + g2 * moe[j]; }
        ln_row(v, lnw, F.lane);
        if (last) { float* o = A.out + (size_t)(b * NX + s - NCX) * 1024;
#pragma unroll
            for (int j = 0; j < 4; ++j) *(f32x4*)(o + 256 * j + 4 * F.lane) = v[j]; }
        else { _Float16* xr = WSP(_Float16, WS_XRES) + (size_t)r * 1024;
#pragma unroll
            for (int j = 0; j < 4; ++j) *(f16x4*)(xr + 256 * j + 4 * F.lane) = f4h(v[j]);
            emit_row(F, A, r, v, wdt, modn + slot * 2048, modn + slot * 2048 + 1024); } }
#undef ROWOF
}
__device__ __forceinline__ void p_qkpost(Frame& F, ArgsR A, int L) {
    const bf16* PROJ = WSP(bf16, WS_PROJ); const float* ROPE = WSP(float, WS_ROPE);
    const int gw = F.vcu * NWAVES + F.wave, NGW = F.G * NWAVES, m = F.lane & 7;
    bf16* KC = WSP(bf16, WS_KC); bf16* VC = WSP(bf16, WS_VC);
    const float* nwp = A.in[I_KNORM] + L * 64 + 8 * m; const f32x4 n0 = *(const f32x4*)nwp, n1 = *(const f32x4*)(nwp + 4);
    for (int it0 = gw * 8; it0 < R * 4; it0 += NGW * 8 * 3) {
        v4u raws[3]; f32x4 rc[3][4];
#pragma unroll
        for (int p = 0; p < 3; ++p) { const int it = it0 + p * NGW * 8, item = (it < R * 4 ? it : gw * 8) + (F.lane >> 3), r = item >> 2, sl = item & 3, s = r % LB;
            raws[p] = *(const v4u*)(PROJ + (size_t)r * NPROJ + KCOL + sl * 64 + 8 * m);
            const int t = s >= NCX ? s - NCX : 0, pos = (m >> 2) ? (t & 63) : (t >> 6); const float* rp = ROPE + (size_t)(pos * 16 + 8 * (m & 1)) * 2;
#pragma unroll
            for (int q = 0; q < 4; ++q) rc[p][q] = *(const f32x4*)(rp + 4 * q); }
#pragma unroll
        for (int p = 0; p < 3; ++p) { const int it = it0 + p * NGW * 8; if (it < R * 4) { const int item = it + (F.lane >> 3), r = item >> 2, sl = item & 3, s = r % LB; const bool lat = s >= NCX;
            const v4u raw = raws[p]; float e[8]; unpack8(raw, e);
            float ss = 0.f;
#pragma unroll
            for (int i = 0; i < 8; ++i) ss += e[i] * e[i];
            ss += dpp_f<0xB1>(ss); ss += dpp_f<0x4E>(ss); ss += dpp_f<0x141>(ss);
            const float rs = __builtin_amdgcn_rsqf(ss * (1.f / 64.f) + LN_EPS);
            e[0] *= rs * n0[0]; e[1] *= rs * n0[1]; e[2] *= rs * n0[2]; e[3] *= rs * n0[3]; e[4] *= rs * n1[0]; e[5] *= rs * n1[1]; e[6] *= rs * n1[2]; e[7] *= rs * n1[3];
            const f32x4 c0 = rc[p][0], c1 = rc[p][1], c2 = rc[p][2], c3 = rc[p][3];
            const float cs[8] = {c0[0], c0[2], c1[0], c1[2], c2[0], c2[2], c3[0], c3[2]}, sn[8] = {c0[1], c0[3], c1[1], c1[3], c2[1], c2[3], c3[1], c3[3]};
            const float sgn = (m & 2) ? 1.f : -1.f; float o[8];
#pragma unroll
            for (int i = 0; i < 8; ++i) { const float pe = dpp_f<0x4E>(e[i]); o[i] = lat ? e[i] * cs[i] + sgn * pe * sn[i] : e[i]; }
            const v4u outv = (v4u){pk2(o[0], o[1]), pk2(o[2], o[3]), pk2(o[4], o[5]), pk2(o[6], o[7])};
            const int bb = r / LB, tl = s >> 6, rr = s & 63;
            if (sl < 2) *(v4u*)(KC + ((size_t)(bb * (LB / 64) + tl) * 2 + sl) * 4096 + (m * 64 + rr) * 8) = outv;
            else *(v4u*)(VC + ((size_t)(bb * (LB / 64) + tl) * 2 + (sl - 2)) * 4096 + ((((rr >> 4) + 4 * (m >> 2)) * 64) + (rr & 15) * 4 + (m & 3)) * 8) = raw; } }
    }
}
template <int MODE> __device__ __forceinline__ void ssd_unit(Frame& F, ArgsR A, int L, int b, int c) {
    constexpr int LD = 72;
    LAS bf16* XT = (LAS bf16*)(F.lds + RING_OFF);
    LAS bf16* Brow = XT + 4 * 64 * LD;
    LAS bf16* CB = Brow + 2 * 64 * LD;
    LAS bf16* Msl = CB + 2 * 64 * LD;
    LAS float* dtv = (LAS float*)(Msl + 8 * 16 * LD);
    LAS float* csv = dtv + 512;
    LAS float* ssq = csv + 512;
    LAS bf16* YO = (LAS bf16*)(ssq + 128);
    const int tid = F.tid, lane = F.lane, w = F.wave, q = lane >> 4, c16 = lane & 15;
    const bf16* PROJ = WSP(bf16, WS_PROJ);
    const int r0 = b * LB + 64 * c, seg_lo = (c < 4) ? b * LB : b * LB + NCX, seg_hi = (c < 4) ? b * LB + NCX : (b + 1) * LB;
    __syncthreads();
    { const int cg = tid & 63, ro = tid >> 6, ch0 = 8 * cg;
      if (MODE == 3 || cg < 48) {
        v4u raw[11];
#pragma unroll
        for (int i = 0; i < 11; ++i) { const int rr = r0 + 8 * ro - 1 + i, rc = rr < seg_lo ? seg_lo : (rr >= seg_hi ? seg_hi - 1 : rr);
            v4u p = *(const v4u*)(PROJ + (size_t)rc * NPROJ + XBCCOL + ch0); if (rr < seg_lo || rr >= seg_hi) p = (v4u){0u, 0u, 0u, 0u}; raw[i] = p; }
        float wt[4][8], bs[8];
        { const float* cw = A.in[I_SCONVW] + (size_t)L * 4 * 512 + ch0;
#pragma unroll
          for (int j = 0; j < 4; ++j) { const f32x4 a0 = *(const f32x4*)(cw + j * 512), a1 = *(const f32x4*)(cw + j * 512 + 4); wt[j][0] = a0[0]; wt[j][1] = a0[1]; wt[j][2] = a0[2]; wt[j][3] = a0[3]; wt[j][4] = a1[0]; wt[j][5] = a1[1]; wt[j][6] = a1[2]; wt[j][7] = a1[3]; }
          const f32x4 b0 = *(const f32x4*)(A.in[I_SCONVB] + L * 512 + ch0), b1 = *(const f32x4*)(A.in[I_SCONVB] + L * 512 + ch0 + 4); bs[0] = b0[0]; bs[1] = b0[1]; bs[2] = b0[2]; bs[3] = b0[3]; bs[4] = b1[0]; bs[5] = b1[1]; bs[6] = b1[2]; bs[7] = b1[3]; }
        v4u rp[8];
        { float w0[8], w1[8], w2[8], w3[8]; unpack8(raw[0], w0); unpack8(raw[1], w1); unpack8(raw[2], w2);
#pragma unroll
          for (int l = 0; l < 8; ++l) { unpack8(raw[l + 3], w3); float y[8];
#pragma unroll
              for (int cc = 0; cc < 8; ++cc) { y[cc] = silu_ff(wt[0][cc] * w0[cc] + wt[1][cc] * w1[cc] + wt[2][cc] * w2[cc] + wt[3][cc] * w3[cc] + bs[cc]); w0[cc] = w1[cc]; w1[cc] = w2[cc]; w2[cc] = w3[cc]; }
              rp[l] = (v4u){pk2(y[0], y[1]), pk2(y[2], y[3]), pk2(y[4], y[5]), pk2(y[6], y[7])}; } }
#define ROWPK(l) (rp[l])
#define CPAIR(cc, i) (((cc) & 1) ? ((rp[2 * (i)][(cc) >> 1] >> 16) | (rp[2 * (i) + 1][(cc) >> 1] & 0xffff0000u)) : ((rp[2 * (i)][(cc) >> 1] & 0xffffu) | (rp[2 * (i) + 1][(cc) >> 1] << 16)))
#define COLPK(cc) ((v4u){CPAIR(cc, 0), CPAIR(cc, 1), CPAIR(cc, 2), CPAIR(cc, 3)})
        if (ch0 < 256) { const int h = ch0 >> 6, p0 = ch0 & 63;
#pragma unroll
            for (int cc = 0; cc < 8; ++cc) *(LAS v4u*)(XT + (h * 64 + p0 + cc) * LD + 8 * ro) = COLPK(cc);
        } else if (ch0 < 384) { const int g = (ch0 - 256) >> 6, n0 = ch0 & 63;
#pragma unroll
            for (int l = 0; l < 8; ++l) *(LAS v4u*)(Brow + (g * 64 + 8 * ro + l) * LD + n0) = ROWPK(l);
            if (MODE == 1) {
#pragma unroll
                for (int cc = 0; cc < 8; ++cc) *(LAS v4u*)(CB + (g * 64 + n0 + cc) * LD + 8 * ro) = COLPK(cc); }
        } else { const int g = (ch0 - 384) >> 6, n0 = ch0 & 63;
#pragma unroll
            for (int l = 0; l < 8; ++l) *(LAS v4u*)(CB + (g * 64 + 8 * ro + l) * LD + n0) = ROWPK(l); }
#undef ROWPK
#undef COLPK
#undef CPAIR
      } }
    { const int dh = tid >> 6, l = tid & 63;
      const float dt = softplus_f(WSP(float, WS_DT)[(size_t)(r0 + l) * 8 + dh] + A.in[I_SDTB][L * 8 + dh]); const float a = -__expf(A.in[I_SALOG][L * 8 + dh]);
      float s = dt * a;
      if (w < 4) {
#pragma unroll
          for (int o = 1; o < 64; o <<= 1) { const float t = __shfl_up(s, o); if (l >= o) s += t; } }
      else {
#pragma unroll
          for (int o = 1; o < 64; o <<= 1) { const float t = __shfl_down(s, o); if (l + o < 64) s += t; } }
      dtv[dh * 64 + l] = dt; csv[dh * 64 + l] = s; }
    __syncthreads();
    if (MODE == 1) {
        const int d = w >> 2, h = w & 3, g = h >> 1, dh = w;
        const float cs_end = d == 0 ? csv[dh * 64 + 63] : csv[dh * 64];
        const size_t chain = (size_t)((b * 2 + d) * 4 + h) * NCH + c;
        float* S = WSP(float, WS_S) + chain * 4096;
        float wg[2][8];
#pragma unroll
        for (int ks = 0; ks < 2; ++ks)
#pragma unroll
            for (int i = 0; i < 8; ++i) { const int k = 32 * ks + 8 * q + i; wg[ks][i] = __expf(cs_end - csv[dh * 64 + k]) * dtv[dh * 64 + k]; }
#pragma unroll
        for (int pt = 0; pt < 4; ++pt) { f32x4 acc[4];
#pragma unroll
            for (int nt = 0; nt < 4; ++nt) acc[nt] = (f32x4){0.f, 0.f, 0.f, 0.f};
#pragma unroll
            for (int ks = 0; ks < 2; ++ks) { const bf16x8 a0 = lds_frag(XT + h * 64 * LD, LD, 16 * pt, 32 * ks, lane); bf16x8 a;
#pragma unroll
                for (int i = 0; i < 8; ++i) a[i] = (short)f2bf(bf2f((unsigned short)a0[i]) * wg[ks][i]);
#pragma unroll
                for (int nt = 0; nt < 4; ++nt) acc[nt] = mfma16(a, lds_frag(CB + g * 64 * LD, LD, 16 * nt, 32 * ks, lane), acc[nt]); }
#pragma unroll
            for (int nt = 0; nt < 4; ++nt)
#pragma unroll
                for (int j = 0; j < 4; ++j) S[(16 * pt + 4 * q + j) * 64 + 16 * nt + c16] = acc[nt][j]; }
        if (lane == 0) WSP(float, WS_TOT)[chain] = __expf(cs_end);
    } else {
        {
          const int h = w & 3, rh = w >> 2, g2 = h >> 1; const LAS bf16* Cg2 = CB + g2 * 64 * LD;
          f32x4 yo[2][4];
#pragma unroll
          for (int r2 = 0; r2 < 2; ++r2)
#pragma unroll
              for (int pt = 0; pt < 4; ++pt) yo[r2][pt] = (f32x4){0.f, 0.f, 0.f, 0.f};
#pragma unroll
          for (int d = 0; d < 2; ++d) { const int dh = d * 4 + h; const bf16* Hin = WSP(bf16, WS_HIN) + ((size_t)((b * 2 + d) * 4 + h) * NCH + c) * 4096;
              bf16x8 hq[4][2];
#pragma unroll
              for (int pt = 0; pt < 4; ++pt)
#pragma unroll
                  for (int ks = 0; ks < 2; ++ks) hq[pt][ks] = *(const bf16x8*)(Hin + (16 * pt + c16) * 64 + 32 * ks + 8 * q);
#pragma unroll
              for (int r2 = 0; r2 < 2; ++r2) { const int rt = 2 * rh + r2; const bf16x8 a0 = lds_frag(Cg2, LD, 16 * rt, 0, lane), a1 = lds_frag(Cg2, LD, 16 * rt, 32, lane);
                  float ec[4];
#pragma unroll
                  for (int j = 0; j < 4; ++j) ec[j] = exp_f(csv[dh * 64 + 16 * rt + 4 * q + j]);
#pragma unroll
                  for (int pt = 0; pt < 4; ++pt) { f32x4 off = {0.f, 0.f, 0.f, 0.f}; off = mfma16(a0, hq[pt][0], off); off = mfma16(a1, hq[pt][1], off);
#pragma unroll
                      for (int j = 0; j < 4; ++j) yo[r2][pt][j] += off[j] * ec[j]; } } }
#pragma unroll
          for (int r2 = 0; r2 < 2; ++r2)
#pragma unroll
              for (int pt = 0; pt < 4; ++pt)
#pragma unroll
                  for (int j = 0; j < 4; ++j) YO[(h * 64 + 16 * (2 * rh + r2) + 4 * q + j) * LD + 16 * pt + c16] = (bf16)f2bf(yo[r2][pt][j]);
        }
        __syncthreads();
        const int rt = w & 3, g = w >> 2;
        const LAS bf16* Cg = CB + g * 64 * LD; const LAS bf16* Bg = Brow + g * 64 * LD; LAS bf16* Mw = Msl + w * 16 * LD;
        f32x4 G[4];
#pragma unroll
        for (int st = 0; st < 4; ++st) { G[st] = (f32x4){0.f, 0.f, 0.f, 0.f};
#pragma unroll
            for (int ks = 0; ks < 2; ++ks) G[st] = mfma16(lds_frag(Bg, LD, 16 * st, 32 * ks, lane), lds_frag(Cg, LD, 16 * rt, 32 * ks, lane), G[st]); }
        f32x4 y[2][4];
#pragma unroll
        for (int hh = 0; hh < 2; ++hh)
#pragma unroll
            for (int pt = 0; pt < 4; ++pt) y[hh][pt] = (f32x4){0.f, 0.f, 0.f, 0.f};
#pragma unroll
        for (int hh = 0; hh < 2; ++hh) { const int h = 2 * g + hh; const LAS bf16* XTh = XT + h * 64 * LD;
#pragma unroll
            for (int d = 0; d < 2; ++d) { const int dh = d * 4 + h;
                float csl[4];
#pragma unroll
                for (int j = 0; j < 4; ++j) csl[j] = csv[dh * 64 + 16 * rt + 4 * q + j];
                { const int l = 16 * rt + c16; const float csm = csv[dh * 64 + l];
#pragma unroll
                  for (int st = 0; st < 4; ++st) { const f32x4 css = *(const LAS f32x4*)(csv + dh * 64 + 16 * st + 4 * q), dts = *(const LAS f32x4*)(dtv + dh * 64 + 16 * st + 4 * q); float val[4];
#pragma unroll
                      for (int j = 0; j < 4; ++j) { const int s = 16 * st + 4 * q + j; const bool valid = d == 0 ? (s <= l) : (s >= l);
                          val[j] = valid ? G[st][j] * exp_f(fminf(csm - css[j], 0.f)) * dts[j] : 0.f; }
                      *(LAS v2u*)(Mw + c16 * LD + 16 * st + 4 * q) = (v2u){pk2(val[0], val[1]), pk2(val[2], val[3])}; } }
                LDS_WAIT();
#pragma unroll
                for (int ks = 0; ks < 2; ++ks) { const bf16x8 a = lds_frag(Mw, LD, 0, 32 * ks, lane);
#pragma unroll
                    for (int pt = 0; pt < 4; ++pt) y[hh][pt] = mfma16(a, lds_frag(XTh, LD, 16 * pt, 32 * ks, lane), y[hh][pt]); }
                LDS_WAIT();
            }
            const float Dv = A.in[I_SD][L * 4 + h];
#pragma unroll
            for (int pt = 0; pt < 4; ++pt)
#pragma unroll
                for (int j = 0; j < 4; ++j) y[hh][pt][j] += Dv * bf2f(XTh[(16 * pt + c16) * LD + 16 * rt + 4 * q + j]) + bf2f(YO[(h * 64 + 16 * rt + 4 * q + j) * LD + 16 * pt + c16]);
        }
        float ss[4] = {0.f, 0.f, 0.f, 0.f};
#pragma unroll
        for (int hh = 0; hh < 2; ++hh)
#pragma unroll
            for (int pt = 0; pt < 4; ++pt)
#pragma unroll
                for (int j = 0; j < 4; ++j) { const int r = r0 + 16 * rt + 4 * q + j; const float z = bf2f(PROJ[(size_t)r * NPROJ + ZCOL + (2 * g + hh) * 64 + 16 * pt + c16]);
                    const float v = y[hh][pt][j] * silu_ff(z); y[hh][pt][j] = v; ss[j] += v * v; }
#pragma unroll
        for (int j = 0; j < 4; ++j) { float s = ss[j]; s += __shfl_xor(s, 1); s += __shfl_xor(s, 2); s += __shfl_xor(s, 4); s += __shfl_xor(s, 8); if (c16 == 0) ssq[g * 64 + 16 * rt + 4 * q + j] = s; }
        __syncthreads();
        bf16* MG = WSP(bf16, WS_MERGED);
#pragma unroll
        for (int j = 0; j < 4; ++j) { const int l = 16 * rt + 4 * q + j; const float rs = __builtin_amdgcn_rsqf((ssq[l] + ssq[64 + l]) * (1.f / 256.f) + LN_EPS);
#pragma unroll
            for (int hh = 0; hh < 2; ++hh)
#pragma unroll
                for (int pt = 0; pt < 4; ++pt) { const int chn = (2 * g + hh) * 64 + 16 * pt + c16; MG[(size_t)(r0 + l) * 1024 + 512 + chn] = (bf16)f2bf(y[hh][pt][j] * rs * A.in[I_SNORM][L * 256 + chn]); } }
    }
}
template <int MODE> __device__ __forceinline__ void rg_unit(Frame& F, ArgsR A, int L, int b, int c) {
    constexpr int LDU = 264, LDQ = 68;
    LAS bf16* U = (LAS bf16*)(F.lds + RING_OFF);
    LAS unsigned* QT = (LAS unsigned*)(F.lds + RING_OFF + 33792);
    const int tid = F.tid, lane = F.lane, w = F.wave, q = lane >> 4, c16 = lane & 15;
    const bf16* PROJ = WSP(bf16, WS_PROJ);
    const int r0 = b * LB + 64 * c, seg_lo = (c < 4) ? b * LB : b * LB + NCX, seg_hi = (c < 4) ? b * LB + NCX : (b + 1) * LB;
    __syncthreads();
    { const int cg = tid & 31, rq = tid >> 5, ch0 = 8 * cg;
      v4u raw[7];
#pragma unroll
      for (int i = 0; i < 7; ++i) { const int rr = r0 + 4 * rq - 1 + i, rc = rr < seg_lo ? seg_lo : (rr >= seg_hi ? seg_hi - 1 : rr);
          v4u p = *(const v4u*)(PROJ + (size_t)rc * NPROJ + UCOL + ch0); if (rr < seg_lo || rr >= seg_hi) p = (v4u){0u, 0u, 0u, 0u}; raw[i] = p; }
      float wt[4][8], bs[8];
      { const float* cw = A.in[I_RCONVW] + (size_t)L * 4 * 256 + ch0;
#pragma unroll
        for (int j = 0; j < 4; ++j) { const f32x4 a0 = *(const f32x4*)(cw + j * 256), a1 = *(const f32x4*)(cw + j * 256 + 4); wt[j][0] = a0[0]; wt[j][1] = a0[1]; wt[j][2] = a0[2]; wt[j][3] = a0[3]; wt[j][4] = a1[0]; wt[j][5] = a1[1]; wt[j][6] = a1[2]; wt[j][7] = a1[3]; }
        const f32x4 b0 = *(const f32x4*)(A.in[I_RCONVB] + L * 256 + ch0), b1 = *(const f32x4*)(A.in[I_RCONVB] + L * 256 + ch0 + 4); bs[0] = b0[0]; bs[1] = b0[1]; bs[2] = b0[2]; bs[3] = b0[3]; bs[4] = b1[0]; bs[5] = b1[1]; bs[6] = b1[2]; bs[7] = b1[3]; }
      float w0[8], w1[8], w2[8], w3[8]; unpack8(raw[0], w0); unpack8(raw[1], w1); unpack8(raw[2], w2);
#pragma unroll
      for (int l = 0; l < 4; ++l) { unpack8(raw[l + 3], w3); float yv[8];
#pragma unroll
          for (int cc = 0; cc < 8; ++cc) { yv[cc] = wt[0][cc] * w0[cc] + wt[1][cc] * w1[cc] + wt[2][cc] * w2[cc] + wt[3][cc] * w3[cc] + bs[cc]; w0[cc] = w1[cc]; w1[cc] = w2[cc]; w2[cc] = w3[cc]; }
          *(LAS v4u*)(U + (4 * rq + l) * LDU + ch0) = (v4u){pk2(yv[0], yv[1]), pk2(yv[2], yv[3]), pk2(yv[4], yv[5]), pk2(yv[6], yv[7])}; }
    }
    __syncthreads();
    LAS bf16* P16 = (LAS bf16*)(F.lds + RING_OFF + 33792 + 69632);
#pragma unroll 1
    for (int d = 0; d < 2; ++d) {
        { const int blk = w & 3, eh = w >> 2;
          const bf16* WA = WSP(bf16, WS_RGW) + (size_t)(((L * 2 + 0) * 2 + d) * 4 + blk) * 4096; const bf16* WX = WSP(bf16, WS_RGW) + (size_t)(((L * 2 + 1) * 2 + d) * 4 + blk) * 4096;
          bf16x8 wa0[2], wa1[2], wx0[2], wx1[2]; float ba[2], bx[2], sp[2];
#pragma unroll
          for (int n2 = 0; n2 < 2; ++n2) { const int e = 32 * eh + 16 * n2 + c16, ch = blk * 64 + e;
              wa0[n2] = *(const bf16x8*)(WA + e * 64 + 8 * q); wa1[n2] = *(const bf16x8*)(WA + e * 64 + 32 + 8 * q); wx0[n2] = *(const bf16x8*)(WX + e * 64 + 8 * q); wx1[n2] = *(const bf16x8*)(WX + e * 64 + 32 + 8 * q);
              ba[n2] = A.in[I_RBA][(L * 2 + d) * 256 + ch]; bx[n2] = A.in[I_RBX][(L * 2 + d) * 256 + ch]; sp[n2] = A.in[I_RLAM][(L * 2 + d) * 256 + ch]; }
          sp[0] = softplus_f(-sp[0]); sp[1] = softplus_f(-sp[1]);
#pragma unroll
          for (int rt = 0; rt < 4; ++rt) {
              const bf16x8 a0 = lds_frag(U, LDU, 16 * rt, blk * 64, lane), a1 = lds_frag(U, LDU, 16 * rt, blk * 64 + 32, lane);
#pragma unroll
              for (int n2 = 0; n2 < 2; ++n2) { const int ch = blk * 64 + 32 * eh + 16 * n2 + c16;
                  f32x4 pa = {0.f, 0.f, 0.f, 0.f}, px = {0.f, 0.f, 0.f, 0.f};
                  pa = mfma16(a0, wa0[n2], pa); pa = mfma16(a1, wa1[n2], pa); px = mfma16(a0, wx0[n2], px); px = mfma16(a1, wx1[n2], px);
                  v4u pk;
#pragma unroll
                  for (int j = 0; j < 4; ++j) { const int l = 16 * rt + 4 * q + j; const float la = -8.0f * sigmoid_f(pa[j] + ba[n2]) * sp[n2];
                      const float inp = __builtin_amdgcn_sqrtf(fmaxf(1.0f - exp_f(2.0f * la), 0.f)) * sigmoid_f(px[j] + bx[n2]) * bf2f(U[l * LDU + ch]);
                      pk[j] = pk2(la, inp); }
                  if (d == 1) pk = (v4u){pk[3], pk[2], pk[1], pk[0]};
                  *(LAS v4u*)(QT + ch * LDQ + (d == 0 ? 16 * rt + 4 * q : 60 - 16 * rt - 4 * q)) = pk; } } }
        __syncthreads();
        if (tid < 256) { const int ch = tid; const size_t o = (size_t)((b * NCH + c) * 2 + d) * 256 + ch;
            float h = MODE == 1 ? 0.f : WSP(float, WS_RGC)[o], ls = 0.f;
#pragma unroll 1
            for (int g = 0; g < 4; ++g) { v4u qv[4];
#pragma unroll
                for (int i = 0; i < 4; ++i) qv[i] = *(const LAS v4u*)(QT + ch * LDQ + 16 * g + 4 * i);
#pragma unroll
                for (int kk = 0; kk < 16; ++kk) { const unsigned e = qv[kk >> 2][kk & 3]; const float la = bf2f(e & 0xffffu); h = exp_f(la) * h + __uint_as_float(e & 0xffff0000u); ls += la;
                    if (MODE == 1) { const int k = 16 * g + kk, l = d == 0 ? k : 63 - k;
                        WSP(unsigned, WS_RGL)[((size_t)(b * 2 + d) * LB + 64 * c + l) * 256 + ch] = pk2(h, exp_f(ls)); }
                    if (MODE == 3) { const int k = 16 * g + kk; if (d == 0) P16[k * 256 + ch] = (bf16)f2bf(h); else P16[(63 - k) * 256 + ch] = (bf16)f2bf(h + bf2f(P16[(63 - k) * 256 + ch])); } } }
            if (MODE == 1) { float* RS = WSP(float, WS_RGS); *(f32x2_t*)(RS + 2 * o) = (f32x2_t){__expf(ls), h}; } }
        __syncthreads();
    }
    if (MODE == 3) {
        bf16* MG = WSP(bf16, WS_MERGED);
        const f32x4 nwr = *(const f32x4*)(A.in[I_RONORM] + L * 256 + 4 * lane); const f32x4 nwa0 = *(const f32x4*)(A.in[I_AONORM] + L * 512 + 8 * lane), nwa1 = *(const f32x4*)(A.in[I_AONORM] + L * 512 + 8 * lane + 4);
#pragma unroll 1
        for (int r4 = 0; r4 < 8; r4 += 4) {
        v2u gp[4]; v4u op[4];
#pragma unroll
        for (int rr = 0; rr < 4; ++rr) { const size_t r = (size_t)(r0 + 8 * w + r4 + rr); gp[rr] = *(const v2u*)(PROJ + r * NPROJ + GCOL + 4 * lane); op[rr] = *(const v4u*)(WSP(bf16, WS_OB) + r * 512 + 8 * lane); }
#pragma unroll
        for (int rr = 0; rr < 4; ++rr) { const int l = 8 * w + r4 + rr; const size_t r = (size_t)(r0 + l);
            { const v2u hp = *(const LAS v2u*)(P16 + l * 256 + 4 * lane); const f32x4 hv = {bf2f(hp.x & 0xffffu), bf2f(hp.x >> 16), bf2f(hp.y & 0xffffu), bf2f(hp.y >> 16)};
              float v[4]; v[0] = hv[0] * gelu_tanh_f(bf2f(gp[rr].x & 0xffffu)); v[1] = hv[1] * gelu_tanh_f(bf2f(gp[rr].x >> 16)); v[2] = hv[2] * gelu_tanh_f(bf2f(gp[rr].y & 0xffffu)); v[3] = hv[3] * gelu_tanh_f(bf2f(gp[rr].y >> 16));
              const float rs = __builtin_amdgcn_rsqf(wave_sum((v[0] * v[0] + v[1] * v[1]) + (v[2] * v[2] + v[3] * v[3])) * (1.f / 256.f) + LN_EPS);
              v2u o; o.x = pk2(v[0] * rs * nwr[0], v[1] * rs * nwr[1]); o.y = pk2(v[2] * rs * nwr[2], v[3] * rs * nwr[3]); *(v2u*)(MG + r * 1024 + 768 + 4 * lane) = o; }
            { float v[8]; unpack8(op[rr], v); float s = 0.f;
#pragma unroll
              for (int i = 0; i < 8; ++i) s += v[i] * v[i];
              const float rs = __builtin_amdgcn_rsqf(wave_sum(s) * (1.f / 512.f) + LN_EPS);
              v4u o; o.x = pk2(v[0] * rs * nwa0[0], v[1] * rs * nwa0[1]); o.y = pk2(v[2] * rs * nwa0[2], v[3] * rs * nwa0[3]); o.z = pk2(v[4] * rs * nwa1[0], v[5] * rs * nwa1[1]); o.w = pk2(v[6] * rs * nwa1[2], v[7] * rs * nwa1[3]);
              *(v4u*)(MG + r * 1024 + 8 * lane) = o; } }
        }
    }
}
__device__ __forceinline__ void p_carry(Frame& F, ArgsR A) {
    typedef float f32x2 __attribute__((ext_vector_type(2)));
    const int gt = blockIdx.x * (NWAVES * 64) + F.tid, NT = F.G * NWAVES * 64;
    for (int idx = gt; idx < 64 * 2048; idx += NT) { const int chain = idx >> 11, e2 = idx & 2047, d = (chain >> 2) & 1;
        const f32x2* S = (const f32x2*)(WSP(float, WS_S) + (size_t)chain * NCH * 4096) + e2; unsigned* H = WSP(unsigned, WS_HIN) + (size_t)chain * NCH * 2048 + e2; const float* T = WSP(float, WS_TOT) + chain * NCH;
        f32x2 st = {0.f, 0.f};
        for (int k0 = 0; k0 < NCH; k0 += 4) { f32x2 s[4]; float tt[4]; int cc[4];
#pragma unroll
            for (int i = 0; i < 4; ++i) { const int k = k0 + i; cc[i] = d == 0 ? k : (k < 4 ? 3 - k : 71 - k); s[i] = S[(size_t)cc[i] * 2048]; tt[i] = T[cc[i]]; }
#pragma unroll
            for (int i = 0; i < 4; ++i) { H[(size_t)cc[i] * 2048] = pk2(st[0], st[1]); st = st * tt[i] + s[i]; } } }
    for (int idx = gt; idx < 4096; idx += NT) { const int b = idx >> 9, d = (idx >> 8) & 1, ch = idx & 255; float st = 0.f;
        for (int k0 = 0; k0 < NCH; k0 += 4) { f32x2 av[4]; size_t oo[4];
#pragma unroll
            for (int i = 0; i < 4; ++i) { const int k = k0 + i, c = d == 0 ? k : (k < 4 ? 3 - k : 71 - k); oo[i] = (size_t)((b * NCH + c) * 2 + d) * 256 + ch; av[i] = *(const f32x2*)(WSP(float, WS_RGS) + 2 * oo[i]); }
#pragma unroll
            for (int i = 0; i < 4; ++i) { WSP(float, WS_RGC)[oo[i]] = st; st = av[i][0] * st + av[i][1]; } } }
}
__device__ __forceinline__ unsigned block_sum_u(Frame& F, unsigned v, LAS unsigned* red) {
#pragma unroll
    for (int o = 1; o < 64; o <<= 1) v += __shfl_xor(v, o);
    __syncthreads();
    if (F.lane == 0) red[F.wave] = v;
    __syncthreads();
    unsigned s = 0;
#pragma unroll
    for (int i = 0; i < 8; ++i) s += red[i];
    return s;
}
__device__ __forceinline__ unsigned block_excl_scan_u(Frame& F, unsigned v, LAS unsigned* red) {
    unsigned inc = v;
#pragma unroll
    for (int o = 1; o < 64; o <<= 1) { const unsigned t = __shfl_up(inc, o); if (F.lane >= o) inc += t; }
    __syncthreads();
    if (F.lane == 63) red[F.wave] = inc;
    __syncthreads();
    unsigned base = 0;
#pragma unroll
    for (int i = 0; i < 8; ++i) base += (i < F.wave) ? red[i] : 0u;
    return base + inc - v;
}
__device__ __forceinline__ void topk_unit(Frame& F, ArgsR A, int set, int b, int e) {
    LAS unsigned* red = (LAS unsigned*)(F.lds + RING_OFF);
    const int n = set == 0 ? NX : NCX, cap = set == 0 ? 512 : 32, row0 = b * LB + (set == 0 ? NCX : 0);
    const float* AFF = WSP(float, WS_AFF);
    unsigned key[8];
#pragma unroll
    for (int j = 0; j < 8; ++j) { const int t = 8 * F.tid + j, tc = t < n ? t : n - 1; const unsigned kv = __float_as_uint(AFF[(size_t)(row0 + tc) * 16 + e]); key[j] = t < n ? kv : 0u; }
    unsigned prefix = 0u;
    for (int it = 0; it < 15; ++it) { const int sh = 28 - 2 * it; const unsigned c1 = prefix | (1u << sh), c2 = prefix | (2u << sh), c3 = prefix | (3u << sh); unsigned pk = 0;
#pragma unroll
        for (int j = 0; j < 8; ++j) pk += (key[j] >= c1 ? 1u : 0u) + (key[j] >= c2 ? 1u << 10 : 0u) + (key[j] >= c3 ? 1u << 20 : 0u);
#pragma unroll
        for (int o = 1; o < 64; o <<= 1) pk += __shfl_xor(pk, o);
        LAS unsigned* rb = red + 16 + 8 * (it & 1);
        if (F.lane == 0) rb[F.wave] = pk;
        __syncthreads();
        unsigned n1 = 0, n2 = 0, n3 = 0;
#pragma unroll
        for (int i = 0; i < 8; ++i) { const unsigned v = rb[i]; n1 += v & 1023u; n2 += (v >> 10) & 1023u; n3 += v >> 20; }
        prefix = n3 >= (unsigned)cap ? c3 : (n2 >= (unsigned)cap ? c2 : (n1 >= (unsigned)cap ? c1 : prefix)); }
    const unsigned T = prefix; unsigned ngt = 0, neq = 0;
#pragma unroll
    for (int j = 0; j < 8; ++j) { ngt += key[j] > T ? 1u : 0u; neq += key[j] == T ? 1u : 0u; }
    const unsigned tot_gt = block_sum_u(F, ngt, red); const unsigned need = (unsigned)cap - tot_gt;
    unsigned tie = block_excl_scan_u(F, neq, red);
    unsigned selmask = 0, nsel = 0;
#pragma unroll
    for (int j = 0; j < 8; ++j) { bool sel = key[j] > T; if (key[j] == T) { sel = tie < need; ++tie; } if (sel) { selmask |= 1u << j; ++nsel; } }
    unsigned slot = block_excl_scan_u(F, nsel, red);
    int* INV = WSP(int, WS_INV); int* SRC = WSP(int, WS_SRC); float* GATE = WSP(float, WS_GATE);
#pragma unroll
    for (int j = 0; j < 8; ++j) { const int t = 8 * F.tid + j; if (t < n) { const int r = row0 + t;
        if ((selmask >> j) & 1u) { const int rg = e * EROWS + (set == 0 ? b * 512 : 4096 + b * 32) + (int)slot; ++slot; SRC[rg] = r; GATE[rg] = __uint_as_float(key[j]); INV[(size_t)r * 16 + e] = rg; }
        else INV[(size_t)r * 16 + e] = -1; } }
}
__device__ __forceinline__ void p_topk(Frame& F, ArgsR A, int L) {
    const int nu = L == 0 ? 256 : 128;
    for (int u = blockIdx.x; u < nu; u += F.G) { __syncthreads(); topk_unit(F, A, u >> 7, (u & 127) >> 4, u & 15); }
}
__device__ __forceinline__ int queue_next(Frame& F, gu32* ctr) { __syncthreads(); if (F.tid == 0) F.MISC[0] = __hip_atomic_fetch_add(ctr, 1u, RLX_AGENT); __syncthreads(); return (int)F.MISC[0]; }
__device__ __forceinline__ void p_x1(Frame& F, ArgsR A, int L) {
    gu32* ctr = (gu32*)(A.ws + WS_CTL) + CW_QUEUE + 64 * (2 * L);
    for (;;) { const int u = queue_next(F, ctr); if (u >= 2 * NB * NCH) break;
        if (u < NB * NCH) rg_unit<1>(F, A, L, u / NCH, u % NCH); else ssd_unit<1>(F, A, L, (u - NB * NCH) / NCH, (u - NB * NCH) % NCH); }
}
__device__ __forceinline__ void p_x3(Frame& F0, ArgsR A, int L) {
    const int par = F0.vcu & 1;
#pragma unroll 1
    for (int step = 0; step < 2; ++step) { Frame F; make_frame(F, F0.lds);
      if ((step ^ par) == 0) {
    gu32* ctr = (gu32*)(A.ws + WS_CTL) + CW_QUEUE + 64 * (2 * L + 1);
    for (;;) { const int u = queue_next(F, ctr); if (u >= NB * NCH) break; if (L == 1 && u % NCH < NCX / 64) continue; ssd_unit<3>(F, A, L, u / NCH, u % NCH); }
      } else {
    const int gw = F.vcu * NWAVES + F.wave, NGW = F.G * NWAVES, lane = F.lane;
    const bf16* PROJ = WSP(bf16, WS_PROJ); bf16* MG = WSP(bf16, WS_MERGED); const unsigned* RGL = WSP(unsigned, WS_RGL); const float* RGC = WSP(float, WS_RGC); const bf16* OB = WSP(bf16, WS_OB);
    const f32x4 nwr = *(const f32x4*)(A.in[I_RONORM] + L * 256 + 4 * lane); const f32x4 nwa0 = *(const f32x4*)(A.in[I_AONORM] + L * 512 + 8 * lane), nwa1 = *(const f32x4*)(A.in[I_AONORM] + L * 512 + 8 * lane + 4);
    const int nrows3 = L == 1 ? NB * NX : R;
    for (int q0 = 2 * gw; q0 < nrows3; q0 += 2 * NGW) { const int r0 = L == 1 ? (q0 / NX) * LB + NCX + q0 % NX : q0;
        v4u sp[2][2]; f32x4 cr[2][2]; v2u gp[2]; v4u op[2];
#pragma unroll
        for (int p = 0; p < 2; ++p) { const int r = r0 + p, b = r / LB, s = r % LB, c = s >> 6;
#pragma unroll
            for (int d = 0; d < 2; ++d) { sp[p][d] = __builtin_nontemporal_load((const v4u*)(RGL + ((size_t)(b * 2 + d) * LB + s) * 256 + 4 * lane)); cr[p][d] = *(const f32x4*)(RGC + (size_t)((b * NCH + c) * 2 + d) * 256 + 4 * lane); }
            gp[p] = *(const v2u*)(PROJ + (size_t)r * NPROJ + GCOL + 4 * lane); op[p] = __builtin_nontemporal_load((const v4u*)(OB + (size_t)r * 512 + 8 * lane)); }
#pragma unroll
        for (int p = 0; p < 2; ++p) { const size_t r = (size_t)(r0 + p);
            { float hv[4];
#pragma unroll
              for (int i = 0; i < 4; ++i) hv[i] = (bf2f(sp[p][0][i] & 0xffffu) + __uint_as_float(sp[p][0][i] & 0xffff0000u) * cr[p][0][i]) + (bf2f(sp[p][1][i] & 0xffffu) + __uint_as_float(sp[p][1][i] & 0xffff0000u) * cr[p][1][i]);
              float v[4]; v[0] = hv[0] * gelu_tanh_f(bf2f(gp[p].x & 0xffffu)); v[1] = hv[1] * gelu_tanh_f(bf2f(gp[p].x >> 16)); v[2] = hv[2] * gelu_tanh_f(bf2f(gp[p].y & 0xffffu)); v[3] = hv[3] * gelu_tanh_f(bf2f(gp[p].y >> 16));
              const float rs = __builtin_amdgcn_rsqf(wave_sum((v[0] * v[0] + v[1] * v[1]) + (v[2] * v[2] + v[3] * v[3])) * (1.f / 256.f) + LN_EPS);
              v2u o; o.x = pk2(v[0] * rs * nwr[0], v[1] * rs * nwr[1]); o.y = pk2(v[2] * rs * nwr[2], v[3] * rs * nwr[3]); *(v2u*)(MG + r * 1024 + 768 + 4 * lane) = o; }
            { float v[8]; unpack8(op[p], v); float s = 0.f;
#pragma unroll
              for (int i = 0; i < 8; ++i) s += v[i] * v[i];
              const float rs = __builtin_amdgcn_rsqf(wave_sum(s) * (1.f / 512.f) + LN_EPS);
              v4u o; o.x = pk2(v[0] * rs * nwa0[0], v[1] * rs * nwa0[1]); o.y = pk2(v[2] * rs * nwa0[2], v[3] * rs * nwa0[3]); o.z = pk2(v[4] * rs * nwa1[0], v[5] * rs * nwa1[1]); o.w = pk2(v[6] * rs * nwa1[2], v[7] * rs * nwa1[3]);
              *(v4u*)(MG + r * 1024 + 8 * lane) = o; } } }
      }
      __syncthreads(); }
}
__device__ __forceinline__ void p_attn(Frame& F, ArgsR A, int L, unsigned char* lds_generic) {
    attn_body::bf16* P = (attn_body::bf16*)WSP(bf16, WS_PROJ);
    const int nun = L == 0 ? 1024 + 64 : 1024;
    const int slot = (F.vcu >> 3) & 3;
    for (int a = F.vcu, i = 0; a < nun; a += F.G, ++i) { int b, h, q0, nt;
        if (L == 0 && i == slot) { conv_rounds(F, A, 0, 12, 49152); __syncthreads(); }
        if (a < 1024) { b = a >> 7; h = (a & 127) >> 4; q0 = NCX + 256 * (a & 15); nt = 68; } else { b = (a - 1024) >> 3; h = (a - 1024) & 7; q0 = 0; nt = 4; }
        attn_body::attn_unit<8>(b, h, q0, nt, P, (const attn_body::bf16*)WSP(bf16, WS_KC), (const attn_body::bf16*)WSP(bf16, WS_VC), (attn_body::bf16*)WSP(bf16, WS_OB), A.in[I_QNORM] + L * 64, WSP(float, WS_ROPE), (char*)lds_generic + RING_OFF); }
}
__device__ __forceinline__ void make_frame(Frame& F, LAS unsigned char* lds) {
    F.lds = lds; F.MISC = (volatile LAS unsigned*)(lds + MISC_OFF);
    int tid = threadIdx.x; asm volatile("" : "+v"(tid));
    F.tid = tid; F.lane = F.tid & 63; F.wave = __builtin_amdgcn_readfirstlane(F.tid >> 6);
    int g = gridDim.x, bx = blockIdx.x; asm volatile("" : "+s"(g), "+s"(bx));
    F.G = g; F.vcu = (F.G % 8 == 0) ? (bx % 8) * (F.G / 8) + bx / 8 : bx;
}
__device__ __forceinline__ const __attribute__((address_space(4))) Args* kargs_ptr() { auto p = __builtin_amdgcn_kernarg_segment_ptr(); asm volatile("" : "+s"(p)); return (const __attribute__((address_space(4))) Args*)p; }
#define KARGS (*kargs_ptr())
PHASE_FN void ph_pro0(LAS unsigned char* lds) { Frame F; make_frame(F, lds); p_pro0(F, KARGS); }
PHASE_FN void ph_pro2(LAS unsigned char* lds, const XcdBarrier& bar) { Frame F; make_frame(F, lds); p_pro2(F, KARGS, bar); }
PHASE_FN void ph_inproj(LAS unsigned char* lds, int L) { Frame F; make_frame(F, lds); ArgsR A = KARGS;
    pg8::Gemm g{WSP(bf16, WS_HA), WSP(bf16, WS_WIN) + (size_t)L * 2048 * 1024, R, NPROJ, 1024}; pg8::StaticOrder S; S.init(R, NPROJ, F.G, (int)blockIdx.x);
    pg8::EpiStoreBf16 E{WSP(bf16, WS_PROJ), NPROJ, nullptr};
    pg8::gemm_phase<pg8::EpiStoreBf16, pg8::StaticOrder, true, true>(F.lds + RING_OFF, g, S, E);
    if (blockIdx.x >= 64) conv_rounds(F, A, L, 6, 49152); }
PHASE_FN void ph_qkpost(LAS unsigned char* lds, int L) { Frame F; make_frame(F, lds); p_qkpost(F, KARGS, L); }
PHASE_FN void ph_x1(LAS unsigned char* lds, int L) { Frame F; make_frame(F, lds); p_x1(F, KARGS, L); }
PHASE_FN void ph_attn(LAS unsigned char* lds, unsigned char* lds_generic, int L) { Frame F; make_frame(F, lds); p_attn(F, KARGS, L, lds_generic); }
PHASE_FN void ph_carry(LAS unsigned char* lds, int L) { Frame F; make_frame(F, lds); p_carry(F, KARGS); if (L == 1) { __syncthreads(); conv_rounds(F, KARGS, 1, 2, 49152); } }
PHASE_FN void ph_x3(LAS unsigned char* lds, int L) { Frame F; make_frame(F, lds); p_x3(F, KARGS, L); }
PHASE_FN void ph_outproj(LAS unsigned char* lds, int L) { Frame F; make_frame(F, lds); ArgsR A = KARGS;
    pg8::Gemm g{WSP(bf16, WS_MERGED), WSP(bf16, WS_WOUT) + (size_t)L * 1024 * 1024, R, 1024, 1024}; pg8::RowOrder S{L == 1, F.G, F.vcu};
    pg8::EpiStoreBf16 E{WSP(bf16, WS_YPRE), 1024, nullptr};
    pg8::gemm_phase<pg8::EpiStoreBf16, pg8::RowOrder, true, true>(F.lds + RING_OFF, g, S, E);
    if (L == 0 && F.vcu >= 32) conv_rounds(F, A, 0, 6, 49152); }
PHASE_FN void ph_ln1(LAS unsigned char* lds, int L, const XcdBarrier& bar) { Frame F; make_frame(F, lds); p_ln1(F, KARGS, L, bar); }
PHASE_FN void ph_topk(LAS unsigned char* lds, int L) { Frame F; make_frame(F, lds); p_topk(F, KARGS, L);
    conv_rounds(F, KARGS, L, blockIdx.x >= 128 ? 5 : 0, 49152); conv_rounds(F, KARGS, L, 1 << 20, 49152); }
PHASE_FN void ph_gemm1(LAS unsigned char* lds, int L) { Frame F; make_frame(F, lds); ArgsR A = KARGS;
    pg8::Gemm g{WSP(bf16, WS_HA), WSP(bf16, WS_WGU), RGROWS, 4096, 1024, WSP(int, WS_SRC)}; pg8::MoeOrder S{L == 0 ? 17 : 16, 16, F.G, F.vcu};
    pg8::EpiSwiGlu E{WSP(bf16, WS_HID), FF};
    pg8::gemm_phase<pg8::EpiSwiGlu, pg8::MoeOrder, true, true, true>(F.lds + RING_OFF, g, S, E); }
PHASE_FN void ph_gemm2(LAS unsigned char* lds, int L) { Frame F; make_frame(F, lds); ArgsR A = KARGS;
    pg8::Gemm g{WSP(bf16, WS_HID), WSP(bf16, WS_WD), RGROWS, 1024, FF}; pg8::MoeOrder S{L == 0 ? 17 : 16, 4, F.G, F.vcu};
    pg8::EpiStoreBf16 E{WSP(bf16, WS_YPRE), 1024, WSP(float, WS_GATE)};
    pg8::gemm_phase<pg8::EpiStoreBf16, pg8::MoeOrder, true, true>(F.lds + RING_OFF, g, S, E);
    if (L == 0 && F.vcu >= 64) { const int qmax = 32768 / (8 * (F.G > 64 ? F.G - 64 : 1)); conv_rounds(F, A, 1, qmax < 20 ? qmax : 20, 32768); } }
PHASE_FN void ph_ln2(LAS unsigned char* lds, int L, const XcdBarrier& bar) { Frame F; make_frame(F, lds); p_ln2(F, KARGS, L, bar); }

__global__ void __launch_bounds__(NWAVES * 64, 2) mk_fwd(Args A) {
    extern __shared__ __attribute__((aligned(16))) unsigned char lds[];
    LAS unsigned char* L3 = (LAS unsigned char*)lds;
    volatile LAS unsigned* MISC = (volatile LAS unsigned*)(L3 + MISC_OFF);
    gu32* ctl = (gu32*)(A.ws + WS_CTL);
    for (int u = threadIdx.x; u < (LDS_BYTES - LDSCTL_OFF) / 4; u += NWAVES * 64) ((LAS unsigned*)(L3 + LDSCTL_OFF))[u] = 0u;
    __syncthreads();
    const int lo = A.ph_lo, hi = A.ph_hi;
    XcdBarrier bar; bar.bar = (unsigned*)(ctl + CW_BAR); bar.x = 0; bar.st = nullptr;
    if (hi - lo > 1) bar = xcd_barrier_post((unsigned*)(ctl + CW_BAR), MISC + 8);
#ifndef PHMASK
#define PHMASK 0xfffff
#endif
#define EN(bit) (((PHMASK) >> (bit)) & 1)
#ifndef DUPMASK
#define DUPMASK 0
#endif
#define DUP(bit, call) do { if (((DUPMASK) >> (bit)) & 1) { __syncthreads(); call; } } while (0)
#define IN(k) (lo <= (k) && (k) < hi)
#define SEAM(k) do { if (IN(k) && IN((k) + 1)) xcd_barrier(bar); else __syncthreads(); } while (0)
    ph_pro0(L3);
    ph_pro2(L3, bar); SEAM(PH_PRO2);
#pragma unroll 1
    for (int L = 0; L < 2; ++L) {
        const int pb = PH_L0 + PH_PER_LAYER * L;
        if (EN(3) && IN(pb + PL_INPROJ)) { ph_inproj(L3, L); DUP(3, ph_inproj(L3, L)); } SEAM(pb + PL_INPROJ);
        if (EN(4) && IN(pb + PL_QKPOST)) ph_qkpost(L3, L); SEAM(pb + PL_QKPOST);
        if (IN(pb + PL_MIX1)) { if (EN(15)) { ph_attn(L3, lds, L); DUP(15, ph_attn(L3, lds, L)); } __syncthreads(); if (EN(5)) ph_x1(L3, L); } SEAM(pb + PL_MIX1);
        if (EN(6) && IN(pb + PL_CARRY)) { ph_carry(L3, L); DUP(6, ph_carry(L3, L)); } SEAM(pb + PL_CARRY);
        if (EN(7) && IN(pb + PL_MIX3)) ph_x3(L3, L); SEAM(pb + PL_MIX3);
        ph_outproj(L3, L);
        ph_ln1(L3, L, bar); SEAM(pb + PL_LN1);
        if (EN(10) && IN(pb + PL_TOPK)) { ph_topk(L3, L); DUP(10, ph_topk(L3, L)); } SEAM(pb + PL_TOPK);
        if (EN(12) && IN(pb + PL_GEMM1)) { ph_gemm1(L3, L); DUP(12, ph_gemm1(L3, L)); } SEAM(pb + PL_GEMM1);
        ph_gemm2(L3, L);
        ph_ln2(L3, L, bar); SEAM(pb + PL_LN2);
    }
#undef IN
#undef SEAM
}

extern "C" void kernel_launch(void* const* d_in, const int* in_sizes, int n_in, void* d_out, int out_size, void* d_ws, size_t ws_size, hipStream_t stream) {
    static int grid = 0;
    if (grid == 0) {
        if (n_in != 33 || out_size != NB * NX * DMODEL || ws_size < WS_END) { fprintf(stderr, "kernel_launch: unexpected problem (n_in %d, out %d, ws %zu)\n", n_in, out_size, ws_size); grid = -1; return; }
        int dev = 0, cus = 0, per_cu = 0;
        if (hipGetDevice(&dev) != hipSuccess || hipDeviceGetAttribute(&cus, hipDeviceAttributeMultiprocessorCount, dev) != hipSuccess) { grid = -1; return; }
        if (hipFuncSetAttribute((const void*)mk_fwd, hipFuncAttributeMaxDynamicSharedMemorySize, LDS_BYTES) != hipSuccess) { fprintf(stderr, "kernel_launch: hipFuncSetAttribute failed\n"); grid = -1; return; }
        if (hipOccupancyMaxActiveBlocksPerMultiprocessor(&per_cu, (const void*)mk_fwd, NWAVES * 64, LDS_BYTES) != hipSuccess || per_cu < 1) fprintf(stderr, "kernel_launch: occupancy query reports %d\n", per_cu);
        (void)hipGetLastError();
        grid = cus;
    }
    if (grid < 0) return;
    if (hipMemsetAsync((char*)d_ws + WS_CTL, 0, CTL_ZERO_BYTES, stream) != hipSuccess) return;
    Args a{};
    for (int i = 0; i < 33; ++i) a.in[i] = (const float*)d_in[i];
    a.out = (float*)d_out; a.ws = (unsigned char*)d_ws;
#if MK_PER_PHASE
    for (int p = 0; p < N_PHASES; ++p) { a.ph_lo = p; a.ph_hi = p + 1; hipLaunchKernelGGL(mk_fwd, dim3(grid), dim3(NWAVES * 64), LDS_BYTES, stream, a); }
#else
    a.ph_lo = 0; a.ph_hi = N_PHASES; hipLaunchKernelGGL(mk_fwd, dim3(grid), dim3(NWAVES * 64), LDS_BYTES, stream, a);
#endif
}
```
